# Optimizing an MI355X kernel written in HIP

```python
import jax, jax.numpy as jnp
from jax import lax
import numpy as np

D_MODEL = 2048
BATCH = 4
SEQ = 2048
DEPTH = 2
DEC_BATCH = 32
DEC_SEQ = 16
PAST_LEN = 4096

CHUNK = 64
D_MIX = 2 * D_MODEL
D_SSD = D_MIX // 2
SSD_HEAD_DIM = 64
SSD_HEADS = D_SSD // SSD_HEAD_DIM
SSD_GROUPS = 8
SSD_HEADS_PER_GROUP = SSD_HEADS // SSD_GROUPS
D_STATE = 128
SSD_CONV = 4
D_XBC = D_SSD + 2 * SSD_GROUPS * D_STATE
D_GMLP = D_MIX - D_SSD
GMLP_GROUPS = 8
GMLP_GROUP_DIM = D_GMLP // GMLP_GROUPS
GMLP_CHUNK = 128
D_IN = D_SSD + D_XBC + SSD_HEADS + 2 * D_GMLP
D_FF = 5632
FFN_CONV = 3
EPS = 1e-6

kernel_name = "hybrid_ssd_gmlp_convffn_stream_step"


def _rmsnorm(x, w):
    xf = x.astype(jnp.float32)
    y = xf * lax.rsqrt(jnp.mean(xf * xf, axis=-1, keepdims=True) + EPS)
    return (y * w.astype(jnp.float32)).astype(x.dtype)


def _group_rmsnorm(x, w, groups):
    shp = x.shape
    xf = x.astype(jnp.float32).reshape(shp[:-1] + (groups, shp[-1] // groups))
    y = xf * lax.rsqrt(jnp.mean(xf * xf, axis=-1, keepdims=True) + EPS)
    return y.reshape(shp) * w.astype(jnp.float32)


def _causal_dwconv(x, buf, w, b):
    k = w.shape[0]
    L = x.shape[1]
    xp = jnp.concatenate([buf.astype(x.dtype), x], axis=1)
    y = xp[:, 0:L] * w[0] + b
    for i in range(1, k):
        y = y + xp[:, i:i + L] * w[i]
    return y, xp[:, L:]


def _ssd_scan(x, dt, a, bm, cm, h0, block):
    bsz, L = x.shape[0], x.shape[1]
    nc = L // block
    G, E, P, N = SSD_GROUPS, SSD_HEADS_PER_GROUP, SSD_HEAD_DIM, D_STATE
    xc = x.reshape(bsz, nc, block, G, E, P)
    dtc = dt.reshape(bsz, nc, block, G, E)
    bc = bm.reshape(bsz, nc, block, G, N)
    cc = cm.reshape(bsz, nc, block, G, N)
    acs = jnp.cumsum(dtc * a.reshape(G, E), axis=2)
    xdt = xc * dtc[..., None]
    causal = jnp.tril(jnp.ones((block, block), dtype=bool))
    seg = acs[:, :, :, None] - acs[:, :, None, :]
    decay = jnp.exp(jnp.where(causal[:, :, None, None], seg, -jnp.inf))
    cb = jnp.einsum('bcign,bcjgn->bcijg', cc, bc)
    y_diag = jnp.einsum('bcijge,bcjgep->bcigep', cb[..., None] * decay, xdt)
    decay_end = jnp.exp(acs[:, :, -1:] - acs)
    states = jnp.einsum('bcjgn,bcjgep->bcgepn', bc, xdt * decay_end[..., None])
    chunk_decay = jnp.exp(acs[:, :, -1])

    def step(h, inp):
        s, d = inp
        return d[..., None, None] * h + s, h

    h_final, h_prev = lax.scan(step, h0.reshape(bsz, G, E, P, N),
                               (jnp.moveaxis(states, 1, 0), jnp.moveaxis(chunk_decay, 1, 0)))
    h_prev = jnp.moveaxis(h_prev, 0, 1)
    y_off = jnp.einsum('bcign,bcgepn->bcigep', cc, h_prev) * jnp.exp(acs)[..., None]
    y = (y_diag + y_off).reshape(bsz, L, SSD_HEADS, P)
    return y, h_final.reshape(bsz, SSD_HEADS, P, N)


def _spatial_gate(u, v_n, w_s, b_s):
    bsz, L, _ = v_n.shape
    blk = min(GMLP_CHUNK, L)
    nc = L // blk
    vc = v_n.reshape(bsz, nc, blk, GMLP_GROUPS, GMLP_GROUP_DIM)
    pos = jnp.arange(blk)
    mask = (pos[None, :] // CHUNK) <= (pos[:, None] // CHUNK)
    w = jnp.where(mask[None], w_s[:, :blk, :blk], 0)
    s = jnp.einsum('gij,bcjgd->bcigd', w, vc) + b_s[:, :blk].T[None, None, :, :, None]
    return u * s.reshape(bsz, L, D_GMLP)


def _trunk_layer(x, conv_buf, h0, ffn_buf, norm1_w, w_in, ssd_conv_w, ssd_conv_b, dt_bias, a_log,
                 ssd_d, ssd_norm_w, gmlp_norm_w, gmlp_w_s, gmlp_b_s, w_out, norm2_w, w_up,
                 ffn_conv_w, ffn_conv_b, w_down):
    bsz, L, _ = x.shape
    f32 = jnp.float32
    h = _rmsnorm(x, norm1_w)
    proj = jnp.einsum('bld,de->ble', h, w_in)
    s1 = D_SSD
    s2 = s1 + D_XBC
    s3 = s2 + SSD_HEADS
    s4 = s3 + D_GMLP
    z, xbc, dt_raw, u, v = proj[..., :s1], proj[..., s1:s2], proj[..., s2:s3], proj[..., s3:s4], proj[..., s4:]
    xbc, new_conv = _causal_dwconv(xbc, conv_buf, ssd_conv_w, ssd_conv_b)
    xbc = jax.nn.silu(xbc).astype(f32)
    xs = xbc[..., :D_SSD].reshape(bsz, L, SSD_HEADS, SSD_HEAD_DIM)
    bm = xbc[..., D_SSD:D_SSD + SSD_GROUPS * D_STATE].reshape(bsz, L, SSD_GROUPS, D_STATE)
    cm = xbc[..., D_SSD + SSD_GROUPS * D_STATE:].reshape(bsz, L, SSD_GROUPS, D_STATE)
    dt = jax.nn.softplus(dt_raw.astype(f32) + dt_bias.astype(f32))
    a = -jnp.exp(a_log.astype(f32))
    y, h_new = _ssd_scan(xs, dt, a, bm, cm, h0.astype(f32), min(CHUNK, L))
    y = y + ssd_d.astype(f32)[:, None] * xs
    y = y.reshape(bsz, L, D_SSD) * jax.nn.silu(z.astype(f32))
    y_ssd = _group_rmsnorm(y, ssd_norm_w, SSD_GROUPS).astype(x.dtype)
    u = jax.nn.gelu(u)
    v_n = _group_rmsnorm(jax.nn.gelu(v), gmlp_norm_w, GMLP_GROUPS).astype(x.dtype)
    y_gmlp = _spatial_gate(u, v_n, gmlp_w_s, gmlp_b_s).astype(x.dtype)
    mix = jnp.concatenate([y_ssd, y_gmlp], axis=-1)
    x = x + jnp.einsum('ble,ed->bld', mix, w_out)
    h = _rmsnorm(x, norm2_w)
    up = jnp.einsum('bld,df->blf', h, w_up)
    up, new_ffn = _causal_dwconv(up, ffn_buf, ffn_conv_w, ffn_conv_b)
    g, val = up[..., :D_FF], up[..., D_FF:]
    x = x + jnp.einsum('blf,fd->bld', jax.nn.silu(g) * val, w_down)
    return x, new_conv, h_new, new_ffn, v_n


def setup_inputs(seed: int = 0) -> dict:
    key = jax.random.key(seed)
    ks = jax.random.split(key, 24)
    f32 = jnp.float32
    nrm = lambda k, shp, s: jax.random.normal(k, shp, f32) * s
    dt0 = jnp.exp(jax.random.uniform(ks[8], (DEPTH, SSD_HEADS), f32, np.log(1e-3), np.log(1e-1)))
    return {
        'x_prompt': nrm(ks[0], (BATCH, SEQ, D_MODEL), 1.0),
        'x_sample': nrm(ks[1], (DEC_BATCH, DEC_SEQ, D_MODEL), 1.0),
        'state_ssd_conv': nrm(ks[2], (DEPTH, DEC_BATCH, SSD_CONV - 1, D_XBC), 1.0),
        'state_ssd': nrm(ks[3], (DEPTH, DEC_BATCH, SSD_HEADS, SSD_HEAD_DIM, D_STATE), 0.1),
        'state_ffn_conv': nrm(ks[4], (DEPTH, DEC_BATCH, FFN_CONV - 1, 2 * D_FF), 1.0),
        'norm1_w': 1.0 + nrm(ks[5], (DEPTH, D_MODEL), 0.02),
        'w_in': nrm(ks[6], (DEPTH, D_MODEL, D_IN), D_MODEL ** -0.5),
        'ssd_conv_w': nrm(ks[7], (DEPTH, SSD_CONV, D_XBC), 0.5),
        'ssd_conv_b': nrm(ks[9], (DEPTH, D_XBC), 0.02),
        'dt_bias': dt0 + jnp.log(-jnp.expm1(-dt0)),
        'a_log': jnp.log(jax.random.uniform(ks[10], (DEPTH, SSD_HEADS), f32, 1.0, 16.0)),
        'ssd_d': 1.0 + nrm(ks[11], (DEPTH, SSD_HEADS), 0.1),
        'ssd_norm_w': 1.0 + nrm(ks[12], (DEPTH, D_SSD), 0.02),
        'gmlp_norm_w': 1.0 + nrm(ks[13], (DEPTH, D_GMLP), 0.02),
        'gmlp_w_s': nrm(ks[14], (DEPTH, GMLP_GROUPS, GMLP_CHUNK, GMLP_CHUNK), GMLP_CHUNK ** -0.5),
        'gmlp_b_s': 1.0 + nrm(ks[15], (DEPTH, GMLP_GROUPS, GMLP_CHUNK), 0.1),
        'w_out': nrm(ks[16], (DEPTH, D_MIX, D_MODEL), D_MIX ** -0.5),
        'norm2_w': 1.0 + nrm(ks[17], (DEPTH, D_MODEL), 0.02),
        'w_up': nrm(ks[18], (DEPTH, D_MODEL, 2 * D_FF), D_MODEL ** -0.5),
        'ffn_conv_w': nrm(ks[19], (DEPTH, FFN_CONV, 2 * D_FF), 0.6),
        'ffn_conv_b': nrm(ks[20], (DEPTH, 2 * D_FF), 0.02),
        'w_down': nrm(ks[21], (DEPTH, D_FF, D_MODEL), D_FF ** -0.5),
        'final_norm_w': 1.0 + nrm(ks[22], (D_MODEL,), 0.02),
    }


def reference(x_prompt, x_sample, state_ssd_conv, state_ssd, state_ffn_conv, norm1_w, w_in, ssd_conv_w,
              ssd_conv_b, dt_bias, a_log, ssd_d, ssd_norm_w, gmlp_norm_w, gmlp_w_s, gmlp_b_s, w_out,
              norm2_w, w_up, ffn_conv_w, ffn_conv_b, w_down, final_norm_w):
    bp = x_prompt.shape[0]
    yp, ys = x_prompt, x_sample
    p_conv, p_ssd, p_ffn = [], [], []
    s_conv, s_ssd, s_ffn, s_v = [], [], [], []
    for l in range(DEPTH):
        lw = (norm1_w[l], w_in[l], ssd_conv_w[l], ssd_conv_b[l], dt_bias[l], a_log[l], ssd_d[l],
              ssd_norm_w[l], gmlp_norm_w[l], gmlp_w_s[l], gmlp_b_s[l], w_out[l], norm2_w[l], w_up[l],
              ffn_conv_w[l], ffn_conv_b[l], w_down[l])
        yp, c, hs, f, _ = _trunk_layer(
            yp,
            jnp.zeros((bp, SSD_CONV - 1, D_XBC), yp.dtype),
            jnp.zeros((bp, SSD_HEADS, SSD_HEAD_DIM, D_STATE), jnp.float32),
            jnp.zeros((bp, FFN_CONV - 1, 2 * D_FF), yp.dtype),
            *lw)
        p_conv.append(c)
        p_ssd.append(hs)
        p_ffn.append(f)
        ys, c, hs, f, vn = _trunk_layer(ys, state_ssd_conv[l], state_ssd[l], state_ffn_conv[l], *lw)
        s_conv.append(c)
        s_ssd.append(hs)
        s_ffn.append(f)
        s_v.append(vn)
    yp = _rmsnorm(yp, final_norm_w)
    ys = _rmsnorm(ys, final_norm_w)
    return (yp, ys, jnp.stack(p_conv), jnp.stack(p_ssd), jnp.stack(p_ffn),
            jnp.stack(s_conv), jnp.stack(s_ssd), jnp.stack(s_ffn), jnp.stack(s_v))
```

```cpp
#include <hip/hip_runtime.h>
#include <hip/hip_cooperative_groups.h>
#include <cstdio>
namespace cg = cooperative_groups;

#define LAS __attribute__((address_space(3)))
typedef unsigned short bf16_t;
typedef short bf16x8 __attribute__((ext_vector_type(8)));
typedef float f32x4 __attribute__((ext_vector_type(4)));
typedef unsigned u32x4 __attribute__((ext_vector_type(4)));
typedef unsigned u32x2 __attribute__((ext_vector_type(2)));

constexpr int TP = 8192, TS = 512, T = 8704;
constexpr int DM = 2048, NPROJ = 10240, NINP = 10496, DIN = 10272;
constexpr int DMIX = 4096, DFF = 5632, DUP = 11264;
constexpr float EPS = 1e-6f;
constexpr size_t WS_WIN = 0;
constexpr size_t WS_WOUT = WS_WIN + (size_t)NINP * DM * 2;
constexpr size_t WS_WUP = WS_WOUT + (size_t)DM * DMIX * 2;
constexpr size_t WS_WDN = WS_WUP + (size_t)DUP * DM * 2;
constexpr size_t WS_X = WS_WDN + (size_t)DM * DFF * 2;
constexpr size_t WS_H = WS_X + (size_t)T * DM * 4;
constexpr size_t WS_PROJ = WS_H + (size_t)T * DM * 2;
constexpr size_t WS_MIX = WS_PROJ + (size_t)T * DUP * 2;
constexpr size_t WS_DT = WS_MIX + (size_t)T * DFF * 2;
constexpr size_t WS_SSQ = WS_DT + (size_t)T * 32 * 4;
constexpr size_t WS_END = WS_SSQ + (size_t)T * 32 * 4;
constexpr size_t O_YP = 0, O_PCONV = 17825792, O_PSSD = 17924096, O_PFFN = 20021248, O_SCONV = 20201472, O_SSSD = 20987904, O_SFFN = 37765120, O_SV = 39206912;
constexpr int LDS_BYTES = 131072;

struct Params { const float* in[23]; float* out; unsigned char* ws; };
typedef const unsigned char __attribute__((address_space(4)))* kaptr_t;
#define KA_INIT kaptr_t ka_ = (kaptr_t)__builtin_amdgcn_kernarg_segment_ptr(); asm volatile("" : "+s"(ka_))
#define PIN(i) (*(const float* const __attribute__((address_space(4)))*)(ka_ + 8 * (i)))
#define POUT ((float*)PIN(23))
#define PWS ((unsigned char*)PIN(24))
#define TID_INIT int tid = threadIdx.x; asm volatile("" : "+v"(tid))
enum { I_XP = 0, I_XS, I_SCONV, I_SSSD, I_SFFN, I_N1W, I_WIN, I_CW, I_CB, I_DTB, I_ALOG, I_D, I_SNW, I_GNW, I_GWS, I_GBS, I_WOUT, I_N2W, I_WUP, I_FCW, I_FCB, I_WDN, I_FNW };

__device__ __forceinline__ float bf2f(bf16_t b) { return __uint_as_float(((unsigned)b) << 16); }
__device__ __forceinline__ unsigned pk2(float lo, float hi) { unsigned r; asm volatile("v_cvt_pk_bf16_f32 %0, %1, %2" : "=v"(r) : "v"(lo), "v"(hi)); return r; }
__device__ __forceinline__ bf16_t f2bf(float f) { return (bf16_t)(pk2(f, 0.f) & 0xffffu); }
__device__ __forceinline__ void unpack8(u32x4 v, float* f) {
#pragma unroll
    for (int i = 0; i < 4; ++i) { f[2 * i] = __uint_as_float(v[i] << 16); f[2 * i + 1] = __uint_as_float(v[i] & 0xffff0000u); }
}
__device__ __forceinline__ u32x4 pack8(const float* f) { u32x4 r; r.x = pk2(f[0], f[1]); r.y = pk2(f[2], f[3]); r.z = pk2(f[4], f[5]); r.w = pk2(f[6], f[7]); return r; }
__device__ __forceinline__ float silu_f(float x) { return x / (1.0f + __expf(-x)); }
__device__ __forceinline__ float gelu_f(float x) { const float t = 1.5957691216057308f * (x + 0.044715f * x * x * x); return x / (1.0f + __expf(-t)); }
__device__ __forceinline__ float softplus_f(float x) { return x > 20.f ? x : __logf(1.0f + __expf(x)); }
__device__ __forceinline__ float wave_sum(float v) {
#pragma unroll
    for (int o = 32; o > 0; o >>= 1) v += __shfl_xor(v, o);
    return v;
}

namespace pg8 {
constexpr int BM = 256, BK = 64, HALF = 128, HTB = HALF * BK * 2, NXCD = 8, WGM = 8;
__device__ __forceinline__ int lds_byte(int r, int c) { const int st = (r >> 4) * 2 + (c >> 5), rr = r & 15, cc = c & 31, ob = rr * 64 + cc * 2; return st * 1024 + (ob ^ (((ob >> 9) & 1) << 5)); }
__device__ __forceinline__ void stage_rc(int b, int& R, int& C) { const int st = b / 1024, sb = b % 1024, swz = sb ^ (((sb >> 9) & 1) << 5); R = (st >> 1) * 16 + swz / 64; C = (st & 1) * 32 + (swz % 64) / 2; }
__device__ __forceinline__ int perm32(int rho) { const int n = rho >> 4, i = rho & 15; return 8 * (i >> 2) + 4 * n + (i & 3); }
struct Unit { int pm, pn; };
struct Gemm { const bf16_t* A; const bf16_t* Bt; int M, N, K; };
struct StaticOrder {
    int nM, nN, nwg, G, c;
    __device__ void init(int M, int N, int G_, int c_) { nM = M / BM; nN = N / BM; nwg = nM * nN; G = G_; c = c_; }
    __device__ bool next(int i, Unit& u) const {
        const long L = (long)i * G + c; if (L >= nwg) return false;
        int wgid = (int)L; { const int q = nwg / NXCD, r = nwg % NXCD, xcd = wgid % NXCD, off = wgid / NXCD; wgid = (xcd < r ? xcd * (q + 1) : r * (q + 1) + (xcd - r) * q) + off; }
        const int nig = WGM * nN, gid = wgid / nig, fm = gid * WGM, gsz = (nM - fm) < WGM ? (nM - fm) : WGM;
        u.pm = fm + ((wgid % nig) % gsz); u.pn = (wgid % nig) / gsz; return true;
    }
};
template <class Epi>
__device__ __forceinline__ void gemm_phase(LAS unsigned char* lds, const Gemm g, const StaticOrder& S, const Epi& E) {
    int tid = threadIdx.x; asm volatile("" : "+v"(tid));
    const int wid = __builtin_amdgcn_readfirstlane(tid >> 6), lane = tid & 63, wr = wid >> 2, wc = wid & 3, fr = lane & 15, fq = lane >> 4;
    int K = __builtin_amdgcn_readfirstlane(g.K); asm volatile("" : "+s"(K));
    const int nt = K / BK;
    unsigned voffA[2], voffB[2];
#pragma unroll
    for (int i = 0; i < 2; ++i) { int R, C; stage_rc(tid * 16 + i * 8192, R, C); const int Rb = (R & ~31) + perm32(R & 31);
        voffA[i] = (unsigned)(R * K + C) * 2u; voffB[i] = (unsigned)(Rb * K + C) * 2u; }
    const size_t kstep = (size_t)(BK * 2);
    const size_t hstep = (size_t)HALF * K * 2;
    const size_t tstep = 2 * hstep;
    const unsigned ldsw = (unsigned)wid * 1024u;
    const int aoff = lds_byte(wr * 64 + fr, fq * 8), boff = lds_byte(wc * 32 + fr, fq * 8);
#define PG8_SA(b, h) (((b) * 2 + (h)) * HTB)
#define PG8_SB(b, h) ((4 + (b) * 2 + (h)) * HTB)
#define PG8_STAGE(bufoff, gbase, voff) do { _Pragma("unroll") for (int _i = 0; _i < 2; ++_i) \
        __builtin_amdgcn_global_load_lds((const unsigned*)((const char*)(gbase) + (voff)[_i]), (LAS unsigned*)(lds + (bufoff) + ldsw + _i * 8192), 16, 0, 0); } while (0)
#define PG8_LDA(dst, b, h) do { _Pragma("unroll") for (int m = 0; m < 4; ++m) _Pragma("unroll") for (int k = 0; k < 2; ++k) dst[m][k] = *(const LAS bf16x8*)(lds + PG8_SA(b, h) + aoff + m * 2048 + k * 1024); } while (0)
#define PG8_LDB(dst, b, h) do { _Pragma("unroll") for (int n = 0; n < 2; ++n) _Pragma("unroll") for (int k = 0; k < 2; ++k) dst[n][k] = *(const LAS bf16x8*)(lds + PG8_SB(b, h) + boff + n * 2048 + k * 1024); } while (0)
#define PG8_MMA(ai, bj, At, Bt) do { __builtin_amdgcn_s_setprio(1); _Pragma("unroll") for (int m = 0; m < 4; ++m) _Pragma("unroll") for (int n = 0; n < 2; ++n) _Pragma("unroll") for (int k = 0; k < 2; ++k) \
        acc[ai][bj][m][n] = __builtin_amdgcn_mfma_f32_16x16x32_bf16(Bt[n][k], At[m][k], acc[ai][bj][m][n], 0, 0, 0); __builtin_amdgcn_s_setprio(0); } while (0)
#define PG8_WAIT_V(n) asm volatile("s_waitcnt vmcnt(" #n ")" ::: "memory")
#define PG8_WAIT_L(n) asm volatile("s_waitcnt lgkmcnt(" #n ")" ::: "memory")
#define PG8_BAR __builtin_amdgcn_s_barrier()
#define PG8_SCHED __builtin_amdgcn_sched_barrier(0)
    Unit cur, nxt; int ui = 0;
    if (!S.next(0, cur)) return;
    f32x4 acc[2][2][4][2];
#pragma unroll
    for (int a = 0; a < 2; ++a)
#pragma unroll
        for (int b = 0; b < 2; ++b)
#pragma unroll
            for (int m = 0; m < 4; ++m)
#pragma unroll
                for (int n = 0; n < 2; ++n) acc[a][b][m][n] = (f32x4){0.f, 0.f, 0.f, 0.f};
    bf16x8 At[4][2], B0[2][2], B1[2][2];
    const char* cA = (const char*)g.A + (size_t)cur.pm * tstep; const char* cB = (const char*)g.Bt + (size_t)cur.pn * tstep;
    PG8_STAGE(PG8_SB(0, 0), cB, voffB); PG8_STAGE(PG8_SA(0, 0), cA, voffA); PG8_STAGE(PG8_SB(0, 1), cB + hstep, voffB); PG8_STAGE(PG8_SA(0, 1), cA + hstep, voffA);
    if (wr == 1) PG8_BAR;
    PG8_WAIT_V(4); PG8_BAR;
    PG8_STAGE(PG8_SB(1, 0), cB + kstep, voffB); PG8_STAGE(PG8_SA(1, 0), cA + kstep, voffA); PG8_STAGE(PG8_SB(1, 1), cB + hstep + kstep, voffB);
    PG8_WAIT_V(6); PG8_BAR;
    for (;;) {
        const bool has_next = S.next(ui + 1, nxt);
        const char* nA = has_next ? (const char*)g.A + (size_t)nxt.pm * tstep : cA; const char* nB = has_next ? (const char*)g.Bt + (size_t)nxt.pn * tstep : cB;
        for (int t = 0; t < nt; t += 2) {
            const bool last = (t == nt - 2);
            const char* a1 = cA + (size_t)(t + 1) * kstep;
            const char* a2 = last ? nA : cA + (size_t)(t + 2) * kstep; const char* b2 = last ? nB : cB + (size_t)(t + 2) * kstep;
            const char* a3 = a2 + kstep; const char* b3 = b2 + kstep;
            PG8_LDB(B0, 0, 0); PG8_SCHED; PG8_LDA(At, 0, 0); PG8_STAGE(PG8_SA(1, 1), a1 + hstep, voffA);
            PG8_WAIT_L(8); PG8_BAR; PG8_WAIT_L(0); PG8_MMA(0, 0, At, B0); PG8_BAR; PG8_SCHED;
            PG8_LDB(B1, 0, 1); PG8_STAGE(PG8_SB(0, 0), b2, voffB);
            PG8_BAR; PG8_WAIT_L(0); PG8_MMA(0, 1, At, B1); PG8_BAR;
            PG8_LDA(At, 0, 1); PG8_STAGE(PG8_SA(0, 0), a2, voffA);
            PG8_BAR; PG8_WAIT_L(0); PG8_MMA(1, 0, At, B0); PG8_BAR; PG8_SCHED;
            PG8_STAGE(PG8_SB(0, 1), b2 + hstep, voffB);
            PG8_WAIT_V(6); PG8_BAR; PG8_MMA(1, 1, At, B1); PG8_BAR;
            PG8_LDB(B0, 1, 0); PG8_SCHED; PG8_LDA(At, 1, 0); PG8_STAGE(PG8_SA(0, 1), a2 + hstep, voffA);
            PG8_WAIT_L(8); PG8_BAR; PG8_WAIT_L(0); PG8_MMA(0, 0, At, B0); PG8_BAR; PG8_SCHED;
            PG8_LDB(B1, 1, 1); PG8_STAGE(PG8_SB(1, 0), b3, voffB);
            PG8_BAR; PG8_WAIT_L(0); PG8_MMA(0, 1, At, B1); PG8_BAR;
            PG8_LDA(At, 1, 1); PG8_STAGE(PG8_SA(1, 0), a3, voffA);
            PG8_BAR; PG8_WAIT_L(0); PG8_MMA(1, 0, At, B0); PG8_BAR; PG8_SCHED;
            PG8_STAGE(PG8_SB(1, 1), b3 + hstep, voffB);
            PG8_WAIT_V(6); PG8_BAR; PG8_MMA(1, 1, At, B1); PG8_BAR;
        }
        E(acc, cur, wr, wc, fr, fq);
        if (!has_next) break;
#pragma unroll
        for (int a = 0; a < 2; ++a)
#pragma unroll
            for (int b = 0; b < 2; ++b)
#pragma unroll
                for (int m = 0; m < 4; ++m)
#pragma unroll
                    for (int n = 0; n < 2; ++n) acc[a][b][m][n] = (f32x4){0.f, 0.f, 0.f, 0.f};
        cur = nxt; cA = nA; cB = nB; ++ui;
    }
    PG8_WAIT_V(0);
    if (wr == 0) PG8_BAR;
    PG8_BAR;
#undef PG8_SA
#undef PG8_SB
#undef PG8_STAGE
#undef PG8_LDA
#undef PG8_LDB
#undef PG8_MMA
#undef PG8_WAIT_V
#undef PG8_WAIT_L
#undef PG8_BAR
#undef PG8_SCHED
}
}
using pg8::Unit;

struct EpiG1 {
    bf16_t* P; float* DT; const float* dtb;
    __device__ __forceinline__ void operator()(const f32x4 (&acc)[2][2][4][2], const Unit& u, int wr, int wc, int fr, int fq) const {
        const int row0 = u.pm * 256 + wr * 64 + fr;
        if (u.pn < 40) {
            const int mode = u.pn < 8 ? 1 : (u.pn < 24 ? 0 : 2);
            const int col0 = u.pn * 256 + wc * 32 + 8 * fq;
#pragma unroll
            for (int ai = 0; ai < 2; ++ai)
#pragma unroll
                for (int m = 0; m < 4; ++m) { bf16_t* rowp = P + (size_t)(row0 + ai * 128 + m * 16) * NPROJ + col0;
#pragma unroll
                    for (int bj = 0; bj < 2; ++bj) { float v[8];
#pragma unroll
                        for (int j = 0; j < 4; ++j) { v[j] = acc[ai][bj][m][0][j]; v[4 + j] = acc[ai][bj][m][1][j]; }
                        if (mode == 1) {
#pragma unroll
                            for (int j = 0; j < 8; ++j) v[j] = silu_f(v[j]); }
                        else if (mode == 2) {
#pragma unroll
                            for (int j = 0; j < 8; ++j) v[j] = gelu_f(v[j]); }
                        *(u32x4*)(rowp + bj * 128) = pack8(v); } }
        } else if (wc == 0) {
#pragma unroll
            for (int ai = 0; ai < 2; ++ai)
#pragma unroll
                for (int m = 0; m < 4; ++m) { float* rowp = DT + (size_t)(row0 + ai * 128 + m * 16) * 32 + 8 * fq;
#pragma unroll
                    for (int n = 0; n < 2; ++n) { f32x4 o;
#pragma unroll
                        for (int j = 0; j < 4; ++j) o[j] = softplus_f(acc[ai][0][m][n][j] + dtb[8 * fq + 4 * n + j]);
                        *(f32x4*)(rowp + 4 * n) = o; } }
        }
    }
};
struct EpiX {
    float* X;
    __device__ __forceinline__ void operator()(const f32x4 (&acc)[2][2][4][2], const Unit& u, int wr, int wc, int fr, int fq) const {
        const int row0 = u.pm * 256 + wr * 64 + fr, col0 = u.pn * 256 + wc * 32 + 8 * fq;
#pragma unroll
        for (int ai = 0; ai < 2; ++ai)
#pragma unroll
            for (int m = 0; m < 4; ++m) { float* rowp = X + (size_t)(row0 + ai * 128 + m * 16) * DM + col0;
#pragma unroll
                for (int bj = 0; bj < 2; ++bj) { f32x4* q = (f32x4*)(rowp + bj * 128); f32x4 a = q[0], b = q[1]; q[0] = a + acc[ai][bj][m][0]; q[1] = b + acc[ai][bj][m][1]; } }
    }
};
struct EpiUp {
    bf16_t* U;
    __device__ __forceinline__ void operator()(const f32x4 (&acc)[2][2][4][2], const Unit& u, int wr, int wc, int fr, int fq) const {
        const int row0 = u.pm * 256 + wr * 64 + fr, col0 = u.pn * 256 + wc * 32 + 8 * fq;
#pragma unroll
        for (int ai = 0; ai < 2; ++ai)
#pragma unroll
            for (int m = 0; m < 4; ++m) { bf16_t* rowp = U + (size_t)(row0 + ai * 128 + m * 16) * DUP + col0;
#pragma unroll
                for (int bj = 0; bj < 2; ++bj) { u32x4 w; w.x = pk2(acc[ai][bj][m][0][0], acc[ai][bj][m][0][1]); w.y = pk2(acc[ai][bj][m][0][2], acc[ai][bj][m][0][3]);
                    w.z = pk2(acc[ai][bj][m][1][0], acc[ai][bj][m][1][1]); w.w = pk2(acc[ai][bj][m][1][2], acc[ai][bj][m][1][3]); *(u32x4*)(rowp + bj * 128) = w; } }
    }
};

__device__ __forceinline__ int map_col(int n, int mode) {
    if (mode == 0) return n;
    if (n < 6144) return n; if (n < 10240) return n + 32; if (n < 10272) return n - 10240 + 6144; return -1;
}
__device__ __forceinline__ void convert_w(const float* __restrict__ src, int K, int Nsrc, bf16_t* __restrict__ dst, int Ndst, int mode, unsigned char* shm) {
    float* tile = (float*)shm;
    TID_INIT;
    const int ntn = Ndst / 64, ntk = K / 64, ntile = ntn * ntk;
    const int tkk = tid >> 4, tn4 = tid & 15, wn = tid >> 3, wk8 = tid & 7;
    for (int t = blockIdx.x; t < ntile; t += gridDim.x) {
        const int tn = t % ntn, tk = t / ntn, n0 = tn * 64, k0 = tk * 64;
        const int sc = map_col(n0 + 4 * tn4, mode);
#pragma unroll
        for (int i = 0; i < 2; ++i) { const int k = tkk + 32 * i; f32x4 v = (f32x4){0.f, 0.f, 0.f, 0.f};
            if (sc >= 0) v = *(const f32x4*)(src + (size_t)(k0 + k) * Nsrc + sc);
#pragma unroll
            for (int j = 0; j < 4; ++j) tile[k * 65 + 4 * tn4 + j] = v[j]; }
        __syncthreads();
        float f[8];
#pragma unroll
        for (int j = 0; j < 8; ++j) f[j] = tile[(8 * wk8 + j) * 65 + wn];
        *(u32x4*)(dst + (size_t)(n0 + wn) * K + k0 + 8 * wk8) = pack8(f);
        __syncthreads();
    }
}

template <int MODE>
__device__ __forceinline__ void phase_norm(const Params& p, const float* __restrict__ w) {
    KA_INIT; TID_INIT;
    const int lane = tid & 63, gw = blockIdx.x * 8 + (tid >> 6), nw = gridDim.x * 8;
    float* X = (float*)(PWS + WS_X); bf16_t* H = (bf16_t*)(PWS + WS_H);
    for (int row = gw; row < T; row += nw) {
        const float* src = MODE == 0 ? (row < TP ? PIN(I_XP) + (size_t)row * DM : PIN(I_XS) + (size_t)(row - TP) * DM) : X + (size_t)row * DM;
        f32x4 v[8]; float ss = 0.f;
#pragma unroll
        for (int i = 0; i < 8; ++i) { v[i] = *(const f32x4*)(src + i * 256 + lane * 4); ss += v[i][0] * v[i][0] + v[i][1] * v[i][1] + v[i][2] * v[i][2] + v[i][3] * v[i][3]; }
        ss = wave_sum(ss);
        const float rstd = rsqrtf(ss * (1.0f / DM) + EPS);
#pragma unroll
        for (int i = 0; i < 8; ++i) { const int c = i * 256 + lane * 4; const f32x4 wv = *(const f32x4*)(w + c);
            if (MODE == 0) *(f32x4*)(X + (size_t)row * DM + c) = v[i];
            f32x4 o = v[i] * rstd * wv;
            if (MODE == 2) *(f32x4*)(POUT + O_YP + (size_t)row * DM + c) = o;
            else { u32x2 pk; pk.x = pk2(o[0], o[1]); pk.y = pk2(o[2], o[3]); *(u32x2*)(H + (size_t)row * DM + c) = pk; } }
    }
}

__device__ __forceinline__ bf16x8 ldfrag(const bf16_t* base, int ld, int row0, int k0, int lane) { return *(const bf16x8*)(base + (row0 + (lane & 15)) * ld + k0 + (lane >> 4) * 8); }
__device__ __forceinline__ f32x4 mma16(bf16x8 x, bf16x8 y, f32x4 c) { return __builtin_amdgcn_mfma_f32_16x16x32_bf16(x, y, c, 0, 0, 0); }

__device__ __forceinline__ void ssd_chain(const Params& p, int l, bool sample, int seq, int hd, unsigned char* shm) {
    KA_INIT; TID_INIT;
    const int lane = tid & 63, w = tid >> 6, r = lane & 15, q = lane >> 4;
    bf16_t* Cs = (bf16_t*)(shm + 0);
    bf16_t* Bs = (bf16_t*)(shm + 17408);
    bf16_t* BT = (bf16_t*)(shm + 34816);
    bf16_t* XT = (bf16_t*)(shm + 53248);
    bf16_t* Ms = (bf16_t*)(shm + 62464);
    bf16_t* Hs = (bf16_t*)(shm + 71680);
    float* dts = (float*)(shm + 89088);
    float* acss = dts + 64; float* scs = acss + 64; float* part = scs + 64;
    const bf16_t* proj = (const bf16_t*)(PWS + WS_PROJ); const float* DT = (const float*)(PWS + WS_DT);
    bf16_t* mix = (bf16_t*)(PWS + WS_MIX); float* ssq = (float*)(PWS + WS_SSQ);
    const int g = hd >> 2, nchunk = sample ? 1 : 32, nvalid = sample ? 16 : 64;
    const int rowbase = sample ? TP + seq * 16 : seq * 2048;
    const float Dh = PIN(I_D)[l * 32 + hd];
    const float a_neg = -__expf(PIN(I_ALOG)[l * 32 + hd]);
    const float* cw = PIN(I_CW) + (size_t)l * 4 * 4096; const float* cb = PIN(I_CB) + (size_t)l * 4096;
    const int ib = w >> 1, pb0 = 2 * (w & 1), pbS = w >> 1, nb0 = 4 * (w & 1);
    f32x4 hacc[4];
    {
        const size_t hoff = ((size_t)((l * 32 + seq) * 32 + hd) * 64 + 16 * pbS + r) * 128;
#pragma unroll
        for (int tt = 0; tt < 4; ++tt) {
            f32x4 h = (f32x4){0.f, 0.f, 0.f, 0.f};
            if (sample) h = *(const f32x4*)(PIN(I_SSSD) + hoff + 16 * (nb0 + tt) + 4 * q);
            hacc[tt] = h;
            u32x2 pk; pk.x = pk2(h[0], h[1]); pk.y = pk2(h[2], h[3]);
            *(u32x2*)(Hs + (16 * pbS + r) * 136 + 16 * (nb0 + tt) + 4 * q) = pk;
        }
    }
    for (int c = 0; c < nchunk; ++c) {
        const int R0 = rowbase + c * 64;
        if (w < 5) {
            const int t = lane;
#pragma unroll 1
            for (int it = 0; it < 8; ++it) {
                const int cv = w * 8 + it;
                const int ch = cv < 8 ? hd * 64 + cv * 8 : (cv < 24 ? 2048 + g * 128 + (cv - 8) * 8 : 3072 + g * 128 + (cv - 24) * 8);
                float raw[4][8];
#pragma unroll
                for (int k = 0; k < 4; ++k) {
                    const int tt = t - 3 + k;
#pragma unroll
                    for (int j = 0; j < 8; ++j) raw[k][j] = 0.f;
                    if (tt >= 0) { if (tt < nvalid) unpack8(*(const u32x4*)(proj + (size_t)(R0 + tt) * NPROJ + 2048 + ch), raw[k]); }
                    else if (sample) { const float* sp = PIN(I_SCONV) + ((size_t)(l * 32 + seq) * 3 + (3 + tt)) * 4096 + ch; const f32x4 a = *(const f32x4*)sp, b = *(const f32x4*)(sp + 4);
#pragma unroll
                        for (int j = 0; j < 4; ++j) { raw[k][j] = a[j]; raw[k][4 + j] = b[j]; } }
                    else if (c > 0) unpack8(*(const u32x4*)(proj + (size_t)(R0 + tt) * NPROJ + 2048 + ch), raw[k]);
                }
                float v[8];
#pragma unroll
                for (int j = 0; j < 8; ++j) {
                    float s = cb[ch + j] + cw[ch + j] * raw[0][j] + cw[4096 + ch + j] * raw[1][j] + cw[2 * 4096 + ch + j] * raw[2][j] + cw[3 * 4096 + ch + j] * raw[3][j];
                    v[j] = t < nvalid ? silu_f(s) : 0.f;
                }
                if (c == nchunk - 1 && t >= nvalid - 3 && t < nvalid && (cv < 8 || (hd & 3) == 0)) {
                    float* op = POUT + (sample ? O_SCONV + ((size_t)(l * 32 + seq) * 3 + (t - (nvalid - 3))) * 4096 : O_PCONV + ((size_t)(l * 4 + seq) * 3 + (t - (nvalid - 3))) * 4096) + ch;
                    *(f32x4*)op = (f32x4){raw[3][0], raw[3][1], raw[3][2], raw[3][3]}; *(f32x4*)(op + 4) = (f32x4){raw[3][4], raw[3][5], raw[3][6], raw[3][7]};
                }
                if (cv < 8) {
#pragma unroll
                    for (int j = 0; j < 8; ++j) XT[(cv * 8 + j) * 72 + t] = f2bf(v[j]);
                } else if (cv < 24) {
                    const int cc = (cv - 8) * 8; const u32x4 pk = pack8(v);
                    *(u32x4*)(Bs + t * 136 + cc) = pk;
#pragma unroll
                    for (int j = 0; j < 8; ++j) BT[(cc + j) * 72 + t] = (bf16_t)((j & 1) ? (pk[j >> 1] >> 16) : (pk[j >> 1] & 0xffffu));
                } else {
                    const int cc = (cv - 24) * 8;
                    *(u32x4*)(Cs + t * 136 + cc) = pack8(v);
                }
            }
        } else if (w == 7) {
            const float dtv = lane < nvalid ? DT[(size_t)(R0 + lane) * 32 + hd] : 0.f;
            float s = dtv * a_neg;
#pragma unroll
            for (int o = 1; o < 64; o <<= 1) { const float tmp = __shfl_up(s, o); if (lane >= o) s += tmp; }
            const float lastv = __shfl(s, 63);
            dts[lane] = dtv; acss[lane] = s; scs[lane] = dtv * __expf(lastv - s);
        }
        __syncthreads();
        f32x4 yo[2] = {(f32x4){0.f, 0.f, 0.f, 0.f}, (f32x4){0.f, 0.f, 0.f, 0.f}};
#pragma unroll
        for (int ks = 0; ks < 4; ++ks) { const bf16x8 yf = ldfrag(Cs, 136, 16 * ib, 32 * ks, lane);
#pragma unroll
            for (int tt = 0; tt < 2; ++tt) yo[tt] = mma16(ldfrag(Hs, 136, 16 * (pb0 + tt), 32 * ks, lane), yf, yo[tt]); }
        {
            const int i = 16 * ib + r; const float ai = acss[i];
#pragma unroll
            for (int tt = 0; tt < 2; ++tt) { const int jb = pb0 + tt; f32x4 gg = (f32x4){0.f, 0.f, 0.f, 0.f};
                if (jb <= ib) {
#pragma unroll
                    for (int ks = 0; ks < 4; ++ks) gg = mma16(ldfrag(Bs, 136, 16 * jb, 32 * ks, lane), ldfrag(Cs, 136, 16 * ib, 32 * ks, lane), gg); }
                float mv[4];
#pragma unroll
                for (int jj = 0; jj < 4; ++jj) { const int j = 16 * jb + 4 * q + jj; mv[jj] = (j <= i) ? gg[jj] * __expf(fminf(ai - acss[j], 0.f)) * dts[j] : 0.f; }
                u32x2 pk; pk.x = pk2(mv[0], mv[1]); pk.y = pk2(mv[2], mv[3]);
                *(u32x2*)(Ms + i * 72 + 16 * jb + 4 * q) = pk; }
        }
        {
            const float cd = __expf(acss[63]);
#pragma unroll
            for (int tt = 0; tt < 4; ++tt) hacc[tt] *= cd;
#pragma unroll
            for (int ks = 0; ks < 2; ++ks) {
                const bf16x8 xr = ldfrag(XT, 72, 16 * pbS, 32 * ks, lane);
                float xf[8]; u32x4 xu; xu.x = (unsigned)(unsigned short)xr[0] | ((unsigned)(unsigned short)xr[1] << 16); xu.y = (unsigned)(unsigned short)xr[2] | ((unsigned)(unsigned short)xr[3] << 16);
                xu.z = (unsigned)(unsigned short)xr[4] | ((unsigned)(unsigned short)xr[5] << 16); xu.w = (unsigned)(unsigned short)xr[6] | ((unsigned)(unsigned short)xr[7] << 16);
                unpack8(xu, xf);
#pragma unroll
                for (int e = 0; e < 8; ++e) xf[e] *= scs[32 * ks + 8 * q + e];
                const u32x4 xs = pack8(xf); bf16x8 yf;
#pragma unroll
                for (int e = 0; e < 4; ++e) { yf[2 * e] = (short)(xs[e] & 0xffffu); yf[2 * e + 1] = (short)(xs[e] >> 16); }
#pragma unroll
                for (int tt = 0; tt < 4; ++tt) hacc[tt] = mma16(ldfrag(BT, 72, 16 * (nb0 + tt), 32 * ks, lane), yf, hacc[tt]);
            }
        }
        __syncthreads();
        {
            f32x4 yd[2] = {(f32x4){0.f, 0.f, 0.f, 0.f}, (f32x4){0.f, 0.f, 0.f, 0.f}};
#pragma unroll
            for (int ks = 0; ks < 2; ++ks) if (32 * ks <= 16 * ib + 15) { const bf16x8 yf = ldfrag(Ms, 72, 16 * ib, 32 * ks, lane);
#pragma unroll
                for (int tt = 0; tt < 2; ++tt) yd[tt] = mma16(ldfrag(XT, 72, 16 * (pb0 + tt), 32 * ks, lane), yf, yd[tt]); }
            const int i = 16 * ib + r; const float ea = __expf(acss[i]); const bool valid = i < nvalid; const size_t row = (size_t)(R0 + i);
            float ss = 0.f;
#pragma unroll
            for (int tt = 0; tt < 2; ++tt) { const int pc = 16 * (pb0 + tt) + 4 * q;
                u32x2 gz = (u32x2){0u, 0u}; if (valid) gz = *(const u32x2*)(proj + row * NPROJ + hd * 64 + pc);
                const float gate[4] = {__uint_as_float(gz.x << 16), __uint_as_float(gz.x & 0xffff0000u), __uint_as_float(gz.y << 16), __uint_as_float(gz.y & 0xffff0000u)};
                float y[4];
#pragma unroll
                for (int jj = 0; jj < 4; ++jj) { const float xv = bf2f(XT[(pc + jj) * 72 + i]); y[jj] = (yd[tt][jj] + ea * yo[tt][jj] + Dh * xv) * gate[jj]; ss += y[jj] * y[jj]; }
                if (valid) { u32x2 pk; pk.x = pk2(y[0], y[1]); pk.y = pk2(y[2], y[3]); *(u32x2*)(mix + row * DMIX + hd * 64 + pc) = pk; } }
            ss += __shfl_xor(ss, 16); ss += __shfl_xor(ss, 32);
            if (q == 0) part[i * 2 + (w & 1)] = ss;
#pragma unroll
            for (int tt = 0; tt < 4; ++tt) { u32x2 pk; pk.x = pk2(hacc[tt][0], hacc[tt][1]); pk.y = pk2(hacc[tt][2], hacc[tt][3]); *(u32x2*)(Hs + (16 * pbS + r) * 136 + 16 * (nb0 + tt) + 4 * q) = pk; }
        }
        __syncthreads();
        if (tid < nvalid) ssq[(size_t)(R0 + tid) * 32 + hd] = part[2 * tid] + part[2 * tid + 1];
    }
    {
        float* op = POUT + (sample ? O_SSSD + ((size_t)((l * 32 + seq) * 32 + hd) * 64) * 128 : O_PSSD + ((size_t)((l * 4 + seq) * 32 + hd) * 64) * 128);
#pragma unroll
        for (int tt = 0; tt < 4; ++tt) *(f32x4*)(op + (size_t)(16 * pbS + r) * 128 + 16 * (nb0 + tt) + 4 * q) = hacc[tt];
    }
    __syncthreads();
}

__device__ __forceinline__ void gmlp_item(const Params& p, int l, bool sample, int idx, unsigned char* shm) {
    KA_INIT; TID_INIT;
    const int lane = tid & 63, w = tid >> 6, r = lane & 15, q = lane >> 4;
    bf16_t* Ws = (bf16_t*)shm;
    bf16_t* VT = (bf16_t*)(shm + 34816);
    float* rs = (float*)(shm + 104448);
    float* pp = rs + 128;
    const bf16_t* proj = (const bf16_t*)(PWS + WS_PROJ); bf16_t* mix = (bf16_t*)(PWS + WS_MIX);
    const int g = idx & 7, blk = idx >> 3, R0 = sample ? TP + blk * 128 : blk * 128;
    const float* wv = PIN(I_GNW) + (size_t)l * 2048 + g * 256;
#pragma unroll
    for (int hh = 0; hh < 2; ++hh) { const int j = hh * 64 + lane; float ss = 0.f;
#pragma unroll
        for (int cc = 0; cc < 4; ++cc) { const int cv = 4 * w + cc; const u32x4 raw = *(const u32x4*)(proj + (size_t)(R0 + j) * NPROJ + 8192 + g * 256 + 8 * cv);
            float f[8]; unpack8(raw, f);
#pragma unroll
            for (int e = 0; e < 8; ++e) { ss += f[e] * f[e]; VT[(8 * cv + e) * 136 + j] = (bf16_t)((e & 1) ? (raw[e >> 1] >> 16) : (raw[e >> 1] & 0xffffu)); } }
        pp[j * 8 + w] = ss; }
    __syncthreads();
    if (tid < 128) { float s = 0.f;
#pragma unroll
        for (int k = 0; k < 8; ++k) s += pp[tid * 8 + k];
        rs[tid] = rsqrtf(s * (1.0f / 256.f) + EPS); }
    __syncthreads();
    {
        const int i = tid >> 2, jq = (tid & 3) * 32;
        const float* wsrc = PIN(I_GWS) + (size_t)(l * 8 + g) * 128 * 128;
#pragma unroll
        for (int jv = 0; jv < 8; ++jv) { const int j = jq + 4 * jv; f32x4 w4 = (f32x4){0.f, 0.f, 0.f, 0.f};
            if (!sample) { if ((j >> 6) <= (i >> 6)) w4 = *(const f32x4*)(wsrc + i * 128 + j); }
            else { if ((j >> 4) == (i >> 4)) w4 = *(const f32x4*)(wsrc + (i & 15) * 128 + (j & 15)); }
            u32x2 pk; pk.x = pk2(w4[0] * rs[j], w4[1] * rs[j + 1]); pk.y = pk2(w4[2] * rs[j + 2], w4[3] * rs[j + 3]);
            *(u32x2*)(Ws + i * 136 + j) = pk; }
        if (sample) {
#pragma unroll 1
            for (int k = 0; k < 8; ++k) { const int cvv = tid & 31, j = (tid >> 5) + 16 * k; const u32x4 raw = *(const u32x4*)(proj + (size_t)(R0 + j) * NPROJ + 8192 + g * 256 + 8 * cvv);
                float f[8]; unpack8(raw, f); const float rj = rs[j]; const int s = blk * 8 + (j >> 4), t = j & 15;
                float* op = POUT + O_SV + ((size_t)((l * 32 + s) * 16 + t)) * 2048 + g * 256 + 8 * cvv;
                const f32x4 w0 = *(const f32x4*)(wv + 8 * cvv), w1 = *(const f32x4*)(wv + 8 * cvv + 4);
                *(f32x4*)op = (f32x4){f[0] * rj * w0[0], f[1] * rj * w0[1], f[2] * rj * w0[2], f[3] * rj * w0[3]};
                *(f32x4*)(op + 4) = (f32x4){f[4] * rj * w1[0], f[5] * rj * w1[1], f[6] * rj * w1[2], f[7] * rj * w1[3]}; }
        }
    }
    __syncthreads();
    {
        const int ib = w, i = 16 * ib + r; const size_t row = (size_t)(R0 + i);
        const int nks = (!sample && ib < 4) ? 2 : 4;
        bf16x8 yf[4];
#pragma unroll
        for (int ks = 0; ks < 4; ++ks) yf[ks] = ldfrag(Ws, 136, 16 * ib, 32 * ks, lane);
        const float bias = PIN(I_GBS)[(size_t)(l * 8 + g) * 128 + (sample ? (i & 15) : i)];
#pragma unroll 2
        for (int db = 0; db < 16; ++db) { f32x4 acc = (f32x4){0.f, 0.f, 0.f, 0.f};
#pragma unroll
            for (int ks = 0; ks < 4; ++ks) if (ks < nks) acc = mma16(ldfrag(VT, 136, 16 * db, 32 * ks, lane), yf[ks], acc);
            const int d = 16 * db + 4 * q; const f32x4 w4 = *(const f32x4*)(wv + d);
            const u32x2 uz = *(const u32x2*)(proj + row * NPROJ + 6144 + g * 256 + d);
            const float uu[4] = {__uint_as_float(uz.x << 16), __uint_as_float(uz.x & 0xffff0000u), __uint_as_float(uz.y << 16), __uint_as_float(uz.y & 0xffff0000u)};
            float y[4];
#pragma unroll
            for (int jj = 0; jj < 4; ++jj) y[jj] = (acc[jj] * w4[jj] + bias) * uu[jj];
            u32x2 pk; pk.x = pk2(y[0], y[1]); pk.y = pk2(y[2], y[3]);
            *(u32x2*)(mix + row * DMIX + 2048 + g * 256 + d) = pk; }
    }
    __syncthreads();
}

__device__ __forceinline__ void phase_sn(const Params& p, int l) {
    KA_INIT; TID_INIT;
    bf16_t* mix = (bf16_t*)(PWS + WS_MIX); const float* ssq = (const float*)(PWS + WS_SSQ); const float* nw = PIN(I_SNW) + (size_t)l * 2048;
    const int nth = gridDim.x * 512;
    for (int idx = blockIdx.x * 512 + tid; idx < T * 256; idx += nth) {
        const int row = idx >> 8, col = (idx & 255) * 8, g = col >> 8;
        const f32x4 s4 = *(const f32x4*)(ssq + (size_t)row * 32 + 4 * g);
        const float rstd = rsqrtf((s4[0] + s4[1] + s4[2] + s4[3]) * (1.0f / 256.f) + EPS);
        bf16_t* ptr = mix + (size_t)row * DMIX + col; float f[8]; unpack8(*(const u32x4*)ptr, f);
        const f32x4 w0 = *(const f32x4*)(nw + col), w1 = *(const f32x4*)(nw + col + 4);
#pragma unroll
        for (int j = 0; j < 4; ++j) { f[j] *= rstd * w0[j]; f[4 + j] *= rstd * w1[j]; }
        *(u32x4*)ptr = pack8(f);
    }
}

__device__ __forceinline__ void phase_e2(const Params& p, int l) {
    KA_INIT; TID_INIT;
    const bf16_t* up = (const bf16_t*)(PWS + WS_PROJ); bf16_t* act = (bf16_t*)(PWS + WS_MIX);
    const float* fw = PIN(I_FCW) + (size_t)l * 3 * DUP; const float* fb = PIN(I_FCB) + (size_t)l * DUP;
    const int nth = gridDim.x * 512;
    for (int idx = blockIdx.x * 512 + tid; idx < 544 * 704; idx += nth) {
        const int f8 = idx % 704, rb = idx / 704, r0 = rb * 16, ch = f8 * 8;
        const bool sample = r0 >= TP; const int s = (r0 - TP) >> 4;
        const bool seqstart = sample || ((r0 & 2047) == 0);
        const bool seqend = sample || ((r0 & 2047) == 2032);
        float wg[3][8], wl[3][8], bg[8], bl[8];
#pragma unroll
        for (int k = 0; k < 3; ++k)
#pragma unroll
            for (int j = 0; j < 8; ++j) { wg[k][j] = fw[k * DUP + ch + j]; wl[k][j] = fw[k * DUP + DFF + ch + j]; }
#pragma unroll
        for (int j = 0; j < 8; ++j) { bg[j] = fb[ch + j]; bl[j] = fb[DFF + ch + j]; }
        float pg[2][8], pl[2][8];
#pragma unroll
        for (int k = 0; k < 2; ++k) {
#pragma unroll
            for (int j = 0; j < 8; ++j) { pg[k][j] = 0.f; pl[k][j] = 0.f; }
            if (!seqstart) { unpack8(*(const u32x4*)(up + (size_t)(r0 - 2 + k) * DUP + ch), pg[k]); unpack8(*(const u32x4*)(up + (size_t)(r0 - 2 + k) * DUP + DFF + ch), pl[k]); }
            else if (sample) { const float* sp = PIN(I_SFFN) + ((size_t)(l * 32 + s) * 2 + k) * DUP + ch;
#pragma unroll
                for (int j = 0; j < 8; ++j) { pg[k][j] = sp[j]; pl[k][j] = sp[DFF + j]; } }
        }
#pragma unroll 1
        for (int rr = 0; rr < 16; ++rr) {
            float cg_[8], cl[8], o[8];
            unpack8(*(const u32x4*)(up + (size_t)(r0 + rr) * DUP + ch), cg_); unpack8(*(const u32x4*)(up + (size_t)(r0 + rr) * DUP + DFF + ch), cl);
#pragma unroll
            for (int j = 0; j < 8; ++j) {
                const float a = bg[j] + wg[0][j] * pg[0][j] + wg[1][j] * pg[1][j] + wg[2][j] * cg_[j];
                const float b = bl[j] + wl[0][j] * pl[0][j] + wl[1][j] * pl[1][j] + wl[2][j] * cl[j];
                o[j] = silu_f(a) * b;
                pg[0][j] = pg[1][j]; pg[1][j] = cg_[j]; pl[0][j] = pl[1][j]; pl[1][j] = cl[j];
            }
            *(u32x4*)(act + (size_t)(r0 + rr) * DFF + ch) = pack8(o);
            if (seqend && rr >= 14) {
                float* op = POUT + (sample ? O_SFFN + ((size_t)(l * 32 + s) * 2 + (rr - 14)) * DUP : O_PFFN + ((size_t)(l * 4 + (r0 >> 11)) * 2 + (rr - 14)) * DUP) + ch;
                *(f32x4*)op = (f32x4){cg_[0], cg_[1], cg_[2], cg_[3]}; *(f32x4*)(op + 4) = (f32x4){cg_[4], cg_[5], cg_[6], cg_[7]};
                *(f32x4*)(op + DFF) = (f32x4){cl[0], cl[1], cl[2], cl[3]}; *(f32x4*)(op + DFF + 4) = (f32x4){cl[4], cl[5], cl[6], cl[7]};
            }
        }
    }
}


__device__ __forceinline__ void run_g1(LAS unsigned char* lds, const bf16_t* A, const bf16_t* Bt, bf16_t* P, float* DT, const float* dtb) {
    pg8::StaticOrder S; S.init(T, NINP, gridDim.x, blockIdx.x); pg8::Gemm g{A, Bt, T, NINP, DM}; EpiG1 E{P, DT, dtb}; pg8::gemm_phase(lds, g, S, E); }
__device__ __forceinline__ void run_gx(LAS unsigned char* lds, const bf16_t* A, const bf16_t* Bt, float* X, int K) {
    pg8::StaticOrder S; S.init(T, DM, gridDim.x, blockIdx.x); pg8::Gemm g{A, Bt, T, DM, K}; EpiX E{X}; pg8::gemm_phase(lds, g, S, E); }
__device__ __forceinline__ void run_g3(LAS unsigned char* lds, const bf16_t* A, const bf16_t* Bt, bf16_t* U) {
    pg8::StaticOrder S; S.init(T, DUP, gridDim.x, blockIdx.x); pg8::Gemm g{A, Bt, T, DUP, DM}; EpiUp E{U}; pg8::gemm_phase(lds, g, S, E); }
#ifndef EN_PREP
#define EN_PREP 1
#endif
#ifndef EN_GEMM
#define EN_GEMM 15
#endif
#ifndef EN_SSD
#define EN_SSD 1
#endif
#ifndef EN_GMLP
#define EN_GMLP 1
#endif
#ifndef EN_SN
#define EN_SN 1
#endif
#ifndef EN_E2
#define EN_E2 1
#endif
#define WSP(T_, off) ((T_*)(PWS + (off)))
#define GSYNC cg::this_grid().sync()
__global__ void __launch_bounds__(512, 2) fwd_kernel(Params p) {
    extern __shared__ __attribute__((aligned(16))) unsigned char shm[];
    for (int l = 0; l < 2; ++l) {
#if EN_PREP
        { KA_INIT;
        convert_w(PIN(I_WIN) + (size_t)l * DM * DIN, DM, DIN, WSP(bf16_t, WS_WIN), NINP, 1, shm);
        convert_w(PIN(I_WOUT) + (size_t)l * DMIX * DM, DMIX, DM, WSP(bf16_t, WS_WOUT), DM, 0, shm);
        convert_w(PIN(I_WUP) + (size_t)l * DM * DUP, DM, DUP, WSP(bf16_t, WS_WUP), DUP, 0, shm);
        convert_w(PIN(I_WDN) + (size_t)l * DFF * DM, DFF, DM, WSP(bf16_t, WS_WDN), DM, 0, shm);
        if (l == 0) phase_norm<0>(p, PIN(I_N1W)); else phase_norm<1>(p, PIN(I_N1W) + DM); }
#endif
        GSYNC;
        if (EN_GEMM & 1) { KA_INIT; run_g1((LAS unsigned char*)shm, WSP(bf16_t, WS_H), WSP(bf16_t, WS_WIN), WSP(bf16_t, WS_PROJ), WSP(float, WS_DT), PIN(I_DTB) + l * 32); }
        GSYNC;
        {
            const int step = blockIdx.x < 128 ? (1 << 20) : (int)gridDim.x - 128;
            if (EN_SSD) for (int it = blockIdx.x; it < 1152; it += step) { const bool smp = it >= 128; ssd_chain(p, l, smp, smp ? (it - 128) >> 5 : it >> 5, it & 31, shm); }
            if (EN_GMLP) if (blockIdx.x >= 128) for (int it = blockIdx.x - 128; it < 544; it += step) { const bool smp = it >= 512; gmlp_item(p, l, smp, smp ? it - 512 : it, shm); }
        }
        GSYNC;
        if (EN_SN) phase_sn(p, l);
        GSYNC;
        if (EN_GEMM & 2) { KA_INIT; run_gx((LAS unsigned char*)shm, WSP(bf16_t, WS_MIX), WSP(bf16_t, WS_WOUT), WSP(float, WS_X), DMIX); }
        GSYNC;
        { KA_INIT; phase_norm<1>(p, PIN(I_N2W) + (size_t)l * DM); }
        GSYNC;
        if (EN_GEMM & 4) { KA_INIT; run_g3((LAS unsigned char*)shm, WSP(bf16_t, WS_H), WSP(bf16_t, WS_WUP), WSP(bf16_t, WS_PROJ)); }
        GSYNC;
        if (EN_E2) phase_e2(p, l);
        GSYNC;
        if (EN_GEMM & 8) { KA_INIT; run_gx((LAS unsigned char*)shm, WSP(bf16_t, WS_MIX), WSP(bf16_t, WS_WDN), WSP(float, WS_X), DFF); }
        GSYNC;
    }
    { KA_INIT; phase_norm<2>(p, PIN(I_FNW)); }
}

extern "C" void kernel_launch(void* const* d_in, const int* in_sizes, int n_in, void* d_out, int out_size, void* d_ws, size_t ws_size, hipStream_t stream) {
    static int grid = 0;
    if (grid == 0) {
        if (n_in != 23 || ws_size < WS_END) { fprintf(stderr, "kernel_launch: n_in %d ws %zu (need %zu)\n", n_in, ws_size, (size_t)WS_END); grid = -1; return; }
        int dev = 0, cus = 0, per_cu = 0;
        hipGetDevice(&dev); hipDeviceGetAttribute(&cus, hipDeviceAttributeMultiprocessorCount, dev);
        hipFuncSetAttribute((const void*)fwd_kernel, hipFuncAttributeMaxDynamicSharedMemorySize, LDS_BYTES);
        hipOccupancyMaxActiveBlocksPerMultiprocessor(&per_cu, (const void*)fwd_kernel, 512, LDS_BYTES);
        (void)hipGetLastError();
        if (per_cu < 1) per_cu = 1;
        grid = cus;
        if (grid < 129) { fprintf(stderr, "kernel_launch: needs > 128 CUs\n"); grid = -1; return; }
    }
    if (grid < 0) return;
    Params p{};
    for (int i = 0; i < 23; ++i) p.in[i] = (const float*)d_in[i];
    p.out = (float*)d_out; p.ws = (unsigned char*)d_ws;
    void* args[] = {&p};
    hipError_t e = hipLaunchCooperativeKernel((const void*)fwd_kernel, dim3(grid), dim3(512), args, LDS_BYTES, stream);
    if (e != hipSuccess) fprintf(stderr, "cooperative launch failed: %s (grid %d)\n", hipGetErrorString(e), grid);
}
```

```cpp
#include <hip/hip_runtime.h>
#include <hip/hip_cooperative_groups.h>
#include <cstdio>
namespace cg = cooperative_groups;

#define LAS __attribute__((address_space(3)))
typedef unsigned short bf16_t;
typedef short bf16x8 __attribute__((ext_vector_type(8)));
typedef float f32x4 __attribute__((ext_vector_type(4)));
typedef unsigned u32x4 __attribute__((ext_vector_type(4)));
typedef unsigned u32x2 __attribute__((ext_vector_type(2)));

constexpr int TP = 8192, TS = 512, T = 8704;
constexpr int DM = 2048, NPROJ = 10240, NINP = 10496, DIN = 10272;
constexpr int DMIX = 4096, DFF = 5632, DUP = 11264;
constexpr float EPS = 1e-6f;
constexpr size_t WS_WIN = 0;
constexpr size_t WS_WOUT = WS_WIN + (size_t)NINP * DM * 2;
constexpr size_t WS_WUP = WS_WOUT + (size_t)DM * DMIX * 2;
constexpr size_t WS_WDN = WS_WUP + (size_t)DUP * DM * 2;
constexpr size_t WS_X = WS_WDN + (size_t)DM * DFF * 2;
constexpr size_t WS_H = WS_X + (size_t)T * DM * 4;
constexpr size_t WS_PROJ = WS_H + (size_t)T * DM * 2;
constexpr size_t WS_MIX = WS_PROJ + (size_t)T * DUP * 2;
constexpr size_t WS_DT = WS_MIX + (size_t)T * DFF * 2;
constexpr size_t WS_SSQ = WS_DT + (size_t)T * 32 * 4;
constexpr size_t WS_END = WS_SSQ + (size_t)T * 32 * 4;
constexpr size_t O_YP = 0, O_PCONV = 17825792, O_PSSD = 17924096, O_PFFN = 20021248, O_SCONV = 20201472, O_SSSD = 20987904, O_SFFN = 37765120, O_SV = 39206912;
constexpr int LDS_BYTES = 131072 + 256;

struct Params { const float* in[23]; float* out; unsigned char* ws; };
typedef const unsigned char __attribute__((address_space(4)))* kaptr_t;
#define KA_INIT kaptr_t ka_ = (kaptr_t)__builtin_amdgcn_kernarg_segment_ptr(); asm volatile("" : "+s"(ka_))
#define PIN(i) (*(const float* const __attribute__((address_space(4)))*)(ka_ + 8 * (i)))
#define POUT ((float*)PIN(23))
#define PWS ((unsigned char*)PIN(24))
#define TID_INIT int tid = threadIdx.x; asm volatile("" : "+v"(tid))
enum { I_XP = 0, I_XS, I_SCONV, I_SSSD, I_SFFN, I_N1W, I_WIN, I_CW, I_CB, I_DTB, I_ALOG, I_D, I_SNW, I_GNW, I_GWS, I_GBS, I_WOUT, I_N2W, I_WUP, I_FCW, I_FCB, I_WDN, I_FNW };

__device__ __forceinline__ float bf2f(bf16_t b) { return __uint_as_float(((unsigned)b) << 16); }
__device__ __forceinline__ unsigned pk2(float lo, float hi) { unsigned r; asm volatile("v_cvt_pk_bf16_f32 %0, %1, %2" : "=v"(r) : "v"(lo), "v"(hi)); return r; }
__device__ __forceinline__ bf16_t f2bf(float f) { return (bf16_t)(pk2(f, 0.f) & 0xffffu); }
__device__ __forceinline__ void unpack8(u32x4 v, float* f) {
#pragma unroll
    for (int i = 0; i < 4; ++i) { f[2 * i] = __uint_as_float(v[i] << 16); f[2 * i + 1] = __uint_as_float(v[i] & 0xffff0000u); }
}
__device__ __forceinline__ u32x4 pack8(const float* f) { u32x4 r; r.x = pk2(f[0], f[1]); r.y = pk2(f[2], f[3]); r.z = pk2(f[4], f[5]); r.w = pk2(f[6], f[7]); return r; }
__device__ __forceinline__ float silu_f(float x) { return x / (1.0f + __expf(-x)); }
__device__ __forceinline__ float gelu_f(float x) { const float t = 1.5957691216057308f * (x + 0.044715f * x * x * x); return x / (1.0f + __expf(-t)); }
__device__ __forceinline__ float softplus_f(float x) { return x > 20.f ? x : __logf(1.0f + __expf(x)); }
__device__ __forceinline__ float wave_sum(float v) {
#pragma unroll
    for (int o = 32; o > 0; o >>= 1) v += __shfl_xor(v, o);
    return v;
}

namespace pg8 {
constexpr int BM = 256, BK = 64, HALF = 128, HTB = HALF * BK * 2, NXCD = 8, WGM = 8;
__device__ __forceinline__ int lds_byte(int r, int c) { const int st = (r >> 4) * 2 + (c >> 5), rr = r & 15, cc = c & 31, ob = rr * 64 + cc * 2; return st * 1024 + (ob ^ (((ob >> 9) & 1) << 5)); }
__device__ __forceinline__ void stage_rc(int b, int& R, int& C) { const int st = b / 1024, sb = b % 1024, swz = sb ^ (((sb >> 9) & 1) << 5); R = (st >> 1) * 16 + swz / 64; C = (st & 1) * 32 + (swz % 64) / 2; }
__device__ __forceinline__ int perm32(int rho) { const int n = rho >> 4, i = rho & 15; return 8 * (i >> 2) + 4 * n + (i & 3); }
struct Unit { int pm, pn, kt0, nkt, slab; };
struct Gemm { const bf16_t* A; const bf16_t* Bt; int M, N, K; };
struct StaticOrder {
    int nM, nN, nwg, G, c, nkt;
    __device__ void init(int M, int N, int G_, int c_) { nM = M / BM; nN = N / BM; nwg = nM * nN; G = G_; c = c_; nkt = 0; }
    __device__ bool next(int i, Unit& u) const {
        const long L = (long)i * G + c; if (L >= nwg) return false;
        int wgid = (int)L; { const int q = nwg / NXCD, r = nwg % NXCD, xcd = wgid % NXCD, off = wgid / NXCD; wgid = (xcd < r ? xcd * (q + 1) : r * (q + 1) + (xcd - r) * q) + off; }
        const int nig = WGM * nN, gid = wgid / nig, fm = gid * WGM, gsz = (nM - fm) < WGM ? (nM - fm) : WGM;
        u.pm = fm + ((wgid % nig) % gsz); u.pn = (wgid % nig) / gsz; u.kt0 = 0; u.nkt = nkt; u.slab = -1; return true;
    }
};
struct HybridOrder {
    StaticOrder so; int ns, kper, c;
    __device__ void init(int K, int ns_, int G_, int c_) { so.init(TP, DM, G_, c_); so.nkt = K / BK; ns = ns_; kper = K / BK / ns_; c = c_; }
    __device__ bool next(int i, Unit& u) const {
        if (i == 0) { if (so.next(0, u)) return true; i = 1; }
        if (i == 1 && c < 16 * ns) { const int s = c % ns, tile = c / ns; u.pm = 32 + (tile >> 3); u.pn = tile & 7; u.kt0 = s * kper; u.nkt = kper; u.slab = (tile >> 3) * ns + s; return true; }
        return false;
    }
};
template <class Epi, class Sched>
__device__ __forceinline__ void gemm_phase(LAS unsigned char* lds, const Gemm g, const Sched& S, const Epi& E) {
    int tid = threadIdx.x; asm volatile("" : "+v"(tid));
    const int wid = __builtin_amdgcn_readfirstlane(tid >> 6), lane = tid & 63, wr = wid >> 2, wc = wid & 3, fr = lane & 15, fq = lane >> 4;
    int K = __builtin_amdgcn_readfirstlane(g.K); asm volatile("" : "+s"(K));
    unsigned voffA[2], voffB[2];
#pragma unroll
    for (int i = 0; i < 2; ++i) { int R, C; stage_rc(tid * 16 + i * 8192, R, C); const int Rb = (R & ~31) + perm32(R & 31);
        voffA[i] = (unsigned)(R * K + C) * 2u; voffB[i] = (unsigned)(Rb * K + C) * 2u; }
    const size_t kstep = (size_t)(BK * 2);
    const size_t hstep = (size_t)HALF * K * 2;
    const size_t tstep = 2 * hstep;
    const unsigned ldsw = (unsigned)wid * 1024u;
    const int aoff = lds_byte(wr * 64 + fr, fq * 8), boff = lds_byte(wc * 32 + fr, fq * 8);
#define PG8_SA(b, h) (((b) * 2 + (h)) * HTB)
#define PG8_SB(b, h) ((4 + (b) * 2 + (h)) * HTB)
#define PG8_STAGE(bufoff, gbase, voff) do { _Pragma("unroll") for (int _i = 0; _i < 2; ++_i) \
        __builtin_amdgcn_global_load_lds((const unsigned*)((const char*)(gbase) + (voff)[_i]), (LAS unsigned*)(lds + (bufoff) + ldsw + _i * 8192), 16, 0, 0); } while (0)
#define PG8_LDA(dst, b, h) do { _Pragma("unroll") for (int m = 0; m < 4; ++m) _Pragma("unroll") for (int k = 0; k < 2; ++k) dst[m][k] = *(const LAS bf16x8*)(lds + PG8_SA(b, h) + aoff + m * 2048 + k * 1024); } while (0)
#define PG8_LDB(dst, b, h) do { _Pragma("unroll") for (int n = 0; n < 2; ++n) _Pragma("unroll") for (int k = 0; k < 2; ++k) dst[n][k] = *(const LAS bf16x8*)(lds + PG8_SB(b, h) + boff + n * 2048 + k * 1024); } while (0)
#define PG8_MMA(ai, bj, At, Bt) do { __builtin_amdgcn_s_setprio(1); _Pragma("unroll") for (int m = 0; m < 4; ++m) _Pragma("unroll") for (int n = 0; n < 2; ++n) _Pragma("unroll") for (int k = 0; k < 2; ++k) \
        acc[ai][bj][m][n] = __builtin_amdgcn_mfma_f32_16x16x32_bf16(Bt[n][k], At[m][k], acc[ai][bj][m][n], 0, 0, 0); __builtin_amdgcn_s_setprio(0); } while (0)
#define PG8_WAIT_V(n) asm volatile("s_waitcnt vmcnt(" #n ")" ::: "memory")
#define PG8_WAIT_L(n) asm volatile("s_waitcnt lgkmcnt(" #n ")" ::: "memory")
#define PG8_BAR __builtin_amdgcn_s_barrier()
#define PG8_SCHED __builtin_amdgcn_sched_barrier(0)
    Unit cur, nxt; int ui = 0;
    if (!S.next(0, cur)) return;
    f32x4 acc[2][2][4][2];
#pragma unroll
    for (int a = 0; a < 2; ++a)
#pragma unroll
        for (int b = 0; b < 2; ++b)
#pragma unroll
            for (int m = 0; m < 4; ++m)
#pragma unroll
                for (int n = 0; n < 2; ++n) acc[a][b][m][n] = (f32x4){0.f, 0.f, 0.f, 0.f};
    bf16x8 At[4][2], B0[2][2], B1[2][2];
    const char* cA = (const char*)g.A + (size_t)cur.pm * tstep + (size_t)cur.kt0 * kstep; const char* cB = (const char*)g.Bt + (size_t)cur.pn * tstep + (size_t)cur.kt0 * kstep;
    PG8_STAGE(PG8_SB(0, 0), cB, voffB); PG8_STAGE(PG8_SA(0, 0), cA, voffA); PG8_STAGE(PG8_SB(0, 1), cB + hstep, voffB); PG8_STAGE(PG8_SA(0, 1), cA + hstep, voffA);
    if (wr == 1) PG8_BAR;
    PG8_WAIT_V(4); PG8_BAR;
    PG8_STAGE(PG8_SB(1, 0), cB + kstep, voffB); PG8_STAGE(PG8_SA(1, 0), cA + kstep, voffA); PG8_STAGE(PG8_SB(1, 1), cB + hstep + kstep, voffB);
    PG8_WAIT_V(6); PG8_BAR;
    for (;;) {
        const bool has_next = S.next(ui + 1, nxt);
        const char* nA = has_next ? (const char*)g.A + (size_t)nxt.pm * tstep + (size_t)nxt.kt0 * kstep : cA; const char* nB = has_next ? (const char*)g.Bt + (size_t)nxt.pn * tstep + (size_t)nxt.kt0 * kstep : cB;
        const int nt = cur.nkt;
        for (int t = 0; t < nt; t += 2) {
            const bool last = (t == nt - 2);
            const char* a1 = cA + (size_t)(t + 1) * kstep;
            const char* a2 = last ? nA : cA + (size_t)(t + 2) * kstep; const char* b2 = last ? nB : cB + (size_t)(t + 2) * kstep;
            const char* a3 = a2 + kstep; const char* b3 = b2 + kstep;
            PG8_LDB(B0, 0, 0); PG8_SCHED; PG8_LDA(At, 0, 0); PG8_STAGE(PG8_SA(1, 1), a1 + hstep, voffA);
            PG8_WAIT_L(8); PG8_BAR; PG8_WAIT_L(0); PG8_MMA(0, 0, At, B0); PG8_BAR; PG8_SCHED;
            PG8_LDB(B1, 0, 1); PG8_STAGE(PG8_SB(0, 0), b2, voffB);
            PG8_BAR; PG8_WAIT_L(0); PG8_MMA(0, 1, At, B1); PG8_BAR;
            PG8_LDA(At, 0, 1); PG8_STAGE(PG8_SA(0, 0), a2, voffA);
            PG8_BAR; PG8_WAIT_L(0); PG8_MMA(1, 0, At, B0); PG8_BAR; PG8_SCHED;
            PG8_STAGE(PG8_SB(0, 1), b2 + hstep, voffB);
            PG8_WAIT_V(6); PG8_BAR; PG8_MMA(1, 1, At, B1); PG8_BAR;
            PG8_LDB(B0, 1, 0); PG8_SCHED; PG8_LDA(At, 1, 0); PG8_STAGE(PG8_SA(0, 1), a2 + hstep, voffA);
            PG8_WAIT_L(8); PG8_BAR; PG8_WAIT_L(0); PG8_MMA(0, 0, At, B0); PG8_BAR; PG8_SCHED;
            PG8_LDB(B1, 1, 1); PG8_STAGE(PG8_SB(1, 0), b3, voffB);
            PG8_BAR; PG8_WAIT_L(0); PG8_MMA(0, 1, At, B1); PG8_BAR;
            PG8_LDA(At, 1, 1); PG8_STAGE(PG8_SA(1, 0), a3, voffA);
            PG8_BAR; PG8_WAIT_L(0); PG8_MMA(1, 0, At, B0); PG8_BAR; PG8_SCHED;
            PG8_STAGE(PG8_SB(1, 1), b3 + hstep, voffB);
            PG8_WAIT_V(6); PG8_BAR; PG8_MMA(1, 1, At, B1); PG8_BAR;
        }
        E(acc, cur, wr, wc, fr, fq);
        if (!has_next) break;
#pragma unroll
        for (int a = 0; a < 2; ++a)
#pragma unroll
            for (int b = 0; b < 2; ++b)
#pragma unroll
                for (int m = 0; m < 4; ++m)
#pragma unroll
                    for (int n = 0; n < 2; ++n) acc[a][b][m][n] = (f32x4){0.f, 0.f, 0.f, 0.f};
        cur = nxt; cA = nA; cB = nB; ++ui;
    }
    PG8_WAIT_V(0);
    if (wr == 0) PG8_BAR;
    PG8_BAR;
#undef PG8_SA
#undef PG8_SB
#undef PG8_STAGE
#undef PG8_LDA
#undef PG8_LDB
#undef PG8_MMA
#undef PG8_WAIT_V
#undef PG8_WAIT_L
#undef PG8_BAR
#undef PG8_SCHED
}
}
using pg8::Unit;

struct EpiG1 {
    bf16_t* P; float* DT; const float* dtb;
    __device__ __forceinline__ void operator()(const f32x4 (&acc)[2][2][4][2], const Unit& u, int wr, int wc, int fr, int fq) const {
        const int row0 = u.pm * 256 + wr * 64 + fr;
        if (u.pn < 40) {
            const int mode = u.pn < 8 ? 1 : (u.pn < 24 ? 0 : 2);
            const int col0 = u.pn * 256 + wc * 32 + 8 * fq;
#pragma unroll
            for (int ai = 0; ai < 2; ++ai)
#pragma unroll
                for (int m = 0; m < 4; ++m) { bf16_t* rowp = P + (size_t)(row0 + ai * 128 + m * 16) * NPROJ + col0;
#pragma unroll
                    for (int bj = 0; bj < 2; ++bj) { float v[8];
#pragma unroll
                        for (int j = 0; j < 4; ++j) { v[j] = acc[ai][bj][m][0][j]; v[4 + j] = acc[ai][bj][m][1][j]; }
                        if (mode == 1) {
#pragma unroll
                            for (int j = 0; j < 8; ++j) v[j] = silu_f(v[j]); }
                        else if (mode == 2) {
#pragma unroll
                            for (int j = 0; j < 8; ++j) v[j] = gelu_f(v[j]); }
                        *(u32x4*)(rowp + bj * 128) = pack8(v); } }
        } else if (wc == 0) {
#pragma unroll
            for (int ai = 0; ai < 2; ++ai)
#pragma unroll
                for (int m = 0; m < 4; ++m) { float* rowp = DT + (size_t)(row0 + ai * 128 + m * 16) * 32 + 8 * fq;
#pragma unroll
                    for (int n = 0; n < 2; ++n) { f32x4 o;
#pragma unroll
                        for (int j = 0; j < 4; ++j) o[j] = softplus_f(acc[ai][0][m][n][j] + dtb[8 * fq + 4 * n + j]);
                        *(f32x4*)(rowp + 4 * n) = o; } }
        }
    }
};
struct EpiX {
    float* X; float* SL;
    __device__ __forceinline__ void operator()(const f32x4 (&acc)[2][2][4][2], const Unit& u, int wr, int wc, int fr, int fq) const {
        const int col0 = u.pn * 256 + wc * 32 + 8 * fq;
        if (u.slab < 0) {
            const int row0 = u.pm * 256 + wr * 64 + fr;
#pragma unroll
            for (int ai = 0; ai < 2; ++ai)
#pragma unroll
                for (int m = 0; m < 4; ++m) { float* rowp = X + (size_t)(row0 + ai * 128 + m * 16) * DM + col0;
#pragma unroll
                    for (int bj = 0; bj < 2; ++bj) { f32x4* q = (f32x4*)(rowp + bj * 128); f32x4 a = q[0], b = q[1]; q[0] = a + acc[ai][bj][m][0]; q[1] = b + acc[ai][bj][m][1]; } }
        } else {
            float* base = SL + (size_t)u.slab * 256 * DM; const int row0 = wr * 64 + fr;
#pragma unroll
            for (int ai = 0; ai < 2; ++ai)
#pragma unroll
                for (int m = 0; m < 4; ++m) { float* rowp = base + (size_t)(row0 + ai * 128 + m * 16) * DM + col0;
#pragma unroll
                    for (int bj = 0; bj < 2; ++bj) { f32x4* q = (f32x4*)(rowp + bj * 128); q[0] = acc[ai][bj][m][0]; q[1] = acc[ai][bj][m][1]; } }
        }
    }
};
struct EpiUp {
    bf16_t* U;
    __device__ __forceinline__ void operator()(const f32x4 (&acc)[2][2][4][2], const Unit& u, int wr, int wc, int fr, int fq) const {
        const int row0 = u.pm * 256 + wr * 64 + fr, col0 = u.pn * 256 + wc * 32 + 8 * fq;
#pragma unroll
        for (int ai = 0; ai < 2; ++ai)
#pragma unroll
            for (int m = 0; m < 4; ++m) { bf16_t* rowp = U + (size_t)(row0 + ai * 128 + m * 16) * DUP + col0;
#pragma unroll
                for (int bj = 0; bj < 2; ++bj) { u32x4 w; w.x = pk2(acc[ai][bj][m][0][0], acc[ai][bj][m][0][1]); w.y = pk2(acc[ai][bj][m][0][2], acc[ai][bj][m][0][3]);
                    w.z = pk2(acc[ai][bj][m][1][0], acc[ai][bj][m][1][1]); w.w = pk2(acc[ai][bj][m][1][2], acc[ai][bj][m][1][3]); *(u32x4*)(rowp + bj * 128) = w; } }
    }
};

__device__ __forceinline__ int map_col(int n, int mode) {
    if (mode == 0) return n;
    if (n < 6144) return n; if (n < 10240) return n + 32; if (n < 10272) return n - 10240 + 6144; return -1;
}
__device__ __forceinline__ void convert_w(const float* __restrict__ src, int K, int Nsrc, bf16_t* __restrict__ dst, int Ndst, int mode, unsigned char* shm) {
    float* tile = (float*)shm;
    TID_INIT;
    const int ntn = Ndst / 64, ntk = K / 64, ntile = ntn * ntk;
    const int tkk = tid >> 4, tn4 = tid & 15, wn = tid >> 3, wk8 = tid & 7;
    for (int t = blockIdx.x; t < ntile; t += gridDim.x) {
        const int tn = t % ntn, tk = t / ntn, n0 = tn * 64, k0 = tk * 64;
        const int sc = map_col(n0 + 4 * tn4, mode);
#pragma unroll
        for (int i = 0; i < 2; ++i) { const int k = tkk + 32 * i; f32x4 v = (f32x4){0.f, 0.f, 0.f, 0.f};
            if (sc >= 0) v = *(const f32x4*)(src + (size_t)(k0 + k) * Nsrc + sc);
#pragma unroll
            for (int j = 0; j < 4; ++j) tile[k * 65 + 4 * tn4 + j] = v[j]; }
        __syncthreads();
        float f[8];
#pragma unroll
        for (int j = 0; j < 8; ++j) f[j] = tile[(8 * wk8 + j) * 65 + wn];
        *(u32x4*)(dst + (size_t)(n0 + wn) * K + k0 + 8 * wk8) = pack8(f);
        __syncthreads();
    }
}

template <int MODE>
__device__ __forceinline__ void phase_norm(const Params& p, const float* __restrict__ w, int ns, unsigned char* shm) {
    KA_INIT; TID_INIT;
    const int lane = tid & 63, wv_ = tid >> 6, gw = blockIdx.x * 8 + wv_, nw = gridDim.x * 8;
    float* X = (float*)(PWS + WS_X); bf16_t* H = (bf16_t*)(PWS + WS_H);
    const int nrows = ns > 0 ? TP : T;
    for (int row = gw; row < nrows; row += nw) {
        const float* src = MODE == 0 ? (row < TP ? PIN(I_XP) + (size_t)row * DM : PIN(I_XS) + (size_t)(row - TP) * DM) : X + (size_t)row * DM;
        f32x4 v[8]; float ss = 0.f;
#pragma unroll
        for (int i = 0; i < 8; ++i) { v[i] = *(const f32x4*)(src + i * 256 + lane * 4); ss += v[i][0] * v[i][0] + v[i][1] * v[i][1] + v[i][2] * v[i][2] + v[i][3] * v[i][3]; }
        ss = wave_sum(ss);
        const float rstd = rsqrtf(ss * (1.0f / DM) + EPS);
#pragma unroll
        for (int i = 0; i < 8; ++i) { const int c = i * 256 + lane * 4; const f32x4 wv = *(const f32x4*)(w + c);
            if (MODE == 0) *(f32x4*)(X + (size_t)row * DM + c) = v[i];
            f32x4 o = v[i] * rstd * wv;
            if (MODE == 2) *(f32x4*)(POUT + O_YP + (size_t)row * DM + c) = o;
            else { u32x2 pk; pk.x = pk2(o[0], o[1]); pk.y = pk2(o[2], o[3]); *(u32x2*)(H + (size_t)row * DM + c) = pk; } }
    }
    if (ns > 0) {
        float* red = (float*)shm; const float* SL = (const float*)(PWS + WS_PROJ);
        for (int r = blockIdx.x; r < TS; r += gridDim.x) {
            const int row = TP + r, pmi = r >> 8, rr = r & 255, c = wv_ * 256 + lane * 4;
            f32x4 v = *(const f32x4*)(X + (size_t)row * DM + c);
            for (int s = 0; s < ns; ++s) v += *(const f32x4*)(SL + ((size_t)(pmi * ns + s) * 256 + rr) * DM + c);
            float ss = wave_sum(v[0] * v[0] + v[1] * v[1] + v[2] * v[2] + v[3] * v[3]);
            if (lane == 0) red[wv_] = ss;
            __syncthreads();
            ss = red[0] + red[1] + red[2] + red[3] + red[4] + red[5] + red[6] + red[7];
            const float rstd = rsqrtf(ss * (1.0f / DM) + EPS);
            *(f32x4*)(X + (size_t)row * DM + c) = v;
            const f32x4 o = v * rstd * *(const f32x4*)(w + c);
            if (MODE == 2) *(f32x4*)(POUT + O_YP + (size_t)row * DM + c) = o;
            else { u32x2 pk; pk.x = pk2(o[0], o[1]); pk.y = pk2(o[2], o[3]); *(u32x2*)(H + (size_t)row * DM + c) = pk; }
            __syncthreads();
        }
    }
}

__device__ __forceinline__ bf16x8 ldfrag(const bf16_t* base, int ld, int row0, int k0, int lane) { return *(const bf16x8*)(base + (row0 + (lane & 15)) * ld + k0 + (lane >> 4) * 8); }
__device__ __forceinline__ f32x4 mma16(bf16x8 x, bf16x8 y, f32x4 c) { return __builtin_amdgcn_mfma_f32_16x16x32_bf16(x, y, c, 0, 0, 0); }

__device__ __forceinline__ void ssd_chain(const Params& p, int l, bool sample, int seq, int hd, unsigned char* shm) {
    KA_INIT; TID_INIT;
    const int lane = tid & 63, w = tid >> 6, r = lane & 15, q = lane >> 4;
    bf16_t* Cs = (bf16_t*)(shm + 0);
    bf16_t* Bs = (bf16_t*)(shm + 17408);
    bf16_t* BT = (bf16_t*)(shm + 34816);
    bf16_t* XT = (bf16_t*)(shm + 53248);
    bf16_t* Ms = (bf16_t*)(shm + 62464);
    bf16_t* Hs = (bf16_t*)(shm + 71680);
    float* dts = (float*)(shm + 89088);
    float* acss = dts + 64; float* scs = acss + 64; float* part = scs + 64;
    const bf16_t* proj = (const bf16_t*)(PWS + WS_PROJ); const float* DT = (const float*)(PWS + WS_DT);
    bf16_t* mix = (bf16_t*)(PWS + WS_MIX); float* ssq = (float*)(PWS + WS_SSQ);
    const int g = hd >> 2, nchunk = sample ? 1 : 32, nvalid = sample ? 16 : 64;
    const int rowbase = sample ? TP + seq * 16 : seq * 2048;
    const float Dh = PIN(I_D)[l * 32 + hd];
    const float a_neg = -__expf(PIN(I_ALOG)[l * 32 + hd]);
    const float* cw = PIN(I_CW) + (size_t)l * 4 * 4096; const float* cb = PIN(I_CB) + (size_t)l * 4096;
    const int ib = w >> 1, pb0 = 2 * (w & 1), pbS = w >> 1, nb0 = 4 * (w & 1);
    f32x4 hacc[4];
    {
        const size_t hoff = ((size_t)((l * 32 + seq) * 32 + hd) * 64 + 16 * pbS + r) * 128;
#pragma unroll
        for (int tt = 0; tt < 4; ++tt) {
            f32x4 h = (f32x4){0.f, 0.f, 0.f, 0.f};
            if (sample) h = *(const f32x4*)(PIN(I_SSSD) + hoff + 16 * (nb0 + tt) + 4 * q);
            hacc[tt] = h;
            u32x2 pk; pk.x = pk2(h[0], h[1]); pk.y = pk2(h[2], h[3]);
            *(u32x2*)(Hs + (16 * pbS + r) * 136 + 16 * (nb0 + tt) + 4 * q) = pk;
        }
    }
    for (int c = 0; c < nchunk; ++c) {
        const int R0 = rowbase + c * 64;
        if (w < 5) {
            const int t = lane;
#pragma unroll 1
            for (int it = 0; it < 8; ++it) {
                const int cv = w * 8 + it;
                const int ch = cv < 8 ? hd * 64 + cv * 8 : (cv < 24 ? 2048 + g * 128 + (cv - 8) * 8 : 3072 + g * 128 + (cv - 24) * 8);
                float raw[4][8];
#pragma unroll
                for (int k = 0; k < 4; ++k) {
                    const int tt = t - 3 + k;
#pragma unroll
                    for (int j = 0; j < 8; ++j) raw[k][j] = 0.f;
                    if (tt >= 0) { if (tt < nvalid) unpack8(*(const u32x4*)(proj + (size_t)(R0 + tt) * NPROJ + 2048 + ch), raw[k]); }
                    else if (sample) { const float* sp = PIN(I_SCONV) + ((size_t)(l * 32 + seq) * 3 + (3 + tt)) * 4096 + ch; const f32x4 a = *(const f32x4*)sp, b = *(const f32x4*)(sp + 4);
#pragma unroll
                        for (int j = 0; j < 4; ++j) { raw[k][j] = a[j]; raw[k][4 + j] = b[j]; } }
                    else if (c > 0) unpack8(*(const u32x4*)(proj + (size_t)(R0 + tt) * NPROJ + 2048 + ch), raw[k]);
                }
                float v[8];
#pragma unroll
                for (int j = 0; j < 8; ++j) {
                    float s = cb[ch + j] + cw[ch + j] * raw[0][j] + cw[4096 + ch + j] * raw[1][j] + cw[2 * 4096 + ch + j] * raw[2][j] + cw[3 * 4096 + ch + j] * raw[3][j];
                    v[j] = t < nvalid ? silu_f(s) : 0.f;
                }
                if (c == nchunk - 1 && t >= nvalid - 3 && t < nvalid && (cv < 8 || (hd & 3) == 0)) {
                    float* op = POUT + (sample ? O_SCONV + ((size_t)(l * 32 + seq) * 3 + (t - (nvalid - 3))) * 4096 : O_PCONV + ((size_t)(l * 4 + seq) * 3 + (t - (nvalid - 3))) * 4096) + ch;
                    *(f32x4*)op = (f32x4){raw[3][0], raw[3][1], raw[3][2], raw[3][3]}; *(f32x4*)(op + 4) = (f32x4){raw[3][4], raw[3][5], raw[3][6], raw[3][7]};
                }
                if (cv < 8) {
#pragma unroll
                    for (int j = 0; j < 8; ++j) XT[(cv * 8 + j) * 72 + t] = f2bf(v[j]);
                } else if (cv < 24) {
                    const int cc = (cv - 8) * 8; const u32x4 pk = pack8(v);
                    *(u32x4*)(Bs + t * 136 + cc) = pk;
#pragma unroll
                    for (int j = 0; j < 8; ++j) BT[(cc + j) * 72 + t] = (bf16_t)((j & 1) ? (pk[j >> 1] >> 16) : (pk[j >> 1] & 0xffffu));
                } else {
                    const int cc = (cv - 24) * 8;
                    *(u32x4*)(Cs + t * 136 + cc) = pack8(v);
                }
            }
        } else if (w == 7) {
            const float dtv = lane < nvalid ? DT[(size_t)(R0 + lane) * 32 + hd] : 0.f;
            float s = dtv * a_neg;
#pragma unroll
            for (int o = 1; o < 64; o <<= 1) { const float tmp = __shfl_up(s, o); if (lane >= o) s += tmp; }
            const float lastv = __shfl(s, 63);
            dts[lane] = dtv; acss[lane] = s; scs[lane] = dtv * __expf(lastv - s);
        }
        __syncthreads();
        f32x4 yo[2] = {(f32x4){0.f, 0.f, 0.f, 0.f}, (f32x4){0.f, 0.f, 0.f, 0.f}};
#pragma unroll
        for (int ks = 0; ks < 4; ++ks) { const bf16x8 yf = ldfrag(Cs, 136, 16 * ib, 32 * ks, lane);
#pragma unroll
            for (int tt = 0; tt < 2; ++tt) yo[tt] = mma16(ldfrag(Hs, 136, 16 * (pb0 + tt), 32 * ks, lane), yf, yo[tt]); }
        {
            const int i = 16 * ib + r; const float ai = acss[i];
#pragma unroll
            for (int tt = 0; tt < 2; ++tt) { const int jb = pb0 + tt; f32x4 gg = (f32x4){0.f, 0.f, 0.f, 0.f};
                if (jb <= ib) {
#pragma unroll
                    for (int ks = 0; ks < 4; ++ks) gg = mma16(ldfrag(Bs, 136, 16 * jb, 32 * ks, lane), ldfrag(Cs, 136, 16 * ib, 32 * ks, lane), gg); }
                float mv[4];
#pragma unroll
                for (int jj = 0; jj < 4; ++jj) { const int j = 16 * jb + 4 * q + jj; mv[jj] = (j <= i) ? gg[jj] * __expf(fminf(ai - acss[j], 0.f)) * dts[j] : 0.f; }
                u32x2 pk; pk.x = pk2(mv[0], mv[1]); pk.y = pk2(mv[2], mv[3]);
                *(u32x2*)(Ms + i * 72 + 16 * jb + 4 * q) = pk; }
        }
        {
            const float cd = __expf(acss[63]);
#pragma unroll
            for (int tt = 0; tt < 4; ++tt) hacc[tt] *= cd;
#pragma unroll
            for (int ks = 0; ks < 2; ++ks) {
                const bf16x8 xr = ldfrag(XT, 72, 16 * pbS, 32 * ks, lane);
                float xf[8]; u32x4 xu; xu.x = (unsigned)(unsigned short)xr[0] | ((unsigned)(unsigned short)xr[1] << 16); xu.y = (unsigned)(unsigned short)xr[2] | ((unsigned)(unsigned short)xr[3] << 16);
                xu.z = (unsigned)(unsigned short)xr[4] | ((unsigned)(unsigned short)xr[5] << 16); xu.w = (unsigned)(unsigned short)xr[6] | ((unsigned)(unsigned short)xr[7] << 16);
                unpack8(xu, xf);
#pragma unroll
                for (int e = 0; e < 8; ++e) xf[e] *= scs[32 * ks + 8 * q + e];
                const u32x4 xs = pack8(xf); bf16x8 yf;
#pragma unroll
                for (int e = 0; e < 4; ++e) { yf[2 * e] = (short)(xs[e] & 0xffffu); yf[2 * e + 1] = (short)(xs[e] >> 16); }
#pragma unroll
                for (int tt = 0; tt < 4; ++tt) hacc[tt] = mma16(ldfrag(BT, 72, 16 * (nb0 + tt), 32 * ks, lane), yf, hacc[tt]);
            }
        }
        __syncthreads();
        {
            f32x4 yd[2] = {(f32x4){0.f, 0.f, 0.f, 0.f}, (f32x4){0.f, 0.f, 0.f, 0.f}};
#pragma unroll
            for (int ks = 0; ks < 2; ++ks) if (32 * ks <= 16 * ib + 15) { const bf16x8 yf = ldfrag(Ms, 72, 16 * ib, 32 * ks, lane);
#pragma unroll
                for (int tt = 0; tt < 2; ++tt) yd[tt] = mma16(ldfrag(XT, 72, 16 * (pb0 + tt), 32 * ks, lane), yf, yd[tt]); }
            const int i = 16 * ib + r; const float ea = __expf(acss[i]); const bool valid = i < nvalid; const size_t row = (size_t)(R0 + i);
            float ss = 0.f;
#pragma unroll
            for (int tt = 0; tt < 2; ++tt) { const int pc = 16 * (pb0 + tt) + 4 * q;
                u32x2 gz = (u32x2){0u, 0u}; if (valid) gz = *(const u32x2*)(proj + row * NPROJ + hd * 64 + pc);
                const float gate[4] = {__uint_as_float(gz.x << 16), __uint_as_float(gz.x & 0xffff0000u), __uint_as_float(gz.y << 16), __uint_as_float(gz.y & 0xffff0000u)};
                float y[4];
#pragma unroll
                for (int jj = 0; jj < 4; ++jj) { const float xv = bf2f(XT[(pc + jj) * 72 + i]); y[jj] = (yd[tt][jj] + ea * yo[tt][jj] + Dh * xv) * gate[jj]; ss += y[jj] * y[jj]; }
                if (valid) { u32x2 pk; pk.x = pk2(y[0], y[1]); pk.y = pk2(y[2], y[3]); *(u32x2*)(mix + row * DMIX + hd * 64 + pc) = pk; } }
            ss += __shfl_xor(ss, 16); ss += __shfl_xor(ss, 32);
            if (q == 0) part[i * 2 + (w & 1)] = ss;
#pragma unroll
            for (int tt = 0; tt < 4; ++tt) { u32x2 pk; pk.x = pk2(hacc[tt][0], hacc[tt][1]); pk.y = pk2(hacc[tt][2], hacc[tt][3]); *(u32x2*)(Hs + (16 * pbS + r) * 136 + 16 * (nb0 + tt) + 4 * q) = pk; }
        }
        __syncthreads();
        if (tid < nvalid) ssq[(size_t)(R0 + tid) * 32 + hd] = part[2 * tid] + part[2 * tid + 1];
    }
    {
        float* op = POUT + (sample ? O_SSSD + ((size_t)((l * 32 + seq) * 32 + hd) * 64) * 128 : O_PSSD + ((size_t)((l * 4 + seq) * 32 + hd) * 64) * 128);
#pragma unroll
        for (int tt = 0; tt < 4; ++tt) *(f32x4*)(op + (size_t)(16 * pbS + r) * 128 + 16 * (nb0 + tt) + 4 * q) = hacc[tt];
    }
    __syncthreads();
}

__device__ __forceinline__ void gmlp_item(const Params& p, int l, bool sample, int idx, unsigned char* shm) {
    KA_INIT; TID_INIT;
    const int lane = tid & 63, w = tid >> 6, r = lane & 15, q = lane >> 4;
    bf16_t* Ws = (bf16_t*)shm;
    bf16_t* VT = (bf16_t*)(shm + 34816);
    float* rs = (float*)(shm + 104448);
    float* pp = rs + 128;
    const bf16_t* proj = (const bf16_t*)(PWS + WS_PROJ); bf16_t* mix = (bf16_t*)(PWS + WS_MIX);
    const int g = idx & 7, blk = idx >> 3, R0 = sample ? TP + blk * 128 : blk * 128;
    const float* wv = PIN(I_GNW) + (size_t)l * 2048 + g * 256;
#pragma unroll
    for (int hh = 0; hh < 2; ++hh) { const int j = hh * 64 + lane; float ss = 0.f;
#pragma unroll
        for (int cc = 0; cc < 4; ++cc) { const int cv = 4 * w + cc; const u32x4 raw = *(const u32x4*)(proj + (size_t)(R0 + j) * NPROJ + 8192 + g * 256 + 8 * cv);
            float f[8]; unpack8(raw, f);
#pragma unroll
            for (int e = 0; e < 8; ++e) { ss += f[e] * f[e]; VT[(8 * cv + e) * 136 + j] = (bf16_t)((e & 1) ? (raw[e >> 1] >> 16) : (raw[e >> 1] & 0xffffu)); } }
        pp[j * 8 + w] = ss; }
    __syncthreads();
    if (tid < 128) { float s = 0.f;
#pragma unroll
        for (int k = 0; k < 8; ++k) s += pp[tid * 8 + k];
        rs[tid] = rsqrtf(s * (1.0f / 256.f) + EPS); }
    __syncthreads();
    {
        const int i = tid >> 2, jq = (tid & 3) * 32;
        const float* wsrc = PIN(I_GWS) + (size_t)(l * 8 + g) * 128 * 128;
#pragma unroll
        for (int jv = 0; jv < 8; ++jv) { const int j = jq + 4 * jv; f32x4 w4 = (f32x4){0.f, 0.f, 0.f, 0.f};
            if (!sample) { if ((j >> 6) <= (i >> 6)) w4 = *(const f32x4*)(wsrc + i * 128 + j); }
            else { if ((j >> 4) == (i >> 4)) w4 = *(const f32x4*)(wsrc + (i & 15) * 128 + (j & 15)); }
            u32x2 pk; pk.x = pk2(w4[0] * rs[j], w4[1] * rs[j + 1]); pk.y = pk2(w4[2] * rs[j + 2], w4[3] * rs[j + 3]);
            *(u32x2*)(Ws + i * 136 + j) = pk; }
        if (sample) {
#pragma unroll 1
            for (int k = 0; k < 8; ++k) { const int cvv = tid & 31, j = (tid >> 5) + 16 * k; const u32x4 raw = *(const u32x4*)(proj + (size_t)(R0 + j) * NPROJ + 8192 + g * 256 + 8 * cvv);
                float f[8]; unpack8(raw, f); const float rj = rs[j]; const int s = blk * 8 + (j >> 4), t = j & 15;
                float* op = POUT + O_SV + ((size_t)((l * 32 + s) * 16 + t)) * 2048 + g * 256 + 8 * cvv;
                const f32x4 w0 = *(const f32x4*)(wv + 8 * cvv), w1 = *(const f32x4*)(wv + 8 * cvv + 4);
                *(f32x4*)op = (f32x4){f[0] * rj * w0[0], f[1] * rj * w0[1], f[2] * rj * w0[2], f[3] * rj * w0[3]};
                *(f32x4*)(op + 4) = (f32x4){f[4] * rj * w1[0], f[5] * rj * w1[1], f[6] * rj * w1[2], f[7] * rj * w1[3]}; }
        }
    }
    __syncthreads();
    {
        const int ib = w, i = 16 * ib + r; const size_t row = (size_t)(R0 + i);
        const int nks = (!sample && ib < 4) ? 2 : 4;
        bf16x8 yf[4];
#pragma unroll
        for (int ks = 0; ks < 4; ++ks) yf[ks] = ldfrag(Ws, 136, 16 * ib, 32 * ks, lane);
        const float bias = PIN(I_GBS)[(size_t)(l * 8 + g) * 128 + (sample ? (i & 15) : i)];
#pragma unroll 2
        for (int db = 0; db < 16; ++db) { f32x4 acc = (f32x4){0.f, 0.f, 0.f, 0.f};
#pragma unroll
            for (int ks = 0; ks < 4; ++ks) if (ks < nks) acc = mma16(ldfrag(VT, 136, 16 * db, 32 * ks, lane), yf[ks], acc);
            const int d = 16 * db + 4 * q; const f32x4 w4 = *(const f32x4*)(wv + d);
            const u32x2 uz = *(const u32x2*)(proj + row * NPROJ + 6144 + g * 256 + d);
            const float uu[4] = {__uint_as_float(uz.x << 16), __uint_as_float(uz.x & 0xffff0000u), __uint_as_float(uz.y << 16), __uint_as_float(uz.y & 0xffff0000u)};
            float y[4];
#pragma unroll
            for (int jj = 0; jj < 4; ++jj) y[jj] = (acc[jj] * w4[jj] + bias) * uu[jj];
            u32x2 pk; pk.x = pk2(y[0], y[1]); pk.y = pk2(y[2], y[3]);
            *(u32x2*)(mix + row * DMIX + 2048 + g * 256 + d) = pk; }
    }
    __syncthreads();
}

__device__ __forceinline__ void phase_sn(const Params& p, int l) {
    KA_INIT; TID_INIT;
    bf16_t* mix = (bf16_t*)(PWS + WS_MIX); const float* ssq = (const float*)(PWS + WS_SSQ); const float* nw = PIN(I_SNW) + (size_t)l * 2048;
    const int nth = gridDim.x * 512;
    for (int idx = blockIdx.x * 512 + tid; idx < T * 256; idx += nth) {
        const int row = idx >> 8, col = (idx & 255) * 8, g = col >> 8;
        const f32x4 s4 = *(const f32x4*)(ssq + (size_t)row * 32 + 4 * g);
        const float rstd = rsqrtf((s4[0] + s4[1] + s4[2] + s4[3]) * (1.0f / 256.f) + EPS);
        bf16_t* ptr = mix + (size_t)row * DMIX + col; float f[8]; unpack8(*(const u32x4*)ptr, f);
        const f32x4 w0 = *(const f32x4*)(nw + col), w1 = *(const f32x4*)(nw + col + 4);
#pragma unroll
        for (int j = 0; j < 4; ++j) { f[j] *= rstd * w0[j]; f[4 + j] *= rstd * w1[j]; }
        *(u32x4*)ptr = pack8(f);
    }
}

__device__ __forceinline__ void phase_e2(const Params& p, int l) {
    KA_INIT; TID_INIT;
    const bf16_t* up = (const bf16_t*)(PWS + WS_PROJ); bf16_t* act = (bf16_t*)(PWS + WS_MIX);
    const float* fw = PIN(I_FCW) + (size_t)l * 3 * DUP; const float* fb = PIN(I_FCB) + (size_t)l * DUP;
    const int nth = gridDim.x * 512;
    for (int idx = blockIdx.x * 512 + tid; idx < 544 * 704; idx += nth) {
        const int f8 = idx % 704, rb = idx / 704, r0 = rb * 16, ch = f8 * 8;
        const bool sample = r0 >= TP; const int s = (r0 - TP) >> 4;
        const bool seqstart = sample || ((r0 & 2047) == 0);
        const bool seqend = sample || ((r0 & 2047) == 2032);
        float wg[3][8], wl[3][8], bg[8], bl[8];
#pragma unroll
        for (int k = 0; k < 3; ++k)
#pragma unroll
            for (int j = 0; j < 8; ++j) { wg[k][j] = fw[k * DUP + ch + j]; wl[k][j] = fw[k * DUP + DFF + ch + j]; }
#pragma unroll
        for (int j = 0; j < 8; ++j) { bg[j] = fb[ch + j]; bl[j] = fb[DFF + ch + j]; }
        float pg[2][8], pl[2][8];
#pragma unroll
        for (int k = 0; k < 2; ++k) {
#pragma unroll
            for (int j = 0; j < 8; ++j) { pg[k][j] = 0.f; pl[k][j] = 0.f; }
            if (!seqstart) { unpack8(*(const u32x4*)(up + (size_t)(r0 - 2 + k) * DUP + ch), pg[k]); unpack8(*(const u32x4*)(up + (size_t)(r0 - 2 + k) * DUP + DFF + ch), pl[k]); }
            else if (sample) { const float* sp = PIN(I_SFFN) + ((size_t)(l * 32 + s) * 2 + k) * DUP + ch;
#pragma unroll
                for (int j = 0; j < 8; ++j) { pg[k][j] = sp[j]; pl[k][j] = sp[DFF + j]; } }
        }
#pragma unroll 1
        for (int rr = 0; rr < 16; ++rr) {
            float cg_[8], cl[8], o[8];
            unpack8(*(const u32x4*)(up + (size_t)(r0 + rr) * DUP + ch), cg_); unpack8(*(const u32x4*)(up + (size_t)(r0 + rr) * DUP + DFF + ch), cl);
#pragma unroll
            for (int j = 0; j < 8; ++j) {
                const float a = bg[j] + wg[0][j] * pg[0][j] + wg[1][j] * pg[1][j] + wg[2][j] * cg_[j];
                const float b = bl[j] + wl[0][j] * pl[0][j] + wl[1][j] * pl[1][j] + wl[2][j] * cl[j];
                o[j] = silu_f(a) * b;
                pg[0][j] = pg[1][j]; pg[1][j] = cg_[j]; pl[0][j] = pl[1][j]; pl[1][j] = cl[j];
            }
            *(u32x4*)(act + (size_t)(r0 + rr) * DFF + ch) = pack8(o);
            if (seqend && rr >= 14) {
                float* op = POUT + (sample ? O_SFFN + ((size_t)(l * 32 + s) * 2 + (rr - 14)) * DUP : O_PFFN + ((size_t)(l * 4 + (r0 >> 11)) * 2 + (rr - 14)) * DUP) + ch;
                *(f32x4*)op = (f32x4){cg_[0], cg_[1], cg_[2], cg_[3]}; *(f32x4*)(op + 4) = (f32x4){cg_[4], cg_[5], cg_[6], cg_[7]};
                *(f32x4*)(op + DFF) = (f32x4){cl[0], cl[1], cl[2], cl[3]}; *(f32x4*)(op + DFF + 4) = (f32x4){cl[4], cl[5], cl[6], cl[7]};
            }
        }
    }
}


__device__ __forceinline__ void run_g1(LAS unsigned char* lds, const bf16_t* A, const bf16_t* Bt, bf16_t* P, float* DT, const float* dtb) {
    pg8::StaticOrder S; S.init(T, NINP, gridDim.x, blockIdx.x); S.nkt = DM / 64; pg8::Gemm g{A, Bt, T, NINP, DM}; EpiG1 E{P, DT, dtb}; pg8::gemm_phase(lds, g, S, E); }
__device__ __forceinline__ void run_gx(LAS unsigned char* lds, const bf16_t* A, const bf16_t* Bt, float* X, float* SL, int K, int ns) {
    pg8::HybridOrder S; S.init(K, ns, gridDim.x, blockIdx.x); pg8::Gemm g{A, Bt, T, DM, K}; EpiX E{X, SL}; pg8::gemm_phase(lds, g, S, E); }
__device__ __forceinline__ void run_g3(LAS unsigned char* lds, const bf16_t* A, const bf16_t* Bt, bf16_t* U) {
    pg8::StaticOrder S; S.init(T, DUP, gridDim.x, blockIdx.x); S.nkt = DM / 64; pg8::Gemm g{A, Bt, T, DUP, DM}; EpiUp E{U}; pg8::gemm_phase(lds, g, S, E); }
#ifndef EN_PREP
#define EN_PREP 1
#endif
#ifndef EN_GEMM
#define EN_GEMM 15
#endif
#ifndef EN_SSD
#define EN_SSD 1
#endif
#ifndef EN_GMLP
#define EN_GMLP 1
#endif
#ifndef EN_SN
#define EN_SN 1
#endif
#ifndef EN_E2
#define EN_E2 1
#endif
#define WSP(T_, off) ((T_*)(PWS + (off)))
constexpr size_t WS_BAR = WS_END;
constexpr size_t WS_BAR_BYTES = 16384;
constexpr size_t WS_TOTAL = WS_END + WS_BAR_BYTES;
#define XB_TMO      128
#define XB_XCNT(j)  (256  + 64 * (j))
#define XB_XSUB(j)  (1280 + 64 * (j))
#define XB_XGEN(j)  (2304 + 64 * (j))
#define XB_TOP      3328
#define XB_TOPGEN   3392
#define XB_SPIN_CAP (1u << 18)
__device__ __forceinline__ unsigned xb_ld(unsigned* p)              { return __hip_atomic_load(p, __ATOMIC_RELAXED, __HIP_MEMORY_SCOPE_AGENT); }
__device__ __forceinline__ unsigned xb_add(unsigned* p, unsigned v) { return __hip_atomic_fetch_add(p, v, __ATOMIC_RELAXED, __HIP_MEMORY_SCOPE_AGENT); }
__device__ __forceinline__ unsigned xb_xcc_id() { return (unsigned)__builtin_amdgcn_s_getreg((3 << 11) | 20) & 0xFu; }
#define XB_SPIN(cond, bar) do { unsigned _sp = 0; while (cond) { __builtin_amdgcn_s_sleep(1); \
    if ((++_sp & 255u) == 0u) { if (xb_ld(&(bar)[XB_TMO])) break; if (_sp > XB_SPIN_CAP) { atomicAdd(&(bar)[XB_TMO], 1u); break; } } } } while (0)
__device__ __forceinline__ void xcd_barrier_complete(unsigned* bar, unsigned x, unsigned& nloc, unsigned& nx) {
    const unsigned G = gridDim.x;
    unsigned sum, cnt, mine, sp = 0u;
    for (;;) {
        sum = 0u; cnt = 0u; mine = 0u;
#pragma unroll
        for (unsigned j = 0; j < 16; ++j) { const unsigned c = xb_ld(&bar[XB_XCNT(j)]); sum += c; cnt += (c > 0u) ? 1u : 0u; mine = (j == x) ? c : mine; }
        if (sum == G) break;
        __builtin_amdgcn_s_sleep(1);
        if ((++sp & 255u) == 0u) { if (xb_ld(&bar[XB_TMO])) break; if (sp > XB_SPIN_CAP) { atomicAdd(&bar[XB_TMO], 1u); break; } }
    }
    nloc = mine > 0u ? mine : 1u; nx = cnt > 0u ? cnt : 1u;
}
__device__ __forceinline__ void xcd_barrier(unsigned* bar, volatile LAS unsigned* st) {
    asm volatile("s_waitcnt vmcnt(0)" ::: "memory");
    __syncthreads();
    if (threadIdx.x == 0) {
        const unsigned x = xb_xcc_id();
        __builtin_amdgcn_s_waitcnt(0);
        unsigned nloc = st[0], nx = st[1];
        if (nloc == 0u) { xcd_barrier_complete(bar, x, nloc, nx); st[0] = nloc; st[1] = nx; }
        const unsigned old = xb_add(&bar[XB_XSUB(x)], 1u);
        const unsigned gen = old / nloc;
        if (old + 1u == (gen + 1u) * nloc) {
            __builtin_amdgcn_fence(__ATOMIC_RELEASE, "agent");
            asm volatile("s_waitcnt vmcnt(0)" ::: "memory");
            const unsigned og = xb_add(&bar[XB_TOP], 1u);
            const unsigned tg = og / nx;
            if (og + 1u == (tg + 1u) * nx) xb_add(&bar[XB_TOPGEN], 1u);
            else XB_SPIN(xb_ld(&bar[XB_TOPGEN]) == tg, bar);
            __builtin_amdgcn_fence(__ATOMIC_ACQUIRE, "agent");
            xb_add(&bar[XB_XGEN(x)], 1u);
            asm volatile("s_waitcnt vmcnt(0)" ::: "memory");
        } else {
            XB_SPIN(xb_ld(&bar[XB_XGEN(x)]) == gen, bar);
            __builtin_amdgcn_fence(__ATOMIC_ACQUIRE, "agent");
            asm volatile("s_waitcnt vmcnt(0)" ::: "memory");
        }
    }
    __syncthreads();
}
#define GSYNC do { KA_INIT; xcd_barrier((unsigned*)(PWS + WS_BAR), (volatile LAS unsigned*)((LAS unsigned char*)shm + 131072)); } while (0)
__global__ void __launch_bounds__(512, 2) fwd_kernel(Params p) {
    extern __shared__ __attribute__((aligned(16))) unsigned char shm[];
    { KA_INIT;
      volatile LAS unsigned* st = (volatile LAS unsigned*)((LAS unsigned char*)shm + 131072);
      if (threadIdx.x == 0) { st[0] = 0u; st[1] = 0u; (void)xb_add(&((unsigned*)(PWS + WS_BAR))[XB_XCNT(xb_xcc_id())], 1u); }
      __syncthreads(); }
    for (int l = 0; l < 2; ++l) {
#if EN_PREP
        { KA_INIT;
        convert_w(PIN(I_WIN) + (size_t)l * DM * DIN, DM, DIN, WSP(bf16_t, WS_WIN), NINP, 1, shm);
        convert_w(PIN(I_WOUT) + (size_t)l * DMIX * DM, DMIX, DM, WSP(bf16_t, WS_WOUT), DM, 0, shm);
        convert_w(PIN(I_WUP) + (size_t)l * DM * DUP, DM, DUP, WSP(bf16_t, WS_WUP), DUP, 0, shm);
        convert_w(PIN(I_WDN) + (size_t)l * DFF * DM, DFF, DM, WSP(bf16_t, WS_WDN), DM, 0, shm);
        if (l == 0) phase_norm<0>(p, PIN(I_N1W), 0, shm); else phase_norm<1>(p, PIN(I_N1W) + DM, 11, shm); }
#endif
        if (l == 0) cg::this_grid().sync(); else GSYNC;
        if (EN_GEMM & 1) { KA_INIT; run_g1((LAS unsigned char*)shm, WSP(bf16_t, WS_H), WSP(bf16_t, WS_WIN), WSP(bf16_t, WS_PROJ), WSP(float, WS_DT), PIN(I_DTB) + l * 32); }
        GSYNC;
        {
            const int step = blockIdx.x < 128 ? (1 << 20) : (int)gridDim.x - 128;
            if (EN_SSD) for (int it = blockIdx.x; it < 1152; it += step) { const bool smp = it >= 128; ssd_chain(p, l, smp, smp ? (it - 128) >> 5 : it >> 5, it & 31, shm); }
            if (EN_GMLP) if (blockIdx.x >= 128) for (int it = blockIdx.x - 128; it < 544; it += step) { const bool smp = it >= 512; gmlp_item(p, l, smp, smp ? it - 512 : it, shm); }
        }
        GSYNC;
        if (EN_SN) phase_sn(p, l);
        GSYNC;
        if (EN_GEMM & 2) { KA_INIT; run_gx((LAS unsigned char*)shm, WSP(bf16_t, WS_MIX), WSP(bf16_t, WS_WOUT), WSP(float, WS_X), WSP(float, WS_PROJ), DMIX, 16); }
        GSYNC;
        { KA_INIT; phase_norm<1>(p, PIN(I_N2W) + (size_t)l * DM, 16, shm); }
        GSYNC;
        if (EN_GEMM & 4) { KA_INIT; run_g3((LAS unsigned char*)shm, WSP(bf16_t, WS_H), WSP(bf16_t, WS_WUP), WSP(bf16_t, WS_PROJ)); }
        GSYNC;
        if (EN_E2) phase_e2(p, l);
        GSYNC;
        if (EN_GEMM & 8) { KA_INIT; run_gx((LAS unsigned char*)shm, WSP(bf16_t, WS_MIX), WSP(bf16_t, WS_WDN), WSP(float, WS_X), WSP(float, WS_PROJ), DFF, 11); }
        GSYNC;
    }
    { KA_INIT; phase_norm<2>(p, PIN(I_FNW), 11, shm); }
}

extern "C" void kernel_launch(void* const* d_in, const int* in_sizes, int n_in, void* d_out, int out_size, void* d_ws, size_t ws_size, hipStream_t stream) {
    static int grid = 0;
    if (grid == 0) {
        if (n_in != 23 || ws_size < WS_TOTAL) { fprintf(stderr, "kernel_launch: n_in %d ws %zu (need %zu)\n", n_in, ws_size, (size_t)WS_TOTAL); grid = -1; return; }
        int dev = 0, cus = 0, per_cu = 0;
        hipGetDevice(&dev); hipDeviceGetAttribute(&cus, hipDeviceAttributeMultiprocessorCount, dev);
        hipFuncSetAttribute((const void*)fwd_kernel, hipFuncAttributeMaxDynamicSharedMemorySize, LDS_BYTES);
        hipOccupancyMaxActiveBlocksPerMultiprocessor(&per_cu, (const void*)fwd_kernel, 512, LDS_BYTES);
        (void)hipGetLastError();
        if (per_cu < 1) per_cu = 1;
        grid = cus;
        if (grid < 129) { fprintf(stderr, "kernel_launch: needs > 128 CUs\n"); grid = -1; return; }
    }
    if (grid < 0) return;
    (void)hipMemsetAsync((unsigned char*)d_ws + WS_BAR, 0, WS_BAR_BYTES, stream);
    Params p{};
    for (int i = 0; i < 23; ++i) p.in[i] = (const float*)d_in[i];
    p.out = (float*)d_out; p.ws = (unsigned char*)d_ws;
    void* args[] = {&p};
    hipError_t e = hipLaunchCooperativeKernel((const void*)fwd_kernel, dim3(grid), dim3(512), args, LDS_BYTES, stream);
    if (e != hipSuccess) fprintf(stderr, "cooperative launch failed: %s (grid %d)\n", hipGetErrorString(e), grid);
}
```

```cpp
#include <hip/hip_runtime.h>
#include <hip/hip_cooperative_groups.h>
#include <cstdio>
namespace cg = cooperative_groups;

#define LAS __attribute__((address_space(3)))
typedef unsigned short bf16_t;
typedef short bf16x8 __attribute__((ext_vector_type(8)));
typedef float f32x4 __attribute__((ext_vector_type(4)));
typedef unsigned u32x4 __attribute__((ext_vector_type(4)));
typedef unsigned u32x2 __attribute__((ext_vector_type(2)));

#ifndef PROBE_A
#define PROBE_A 0
#endif
#ifndef PROBE_B
#define PROBE_B 0
#endif
#define PROBE (PROBE_A | PROBE_B)
constexpr int TP = 8192, TS = 512, T = 8704;
constexpr int DM = 2048, NPROJ = 10240, NINP = 10496, DIN = 10272;
constexpr int DMIX = 4096, DFF = 5632, DUP = 11264;
constexpr float EPS = 1e-6f;
constexpr size_t WS_WIN = 0;
constexpr size_t WS_WOUT = WS_WIN + (size_t)NINP * DM * 2;
constexpr size_t WS_WUP = WS_WOUT + (size_t)DM * DMIX * 2;
constexpr size_t WS_WDN = WS_WUP + (size_t)DUP * DM * 2;
constexpr size_t WS_X = WS_WDN + (size_t)DM * DFF * 2;
constexpr size_t WS_H = WS_X + (size_t)T * DM * 4;
constexpr size_t WS_PROJ = WS_H + (size_t)T * DM * 2;
constexpr size_t WS_MIX = WS_PROJ + (size_t)T * DUP * 2;
constexpr size_t WS_DT = WS_MIX + (size_t)T * DFF * 2;
constexpr size_t WS_SSQ = WS_DT + (size_t)T * 32 * 4;
constexpr size_t WS_END = WS_SSQ + (size_t)T * 32 * 4;
constexpr size_t O_YP = 0, O_PCONV = 17825792, O_PSSD = 17924096, O_PFFN = 20021248, O_SCONV = 20201472, O_SSSD = 20987904, O_SFFN = 37765120, O_SV = 39206912;
constexpr int LDS_BYTES = 147456 + 256;

struct Params { const float* in[23]; float* out; unsigned char* ws; };
typedef const unsigned char __attribute__((address_space(4)))* kaptr_t;
#define KA_INIT kaptr_t ka_ = (kaptr_t)__builtin_amdgcn_kernarg_segment_ptr(); asm volatile("" : "+s"(ka_))
#define PIN(i) (*(const float* const __attribute__((address_space(4)))*)(ka_ + 8 * (i)))
#define POUT ((float*)PIN(23))
#define PWS ((unsigned char*)PIN(24))
#define TID_INIT int tid = threadIdx.x; asm volatile("" : "+v"(tid))
enum { I_XP = 0, I_XS, I_SCONV, I_SSSD, I_SFFN, I_N1W, I_WIN, I_CW, I_CB, I_DTB, I_ALOG, I_D, I_SNW, I_GNW, I_GWS, I_GBS, I_WOUT, I_N2W, I_WUP, I_FCW, I_FCB, I_WDN, I_FNW };

__device__ __forceinline__ float bf2f(bf16_t b) { return __uint_as_float(((unsigned)b) << 16); }
__device__ __forceinline__ unsigned pk2(float lo, float hi) { unsigned r; asm volatile("v_cvt_pk_bf16_f32 %0, %1, %2" : "=v"(r) : "v"(lo), "v"(hi)); return r; }
__device__ __forceinline__ bf16_t f2bf(float f) { return (bf16_t)(pk2(f, 0.f) & 0xffffu); }
__device__ __forceinline__ void unpack8(u32x4 v, float* f) {
#pragma unroll
    for (int i = 0; i < 4; ++i) { f[2 * i] = __uint_as_float(v[i] << 16); f[2 * i + 1] = __uint_as_float(v[i] & 0xffff0000u); }
}
__device__ __forceinline__ u32x4 pack8(const float* f) { u32x4 r; r.x = pk2(f[0], f[1]); r.y = pk2(f[2], f[3]); r.z = pk2(f[4], f[5]); r.w = pk2(f[6], f[7]); return r; }
__device__ __forceinline__ float silu_f(float x) { return x * __builtin_amdgcn_rcpf(1.0f + __expf(-x)); }
__device__ __forceinline__ float gelu_f(float x) { const float t = 1.5957691216057308f * (x + 0.044715f * x * x * x); return x * __builtin_amdgcn_rcpf(1.0f + __expf(-t)); }
__device__ __forceinline__ float softplus_f(float x) { return x > 20.f ? x : __logf(1.0f + __expf(x)); }
__device__ __forceinline__ float wave_sum(float v) {
#pragma unroll
    for (int o = 32; o > 0; o >>= 1) v += __shfl_xor(v, o);
    return v;
}

#define LBAR asm volatile("s_waitcnt lgkmcnt(0)\n\ts_barrier" ::: "memory")
namespace pg8 {
constexpr int BM = 256, BK = 64, HALF = 128, HTB = HALF * BK * 2, NXCD = 8, WGM = 8;
__device__ __forceinline__ int lds_byte(int r, int c) { const int st = (r >> 4) * 2 + (c >> 5), rr = r & 15, cc = c & 31, ob = rr * 64 + cc * 2; return st * 1024 + (ob ^ (((ob >> 9) & 1) << 5)); }
__device__ __forceinline__ void stage_rc(int b, int& R, int& C) { const int st = b / 1024, sb = b % 1024, swz = sb ^ (((sb >> 9) & 1) << 5); R = (st >> 1) * 16 + swz / 64; C = (st & 1) * 32 + (swz % 64) / 2; }
__device__ __forceinline__ int perm32(int rho) { const int n = rho >> 4, i = rho & 15; return 8 * (i >> 2) + 4 * n + (i & 3); }
struct Unit { int pm, pn, kt0, nkt, slab; };
struct Gemm { const bf16_t* A; const bf16_t* Bt; int M, N, K; };
struct StaticOrder {
    int nM, nN, nwg, G, c, nkt;
    __device__ void init(int M, int N, int G_, int c_) { nM = M / BM; nN = N / BM; nwg = nM * nN; G = G_; c = c_; nkt = 0; }
    __device__ bool next(int i, Unit& u) const {
        const long L = (long)i * G + c; if (L >= nwg) return false;
        int wgid = (int)L; { const int q = nwg / NXCD, r = nwg % NXCD, xcd = wgid % NXCD, off = wgid / NXCD; wgid = (xcd < r ? xcd * (q + 1) : r * (q + 1) + (xcd - r) * q) + off; }
        const int nig = WGM * nN, gid = wgid / nig, fm = gid * WGM, gsz = (nM - fm) < WGM ? (nM - fm) : WGM;
        u.pm = fm + ((wgid % nig) % gsz); u.pn = (wgid % nig) / gsz; u.kt0 = 0; u.nkt = nkt; u.slab = -1; return true;
    }
};
struct HybridOrder {
    StaticOrder so; int ns, kper, c;
    __device__ void init(int K, int ns_, int G_, int c_) { so.init(TP, DM, G_, c_); so.nkt = K / BK; ns = ns_; kper = K / BK / ns_; c = c_; }
    __device__ bool next(int i, Unit& u) const {
        if (so.next(i, u)) return true;
        const int nmr = c < so.nwg ? (so.nwg - c + so.G - 1) / so.G : 0;
        const long q = (long)(i - nmr) * so.G + c;
        if (i >= nmr && q < 16 * ns) { const int s = (int)q % ns, tile = (int)q / ns; u.pm = 32 + (tile >> 3); u.pn = tile & 7; u.kt0 = s * kper; u.nkt = kper; u.slab = (tile >> 3) * ns + s; return true; }
        return false;
    }
};
template <class Epi, class Sched>
__device__ __forceinline__ void gemm_phase(LAS unsigned char* lds, const Gemm g, const Sched& S, const Epi& E) {
    int tid = threadIdx.x; asm volatile("" : "+v"(tid));
    const int wid = __builtin_amdgcn_readfirstlane(tid >> 6), lane = tid & 63, wr = wid >> 2, wc = wid & 3, fr = lane & 15, fq = lane >> 4;
    int K = __builtin_amdgcn_readfirstlane(g.K); asm volatile("" : "+s"(K));
    unsigned voffA[2], voffB[2];
#pragma unroll
    for (int i = 0; i < 2; ++i) { int R, C; stage_rc(tid * 16 + i * 8192, R, C); const int Rb = (R & ~31) + perm32(R & 31);
        voffA[i] = (unsigned)(R * K + C) * 2u; voffB[i] = (unsigned)(Rb * K + C) * 2u; }
    const size_t kstep = (size_t)(BK * 2);
    const size_t hstep = (size_t)HALF * K * 2;
    const size_t tstep = 2 * hstep;
    const unsigned ldsw = (unsigned)wid * 1024u;
    const int aoff = lds_byte(wr * 64 + fr, fq * 8), boff = lds_byte(wc * 32 + fr, fq * 8);
#define PG8_SA(b, h) (((b) * 2 + (h)) * HTB)
#define PG8_SB(b, h) ((4 + (b) * 2 + (h)) * HTB)
#define PG8_STAGE(bufoff, gbase, voff) do { _Pragma("unroll") for (int _i = 0; _i < 2; ++_i) \
        __builtin_amdgcn_global_load_lds((const unsigned*)((const char*)(gbase) + (voff)[_i]), (LAS unsigned*)(lds + (bufoff) + ldsw + _i * 8192), 16, 0, 0); } while (0)
#define PG8_LDA(dst, b, h) do { _Pragma("unroll") for (int m = 0; m < 4; ++m) _Pragma("unroll") for (int k = 0; k < 2; ++k) dst[m][k] = *(const LAS bf16x8*)(lds + PG8_SA(b, h) + aoff + m * 2048 + k * 1024); } while (0)
#define PG8_LDB(dst, b, h) do { _Pragma("unroll") for (int n = 0; n < 2; ++n) _Pragma("unroll") for (int k = 0; k < 2; ++k) dst[n][k] = *(const LAS bf16x8*)(lds + PG8_SB(b, h) + boff + n * 2048 + k * 1024); } while (0)
#define PG8_MMA(ai, bj, At, Bt) do { __builtin_amdgcn_s_setprio(1); _Pragma("unroll") for (int m = 0; m < 4; ++m) _Pragma("unroll") for (int n = 0; n < 2; ++n) _Pragma("unroll") for (int k = 0; k < 2; ++k) \
        acc[ai][bj][m][n] = __builtin_amdgcn_mfma_f32_16x16x32_bf16(Bt[n][k], At[m][k], acc[ai][bj][m][n], 0, 0, 0); __builtin_amdgcn_s_setprio(0); } while (0)
#define PG8_WAIT_V(n) asm volatile("s_waitcnt vmcnt(" #n ")" ::: "memory")
#define PG8_WAIT_L(n) asm volatile("s_waitcnt lgkmcnt(" #n ")" ::: "memory")
#define PG8_BAR __builtin_amdgcn_s_barrier()
#define PG8_SCHED __builtin_amdgcn_sched_barrier(0)
    Unit cur, nxt; int ui = 0;
    if (!S.next(0, cur)) return;
    f32x4 acc[2][2][4][2];
#pragma unroll
    for (int a = 0; a < 2; ++a)
#pragma unroll
        for (int b = 0; b < 2; ++b)
#pragma unroll
            for (int m = 0; m < 4; ++m)
#pragma unroll
                for (int n = 0; n < 2; ++n) acc[a][b][m][n] = (f32x4){0.f, 0.f, 0.f, 0.f};
    bf16x8 At[4][2], B0[2][2], B1[2][2];
    const char* cA = (const char*)g.A + (size_t)cur.pm * tstep + (size_t)cur.kt0 * kstep; const char* cB = (const char*)g.Bt + (size_t)cur.pn * tstep + (size_t)cur.kt0 * kstep;
    PG8_STAGE(PG8_SB(0, 0), cB, voffB); PG8_STAGE(PG8_SA(0, 0), cA, voffA); PG8_STAGE(PG8_SB(0, 1), cB + hstep, voffB); PG8_STAGE(PG8_SA(0, 1), cA + hstep, voffA);
    if (wr == 1) PG8_BAR;
    PG8_WAIT_V(4); PG8_BAR;
    PG8_STAGE(PG8_SB(1, 0), cB + kstep, voffB); PG8_STAGE(PG8_SA(1, 0), cA + kstep, voffA); PG8_STAGE(PG8_SB(1, 1), cB + hstep + kstep, voffB);
    PG8_WAIT_V(6); PG8_BAR;
    for (;;) {
        const bool has_next = S.next(ui + 1, nxt);
        const char* nA = has_next ? (const char*)g.A + (size_t)nxt.pm * tstep + (size_t)nxt.kt0 * kstep : cA; const char* nB = has_next ? (const char*)g.Bt + (size_t)nxt.pn * tstep + (size_t)nxt.kt0 * kstep : cB;
        const int nt = cur.nkt;
        for (int t = 0; t < nt; t += 2) {
            const bool last = (t == nt - 2);
            const char* a1 = cA + (size_t)(t + 1) * kstep;
            const char* a2 = last ? nA : cA + (size_t)(t + 2) * kstep; const char* b2 = last ? nB : cB + (size_t)(t + 2) * kstep;
            const char* a3 = a2 + kstep; const char* b3 = b2 + kstep;
            PG8_LDB(B0, 0, 0); PG8_SCHED; PG8_LDA(At, 0, 0); PG8_STAGE(PG8_SA(1, 1), a1 + hstep, voffA);
            PG8_WAIT_L(8); PG8_BAR; PG8_WAIT_L(0); PG8_MMA(0, 0, At, B0); PG8_BAR; PG8_SCHED;
            PG8_LDB(B1, 0, 1); PG8_STAGE(PG8_SB(0, 0), b2, voffB);
            PG8_BAR; PG8_WAIT_L(0); PG8_MMA(0, 1, At, B1); PG8_BAR;
            PG8_LDA(At, 0, 1); PG8_STAGE(PG8_SA(0, 0), a2, voffA);
            PG8_BAR; PG8_WAIT_L(0); PG8_MMA(1, 0, At, B0); PG8_BAR; PG8_SCHED;
            PG8_STAGE(PG8_SB(0, 1), b2 + hstep, voffB);
            PG8_WAIT_V(6); PG8_BAR; PG8_MMA(1, 1, At, B1); PG8_BAR;
            PG8_LDB(B0, 1, 0); PG8_SCHED; PG8_LDA(At, 1, 0); PG8_STAGE(PG8_SA(0, 1), a2 + hstep, voffA);
            PG8_WAIT_L(8); PG8_BAR; PG8_WAIT_L(0); PG8_MMA(0, 0, At, B0); PG8_BAR; PG8_SCHED;
            PG8_LDB(B1, 1, 1); PG8_STAGE(PG8_SB(1, 0), b3, voffB);
            PG8_BAR; PG8_WAIT_L(0); PG8_MMA(0, 1, At, B1); PG8_BAR;
            PG8_LDA(At, 1, 1); PG8_STAGE(PG8_SA(1, 0), a3, voffA);
            PG8_BAR; PG8_WAIT_L(0); PG8_MMA(1, 0, At, B0); PG8_BAR; PG8_SCHED;
            PG8_STAGE(PG8_SB(1, 1), b3 + hstep, voffB);
            PG8_WAIT_V(6); PG8_BAR; PG8_MMA(1, 1, At, B1); PG8_BAR;
        }
        E(acc, cur, wr, wc, fr, fq);
        if (!has_next) break;
#pragma unroll
        for (int a = 0; a < 2; ++a)
#pragma unroll
            for (int b = 0; b < 2; ++b)
#pragma unroll
                for (int m = 0; m < 4; ++m)
#pragma unroll
                    for (int n = 0; n < 2; ++n) acc[a][b][m][n] = (f32x4){0.f, 0.f, 0.f, 0.f};
        cur = nxt; cA = nA; cB = nB; ++ui;
    }
    PG8_WAIT_V(0);
    if (wr == 0) PG8_BAR;
    PG8_BAR;
#undef PG8_SA
#undef PG8_SB
#undef PG8_STAGE
#undef PG8_LDA
#undef PG8_LDB
#undef PG8_MMA
#undef PG8_WAIT_V
#undef PG8_WAIT_L
#undef PG8_BAR
#undef PG8_SCHED
}
}
using pg8::Unit;

struct EpiG1 {
    bf16_t* P; float* DT; const float* dtb;
    __device__ __forceinline__ void operator()(const f32x4 (&acc)[2][2][4][2], const Unit& u, int wr, int wc, int fr, int fq) const {
        const int row0 = u.pm * 256 + wr * 64 + fr;
        if (u.pn < 40) {
            const int mode = u.pn < 8 ? 1 : (u.pn < 24 ? 0 : 2);
            const int col0 = u.pn * 256 + wc * 32 + 8 * fq;
#pragma unroll
            for (int ai = 0; ai < 2; ++ai)
#pragma unroll
                for (int m = 0; m < 4; ++m) { bf16_t* rowp = P + (size_t)(row0 + ai * 128 + m * 16) * NPROJ + col0;
#pragma unroll
                    for (int bj = 0; bj < 2; ++bj) { float v[8];
#pragma unroll
                        for (int j = 0; j < 4; ++j) { v[j] = acc[ai][bj][m][0][j]; v[4 + j] = acc[ai][bj][m][1][j]; }
                        if (mode == 1) {
#pragma unroll
                            for (int j = 0; j < 8; ++j) v[j] = silu_f(v[j]); }
                        else if (mode == 2) {
#pragma unroll
                            for (int j = 0; j < 8; ++j) v[j] = gelu_f(v[j]); }
                        *(u32x4*)(rowp + bj * 128) = pack8(v); } }
        } else if (wc == 0) {
#pragma unroll
            for (int ai = 0; ai < 2; ++ai)
#pragma unroll
                for (int m = 0; m < 4; ++m) { float* rowp = DT + (size_t)(row0 + ai * 128 + m * 16) * 32 + 8 * fq;
#pragma unroll
                    for (int n = 0; n < 2; ++n) { f32x4 o;
#pragma unroll
                        for (int j = 0; j < 4; ++j) o[j] = softplus_f(acc[ai][0][m][n][j] + dtb[8 * fq + 4 * n + j]);
                        *(f32x4*)(rowp + 4 * n) = o; } }
        }
    }
};
struct EpiX {
    float* X; float* SL;
    __device__ __forceinline__ void operator()(const f32x4 (&acc)[2][2][4][2], const Unit& u, int wr, int wc, int fr, int fq) const {
        const int col0 = u.pn * 256 + wc * 32 + 8 * fq;
        if (u.slab < 0) {
            const int row0 = u.pm * 256 + wr * 64 + fr;
#pragma unroll
            for (int ai = 0; ai < 2; ++ai)
#pragma unroll
                for (int m = 0; m < 4; ++m) { float* rowp = X + (size_t)(row0 + ai * 128 + m * 16) * DM + col0;
#pragma unroll
                    for (int bj = 0; bj < 2; ++bj) { f32x4* q = (f32x4*)(rowp + bj * 128); f32x4 a = q[0], b = q[1]; q[0] = a + acc[ai][bj][m][0]; q[1] = b + acc[ai][bj][m][1]; } }
        } else {
            float* base = SL + (size_t)u.slab * 256 * DM; const int row0 = wr * 64 + fr;
#pragma unroll
            for (int ai = 0; ai < 2; ++ai)
#pragma unroll
                for (int m = 0; m < 4; ++m) { float* rowp = base + (size_t)(row0 + ai * 128 + m * 16) * DM + col0;
#pragma unroll
                    for (int bj = 0; bj < 2; ++bj) { f32x4* q = (f32x4*)(rowp + bj * 128); q[0] = acc[ai][bj][m][0]; q[1] = acc[ai][bj][m][1]; } }
        }
    }
};
struct EpiUp {
    bf16_t* U;
    __device__ __forceinline__ void operator()(const f32x4 (&acc)[2][2][4][2], const Unit& u, int wr, int wc, int fr, int fq) const {
        const int row0 = u.pm * 256 + wr * 64 + fr, col0 = u.pn * 256 + wc * 32 + 8 * fq;
#pragma unroll
        for (int ai = 0; ai < 2; ++ai)
#pragma unroll
            for (int m = 0; m < 4; ++m) { bf16_t* rowp = U + (size_t)(row0 + ai * 128 + m * 16) * DUP + col0;
#pragma unroll
                for (int bj = 0; bj < 2; ++bj) { u32x4 w; w.x = pk2(acc[ai][bj][m][0][0], acc[ai][bj][m][0][1]); w.y = pk2(acc[ai][bj][m][0][2], acc[ai][bj][m][0][3]);
                    w.z = pk2(acc[ai][bj][m][1][0], acc[ai][bj][m][1][1]); w.w = pk2(acc[ai][bj][m][1][2], acc[ai][bj][m][1][3]); *(u32x4*)(rowp + bj * 128) = w; } }
    }
};

__device__ __forceinline__ int map_col(int n, int mode) {
    if (mode == 0) return n;
    if (n < 6144) return n; if (n < 10240) return n + 32; if (n < 10272) return n - 10240 + 6144; return -1;
}
__device__ __forceinline__ void convert_w(const float* __restrict__ src, int K, int Nsrc, bf16_t* __restrict__ dst, int Ndst, int mode, unsigned char* shm) {
    float* tile = (float*)shm;
    TID_INIT;
    const int ntn = Ndst / 256, ntk = K / 64, ntile = ntn * ntk;
    const int tkk = tid >> 4, tn4 = tid & 15, wn = tid >> 3, wk8 = tid & 7;
    f32x4 v[4][2];
    int t = blockIdx.x;
#define CW_LOAD(tt_) do { const int tn_ = (tt_) % ntn, tk_ = (tt_) / ntn; \
        _Pragma("unroll") for (int s_ = 0; s_ < 4; ++s_) { const int sc_ = map_col(tn_ * 256 + 64 * s_ + 4 * tn4, mode); \
            _Pragma("unroll") for (int i_ = 0; i_ < 2; ++i_) { v[s_][i_] = (f32x4){0.f, 0.f, 0.f, 0.f}; if (sc_ >= 0) v[s_][i_] = *(const f32x4*)(src + (size_t)(tk_ * 64 + tkk + 32 * i_) * Nsrc + sc_); } } } while (0)
    if (t < ntile) CW_LOAD(t);
    for (; t < ntile; t += gridDim.x) {
        const int tn = t % ntn, tk = t / ntn, n0 = tn * 256, k0 = tk * 64;
#pragma unroll
        for (int s_ = 0; s_ < 4; ++s_)
#pragma unroll
            for (int i = 0; i < 2; ++i)
#pragma unroll
                for (int j = 0; j < 4; ++j) tile[(tkk + 32 * i) * 257 + 64 * s_ + 4 * tn4 + j] = v[s_][i][j];
        LBAR;
        if (t + (int)gridDim.x < ntile) CW_LOAD(t + (int)gridDim.x);
#pragma unroll
        for (int s_ = 0; s_ < 4; ++s_) { float f[8];
#pragma unroll
            for (int j = 0; j < 8; ++j) f[j] = tile[(8 * wk8 + j) * 257 + 64 * s_ + wn];
            *(u32x4*)(dst + (size_t)(n0 + 64 * s_ + wn) * K + k0 + 8 * wk8) = pack8(f); }
        LBAR;
    }
#undef CW_LOAD
}

template <int MODE>
__device__ __forceinline__ void phase_norm(const Params& p, const float* __restrict__ w, int ns, unsigned char* shm, float addA = 0.f) {
    KA_INIT; TID_INIT;
    const int lane = tid & 63, wv_ = tid >> 6, gw = blockIdx.x * 8 + wv_, nw = gridDim.x * 8;
    float* X = (float*)(PWS + WS_X); bf16_t* H = (bf16_t*)(PWS + WS_H);
    const int nrows = ns > 0 ? TP : T;
    for (int row = gw; row < nrows; row += nw) {
        const float* src = MODE == 0 ? (row < TP ? PIN(I_XP) + (size_t)row * DM : PIN(I_XS) + (size_t)(row - TP) * DM) : X + (size_t)row * DM;
        f32x4 v[8]; float ss = 0.f;
#pragma unroll
        for (int i = 0; i < 8; ++i) { v[i] = *(const f32x4*)(src + i * 256 + lane * 4); ss += v[i][0] * v[i][0] + v[i][1] * v[i][1] + v[i][2] * v[i][2] + v[i][3] * v[i][3]; }
        ss = wave_sum(ss);
        const float rstd = rsqrtf(ss * (1.0f / DM) + EPS);
#pragma unroll
        for (int i = 0; i < 8; ++i) { const int c = i * 256 + lane * 4; const f32x4 wv = *(const f32x4*)(w + c);
            if (MODE == 0) *(f32x4*)(X + (size_t)row * DM + c) = v[i];
            f32x4 o = v[i] * rstd * wv;
            if (MODE == 2) { if (PROBE && row == 0 && i == 0 && lane == 0) o[0] += addA; *(f32x4*)(POUT + O_YP + (size_t)row * DM + c) = o; }
            else { u32x2 pk; pk.x = pk2(o[0], o[1]); pk.y = pk2(o[2], o[3]); *(u32x2*)(H + (size_t)row * DM + c) = pk; } }
    }
    if (ns > 0) {
        float* red = (float*)shm; const float* SL = (const float*)(PWS + WS_PROJ);
        for (int r = blockIdx.x; r < TS; r += gridDim.x) {
            const int row = TP + r, pmi = r >> 8, rr = r & 255, c = wv_ * 256 + lane * 4;
            f32x4 v = *(const f32x4*)(X + (size_t)row * DM + c);
            { f32x4 sl[16];
#pragma unroll
              for (int s = 0; s < 16; ++s) { sl[s] = (f32x4){0.f, 0.f, 0.f, 0.f}; if (s < ns) sl[s] = *(const f32x4*)(SL + ((size_t)(pmi * ns + s) * 256 + rr) * DM + c); }
#pragma unroll
              for (int s = 0; s < 16; s += 4) v += (sl[s] + sl[s + 1]) + (sl[s + 2] + sl[s + 3]); }
            float ss = wave_sum(v[0] * v[0] + v[1] * v[1] + v[2] * v[2] + v[3] * v[3]);
            if (lane == 0) red[wv_] = ss;
            __syncthreads();
            ss = red[0] + red[1] + red[2] + red[3] + red[4] + red[5] + red[6] + red[7];
            const float rstd = rsqrtf(ss * (1.0f / DM) + EPS);
            *(f32x4*)(X + (size_t)row * DM + c) = v;
            const f32x4 o = v * rstd * *(const f32x4*)(w + c);
            if (MODE == 2) *(f32x4*)(POUT + O_YP + (size_t)row * DM + c) = o;
            else { u32x2 pk; pk.x = pk2(o[0], o[1]); pk.y = pk2(o[2], o[3]); *(u32x2*)(H + (size_t)row * DM + c) = pk; }
            __syncthreads();
        }
    }
}

__device__ __forceinline__ bf16x8 ldfrag(const bf16_t* base, int ld, int row0, int k0, int lane) { return *(const bf16x8*)(base + (row0 + (lane & 15)) * ld + k0 + (lane >> 4) * 8); }
__device__ __forceinline__ f32x4 mma16(bf16x8 x, bf16x8 y, f32x4 c) { return __builtin_amdgcn_mfma_f32_16x16x32_bf16(x, y, c, 0, 0, 0); }

__device__ __forceinline__ float wave_scan_incl(float s) {
#define DPP_ADD_(ctrl, rmask) { const int t_ = __builtin_amdgcn_update_dpp(0, __float_as_int(s), ctrl, rmask, 0xf, true); s += __int_as_float(t_); }
    DPP_ADD_(0x111, 0xf) DPP_ADD_(0x112, 0xf) DPP_ADD_(0x114, 0xf) DPP_ADD_(0x118, 0xf) DPP_ADD_(0x142, 0xa) DPP_ADD_(0x143, 0xc)
#undef DPP_ADD_
    return s;
}
__device__ __forceinline__ void ssd_chain(const Params& p, int l, bool sample, int seq, int hd, unsigned char* shm) {
    KA_INIT; TID_INIT;
    const int lane = tid & 63, w = __builtin_amdgcn_readfirstlane(tid >> 6), r = lane & 15, q = lane >> 4;
    bf16_t* Cs = (bf16_t*)(shm + 0);
    bf16_t* Bs = (bf16_t*)(shm + 17408);
    bf16_t* BT = (bf16_t*)(shm + 34816);
    bf16_t* XT = (bf16_t*)(shm + 53248);
    bf16_t* Ms = (bf16_t*)(shm + 62464);
    bf16_t* Hs = (bf16_t*)(shm + 71680);
    float* dts = (float*)(shm + 89088);
    float* acss = dts + 64; float* scs = acss + 64; float* part = scs + 64;
    bf16_t* RAW = (bf16_t*)(shm + 90624);
    bf16_t* HALO = (bf16_t*)(shm + 132608);
    float* CWs = (float*)(shm + 136704);
    const bf16_t* proj = (const bf16_t*)(PWS + WS_PROJ); const float* DT = (const float*)(PWS + WS_DT);
    bf16_t* mix = (bf16_t*)(PWS + WS_MIX); float* ssq = (float*)(PWS + WS_SSQ);
    const int g = hd >> 2, nchunk = sample ? 1 : 32, nvalid = sample ? 16 : 64;
    const int rowbase = sample ? TP + seq * 16 : seq * 2048;
    const float Dh = PIN(I_D)[l * 32 + hd];
    const float a_neg = -__expf(PIN(I_ALOG)[l * 32 + hd]);
    const int ib = w >> 1, pb0 = 2 * (w & 1), pbS = w >> 1, nb0 = 4 * (w & 1);
#define SSD_CH(cv) ((cv) < 8 ? hd * 64 + (cv) * 8 : ((cv) < 24 ? 2048 + g * 128 + ((cv) - 8) * 8 : 3072 + g * 128 + ((cv) - 24) * 8))
    typedef const float __attribute__((address_space(4)))* cptr4_t;
    const cptr4_t cw4 = (cptr4_t)(PIN(I_CW) + (size_t)l * 4 * 4096); const cptr4_t cb4 = (cptr4_t)(PIN(I_CB) + (size_t)l * 4096);
    if (tid >= 384 && tid < 384 + 120) { const int e = tid - 384, hr = e / 40, cvv = e % 40; u32x4 hv = (u32x4){0u, 0u, 0u, 0u};
        if (sample) { const float* sp = PIN(I_SCONV) + ((size_t)(l * 32 + seq) * 3 + hr) * 4096 + SSD_CH(cvv); const f32x4 a = *(const f32x4*)sp, b = *(const f32x4*)(sp + 4);
            hv.x = pk2(a[0], a[1]); hv.y = pk2(a[2], a[3]); hv.z = pk2(b[0], b[1]); hv.w = pk2(b[2], b[3]); }
        *(u32x4*)(HALO + (3 + hr) * 328 + cvv * 8) = hv; }
    f32x4 hacc[4];
    {
        const size_t hoff = ((size_t)((l * 32 + seq) * 32 + hd) * 64 + 16 * pbS + r) * 128;
#pragma unroll
        for (int tt = 0; tt < 4; ++tt) {
            f32x4 h = (f32x4){0.f, 0.f, 0.f, 0.f};
            if (sample) h = *(const f32x4*)(PIN(I_SSSD) + hoff + 16 * (nb0 + tt) + 4 * q);
            hacc[tt] = h;
            u32x2 pk; pk.x = pk2(h[0], h[1]); pk.y = pk2(h[2], h[3]);
            *(u32x2*)(Hs + (16 * pbS + r) * 136 + 16 * (nb0 + tt) + 4 * q) = pk;
        }
    }
    u32x4 rawreg[5]; float dtreg = 0.f;
    int goff[5], loff[5];
#pragma unroll
    for (int it = 0; it < 5; ++it) { const int v_ = it * 512 + tid, prow = v_ / 40, pcv = v_ - prow * 40; goff[it] = prow * NPROJ + 2048 + SSD_CH(pcv); loff[it] = prow * 328 + pcv * 8; }
#pragma unroll
    for (int it = 0; it < 5; ++it) { rawreg[it] = (u32x4){0u, 0u, 0u, 0u};
        if (it * 512 + tid < nvalid * 40) rawreg[it] = *(const u32x4*)(proj + (size_t)rowbase * NPROJ + goff[it]); }
    if (w == 7 && lane < nvalid) dtreg = DT[(size_t)(rowbase + lane) * 32 + hd];
    for (int c = 0; c < nchunk; ++c) {
        const int R0 = rowbase + c * 64;
#pragma unroll
        for (int it = 0; it < 5; ++it) *(u32x4*)(RAW + loff[it]) = rawreg[it];
        if (tid >= 392) *(u32x4*)(HALO + ((c & 1) * 3 - 61) * 328 + loff[4]) = rawreg[4];
        if (w == 7) {
            const float dtv = dtreg; const float s = wave_scan_incl(dtv * a_neg);
            const float lastv = __int_as_float(__builtin_amdgcn_readlane(__float_as_int(s), 63));
            dts[lane] = dtv; acss[lane] = s; scs[lane] = dtv * __expf(lastv - s);
        }
        u32x2 gz[2];
        {
            const int i = 16 * ib + r;
#pragma unroll
            for (int tt = 0; tt < 2; ++tt) { gz[tt] = (u32x2){0u, 0u}; if (i < nvalid) gz[tt] = *(const u32x2*)(proj + (size_t)(R0 + i) * NPROJ + hd * 64 + 16 * (pb0 + tt) + 4 * q); }
        }
        if (c + 1 < nchunk) {
#pragma unroll
            for (int it = 0; it < 5; ++it) rawreg[it] = *(const u32x4*)(proj + (size_t)(R0 + 64) * NPROJ + goff[it]);
            if (w == 7) dtreg = DT[(size_t)(R0 + 64 + lane) * 32 + hd];
        }
        LBAR;
        {
            const int t = lane; const int haloff = 132608 + (((c + 1) & 1) * 3 + 3) * 656;
            u32x4 rws[5][4];
#pragma unroll
            for (int it = 0; it < 5; ++it)
#pragma unroll
                for (int k = 0; k < 4; ++k) { const int tt = t - 3 + k; const int off = (tt >= 0 ? 90624 : haloff) + tt * 656 + (5 * w + it) * 16; rws[it][k] = *(const u32x4*)(shm + off); }
#pragma unroll
            for (int it = 0; it < 5; ++it) {
                const int cv = 5 * w + it; const int ch = SSD_CH(cv);
                float v[8];
#pragma unroll
                for (int j = 0; j < 8; ++j) v[j] = cb4[ch + j];
#pragma unroll
                for (int k = 0; k < 4; ++k) { float rw[8]; unpack8(rws[it][k], rw);
#pragma unroll
                    for (int j = 0; j < 8; ++j) v[j] += cw4[k * 4096 + ch + j] * rw[j]; }
#pragma unroll
                for (int j = 0; j < 8; ++j) { const float sv = silu_f(v[j]); v[j] = t < nvalid ? sv : 0.f; }
                if (cv < 8) {
#pragma unroll
                    for (int j = 0; j < 8; ++j) XT[(cv * 8 + j) * 72 + t] = f2bf(v[j]);
                } else if (cv < 24) {
                    const int cc = (cv - 8) * 8; const u32x4 pk = pack8(v);
                    *(u32x4*)(Bs + t * 136 + cc) = pk;
#pragma unroll
                    for (int j = 0; j < 8; ++j) BT[(cc + j) * 72 + t] = (bf16_t)((j & 1) ? (pk[j >> 1] >> 16) : (pk[j >> 1] & 0xffffu));
                } else {
                    const int cc = (cv - 24) * 8;
                    *(u32x4*)(Cs + t * 136 + cc) = pack8(v);
                }
            }
        }
        LBAR;
        f32x4 yo[2] = {(f32x4){0.f, 0.f, 0.f, 0.f}, (f32x4){0.f, 0.f, 0.f, 0.f}};
        {
            const int i = 16 * ib + r;
            bf16x8 fC[4], fH[2][4], fB[2][4], fXT[2], fBT[4][2]; f32x4 aj[2], dj[2], sc[2][2];
#pragma unroll
            for (int ks = 0; ks < 4; ++ks) { fC[ks] = ldfrag(Cs, 136, 16 * ib, 32 * ks, lane);
#pragma unroll
                for (int tt = 0; tt < 2; ++tt) { fH[tt][ks] = ldfrag(Hs, 136, 16 * (pb0 + tt), 32 * ks, lane); fB[tt][ks] = ldfrag(Bs, 136, 16 * (pb0 + tt), 32 * ks, lane); } }
#pragma unroll
            for (int ks = 0; ks < 2; ++ks) { fXT[ks] = ldfrag(XT, 72, 16 * pbS, 32 * ks, lane); sc[ks][0] = *(const f32x4*)(scs + 32 * ks + 8 * q); sc[ks][1] = *(const f32x4*)(scs + 32 * ks + 8 * q + 4);
#pragma unroll
                for (int tt = 0; tt < 4; ++tt) fBT[tt][ks] = ldfrag(BT, 72, 16 * (nb0 + tt), 32 * ks, lane); }
#pragma unroll
            for (int tt = 0; tt < 2; ++tt) { aj[tt] = *(const f32x4*)(acss + 16 * (pb0 + tt) + 4 * q); dj[tt] = *(const f32x4*)(dts + 16 * (pb0 + tt) + 4 * q); }
            const float ai = acss[i]; const float cd = __expf(acss[63]);
            asm volatile("" ::: "memory");
            f32x4 gg[2] = {(f32x4){0.f, 0.f, 0.f, 0.f}, (f32x4){0.f, 0.f, 0.f, 0.f}};
#pragma unroll
            for (int ks = 0; ks < 4; ++ks)
#pragma unroll
                for (int tt = 0; tt < 2; ++tt) { yo[tt] = mma16(fH[tt][ks], fC[ks], yo[tt]); gg[tt] = mma16(fB[tt][ks], fC[ks], gg[tt]); }
#pragma unroll
            for (int tt = 0; tt < 4; ++tt) hacc[tt] *= cd;
#pragma unroll
            for (int ks = 0; ks < 2; ++ks) {
                const bf16x8 xr = fXT[ks];
                float xf[8]; u32x4 xu; xu.x = (unsigned)(unsigned short)xr[0] | ((unsigned)(unsigned short)xr[1] << 16); xu.y = (unsigned)(unsigned short)xr[2] | ((unsigned)(unsigned short)xr[3] << 16);
                xu.z = (unsigned)(unsigned short)xr[4] | ((unsigned)(unsigned short)xr[5] << 16); xu.w = (unsigned)(unsigned short)xr[6] | ((unsigned)(unsigned short)xr[7] << 16);
                unpack8(xu, xf);
#pragma unroll
                for (int e = 0; e < 4; ++e) { xf[e] *= sc[ks][0][e]; xf[4 + e] *= sc[ks][1][e]; }
                const u32x4 xs = pack8(xf); bf16x8 yf;
#pragma unroll
                for (int e = 0; e < 4; ++e) { yf[2 * e] = (short)(xs[e] & 0xffffu); yf[2 * e + 1] = (short)(xs[e] >> 16); }
#pragma unroll
                for (int tt = 0; tt < 4; ++tt) hacc[tt] = mma16(fBT[tt][ks], yf, hacc[tt]);
            }
#pragma unroll
            for (int tt = 0; tt < 2; ++tt) { const int jb = pb0 + tt; float mv[4];
#pragma unroll
                for (int jj = 0; jj < 4; ++jj) { const int j = 16 * jb + 4 * q + jj; mv[jj] = (j <= i) ? gg[tt][jj] * __expf(fminf(ai - aj[tt][jj], 0.f)) * dj[tt][jj] : 0.f; }
                u32x2 pk; pk.x = pk2(mv[0], mv[1]); pk.y = pk2(mv[2], mv[3]);
                *(u32x2*)(Ms + i * 72 + 16 * jb + 4 * q) = pk; }
        }
        LBAR;
        {
            f32x4 yd[2] = {(f32x4){0.f, 0.f, 0.f, 0.f}, (f32x4){0.f, 0.f, 0.f, 0.f}};
            const int i = 16 * ib + r;
            bf16x8 fM[2], fX2[2][2]; bf16_t xe[2][4];
#pragma unroll
            for (int ks = 0; ks < 2; ++ks) { fM[ks] = ldfrag(Ms, 72, 16 * ib, 32 * ks, lane);
#pragma unroll
                for (int tt = 0; tt < 2; ++tt) fX2[tt][ks] = ldfrag(XT, 72, 16 * (pb0 + tt), 32 * ks, lane); }
#pragma unroll
            for (int tt = 0; tt < 2; ++tt)
#pragma unroll
                for (int jj = 0; jj < 4; ++jj) xe[tt][jj] = XT[(16 * (pb0 + tt) + 4 * q + jj) * 72 + i];
            const float ea = __expf(acss[i]);
            asm volatile("" ::: "memory");
#pragma unroll
            for (int ks = 0; ks < 2; ++ks)
#pragma unroll
                for (int tt = 0; tt < 2; ++tt) yd[tt] = mma16(fX2[tt][ks], fM[ks], yd[tt]);
            const bool valid = i < nvalid; const size_t row = (size_t)(R0 + i);
            float ss = 0.f;
#pragma unroll
            for (int tt = 0; tt < 2; ++tt) { const int pc = 16 * (pb0 + tt) + 4 * q;
                const float gate[4] = {__uint_as_float(gz[tt].x << 16), __uint_as_float(gz[tt].x & 0xffff0000u), __uint_as_float(gz[tt].y << 16), __uint_as_float(gz[tt].y & 0xffff0000u)};
                float y[4];
#pragma unroll
                for (int jj = 0; jj < 4; ++jj) { const float xv = bf2f(xe[tt][jj]); y[jj] = (yd[tt][jj] + ea * yo[tt][jj] + Dh * xv) * gate[jj]; ss += y[jj] * y[jj]; }
                if (valid) { u32x2 pk; pk.x = pk2(y[0], y[1]); pk.y = pk2(y[2], y[3]); *(u32x2*)(mix + row * DMIX + hd * 64 + pc) = pk; } }
            ss += __shfl_xor(ss, 16); ss += __shfl_xor(ss, 32);
            if (q == 0) part[i * 2 + (w & 1)] = ss;
#pragma unroll
            for (int tt = 0; tt < 4; ++tt) { u32x2 pk; pk.x = pk2(hacc[tt][0], hacc[tt][1]); pk.y = pk2(hacc[tt][2], hacc[tt][3]); *(u32x2*)(Hs + (16 * pbS + r) * 136 + 16 * (nb0 + tt) + 4 * q) = pk; }
        }
        LBAR;
        if (tid < nvalid) ssq[(size_t)(R0 + tid) * 32 + hd] = part[2 * tid] + part[2 * tid + 1];
    }
    if (tid < 120) { const int hr = tid / 40, cvv = tid % 40;
        if (cvv < 8 || (hd & 3) == 0) { float f[8]; unpack8(*(const u32x4*)(RAW + (nvalid - 3 + hr) * 328 + cvv * 8), f);
            float* op = POUT + (sample ? O_SCONV + ((size_t)(l * 32 + seq) * 3 + hr) * 4096 : O_PCONV + ((size_t)(l * 4 + seq) * 3 + hr) * 4096) + SSD_CH(cvv);
            *(f32x4*)op = (f32x4){f[0], f[1], f[2], f[3]}; *(f32x4*)(op + 4) = (f32x4){f[4], f[5], f[6], f[7]}; } }
    {
        float* op = POUT + (sample ? O_SSSD + ((size_t)((l * 32 + seq) * 32 + hd) * 64) * 128 : O_PSSD + ((size_t)((l * 4 + seq) * 32 + hd) * 64) * 128);
#pragma unroll
        for (int tt = 0; tt < 4; ++tt) *(f32x4*)(op + (size_t)(16 * pbS + r) * 128 + 16 * (nb0 + tt) + 4 * q) = hacc[tt];
    }
    LBAR;
#undef SSD_CH
}

__device__ __forceinline__ void gmlp_item(const Params& p, int l, bool sample, int idx, unsigned char* shm) {
    KA_INIT; TID_INIT;
    const int lane = tid & 63, w = tid >> 6, r = lane & 15, q = lane >> 4;
    bf16_t* Ws = (bf16_t*)shm;
    bf16_t* VT = (bf16_t*)(shm + 34816);
    float* rs = (float*)(shm + 104448);
    float* pp = rs + 128;
    const bf16_t* proj = (const bf16_t*)(PWS + WS_PROJ); bf16_t* mix = (bf16_t*)(PWS + WS_MIX);
    const int g = idx & 7, blk = idx >> 3, R0 = sample ? TP + blk * 128 : blk * 128;
    const float* wv = PIN(I_GNW) + (size_t)l * 2048 + g * 256;
#pragma unroll
    for (int hh = 0; hh < 2; ++hh) { const int j = hh * 64 + lane; float ss = 0.f;
#pragma unroll
        for (int cc = 0; cc < 4; ++cc) { const int cv = 4 * w + cc; const u32x4 raw = *(const u32x4*)(proj + (size_t)(R0 + j) * NPROJ + 8192 + g * 256 + 8 * cv);
            float f[8]; unpack8(raw, f);
#pragma unroll
            for (int e = 0; e < 8; ++e) { ss += f[e] * f[e]; VT[(8 * cv + e) * 136 + j] = (bf16_t)((e & 1) ? (raw[e >> 1] >> 16) : (raw[e >> 1] & 0xffffu)); } }
        pp[j * 8 + w] = ss; }
    LBAR;
    if (tid < 128) { float s = 0.f;
#pragma unroll
        for (int k = 0; k < 8; ++k) s += pp[tid * 8 + k];
        rs[tid] = rsqrtf(s * (1.0f / 256.f) + EPS); }
    LBAR;
    {
        const int i = tid >> 2, jq = (tid & 3) * 32;
        const float* wsrc = PIN(I_GWS) + (size_t)(l * 8 + g) * 128 * 128;
#pragma unroll
        for (int jv = 0; jv < 8; ++jv) { const int j = jq + 4 * jv; f32x4 w4 = (f32x4){0.f, 0.f, 0.f, 0.f};
            if (!sample) { if ((j >> 6) <= (i >> 6)) w4 = *(const f32x4*)(wsrc + i * 128 + j); }
            else { if ((j >> 4) == (i >> 4)) w4 = *(const f32x4*)(wsrc + (i & 15) * 128 + (j & 15)); }
            u32x2 pk; pk.x = pk2(w4[0] * rs[j], w4[1] * rs[j + 1]); pk.y = pk2(w4[2] * rs[j + 2], w4[3] * rs[j + 3]);
            *(u32x2*)(Ws + i * 136 + j) = pk; }
        if (sample) {
#pragma unroll 1
            for (int k = 0; k < 8; ++k) { const int cvv = tid & 31, j = (tid >> 5) + 16 * k; const u32x4 raw = *(const u32x4*)(proj + (size_t)(R0 + j) * NPROJ + 8192 + g * 256 + 8 * cvv);
                float f[8]; unpack8(raw, f); const float rj = rs[j]; const int s = blk * 8 + (j >> 4), t = j & 15;
                float* op = POUT + O_SV + ((size_t)((l * 32 + s) * 16 + t)) * 2048 + g * 256 + 8 * cvv;
                const f32x4 w0 = *(const f32x4*)(wv + 8 * cvv), w1 = *(const f32x4*)(wv + 8 * cvv + 4);
                *(f32x4*)op = (f32x4){f[0] * rj * w0[0], f[1] * rj * w0[1], f[2] * rj * w0[2], f[3] * rj * w0[3]};
                *(f32x4*)(op + 4) = (f32x4){f[4] * rj * w1[0], f[5] * rj * w1[1], f[6] * rj * w1[2], f[7] * rj * w1[3]}; }
        }
    }
    LBAR;
    {
        const int ib = w, i = 16 * ib + r; const size_t row = (size_t)(R0 + i);
        const int nks = (!sample && ib < 4) ? 2 : 4;
        bf16x8 yf[4];
#pragma unroll
        for (int ks = 0; ks < 4; ++ks) yf[ks] = ldfrag(Ws, 136, 16 * ib, 32 * ks, lane);
        const float bias = PIN(I_GBS)[(size_t)(l * 8 + g) * 128 + (sample ? (i & 15) : i)];
        u32x2 uzr[16];
#pragma unroll
        for (int db = 0; db < 16; ++db) uzr[db] = *(const u32x2*)(proj + row * NPROJ + 6144 + g * 256 + 16 * db + 4 * q);
#pragma unroll
        for (int db = 0; db < 16; ++db) { f32x4 acc = (f32x4){0.f, 0.f, 0.f, 0.f};
#pragma unroll
            for (int ks = 0; ks < 4; ++ks) if (ks < nks) acc = mma16(ldfrag(VT, 136, 16 * db, 32 * ks, lane), yf[ks], acc);
            const int d = 16 * db + 4 * q; const f32x4 w4 = *(const f32x4*)(wv + d);
            const u32x2 uz = uzr[db];
            const float uu[4] = {__uint_as_float(uz.x << 16), __uint_as_float(uz.x & 0xffff0000u), __uint_as_float(uz.y << 16), __uint_as_float(uz.y & 0xffff0000u)};
            float y[4];
#pragma unroll
            for (int jj = 0; jj < 4; ++jj) y[jj] = (acc[jj] * w4[jj] + bias) * uu[jj];
            u32x2 pk; pk.x = pk2(y[0], y[1]); pk.y = pk2(y[2], y[3]);
            *(u32x2*)(mix + row * DMIX + 2048 + g * 256 + d) = pk; }
    }
    LBAR;
}

__device__ __forceinline__ void phase_sn(const Params& p, int l) {
    KA_INIT; TID_INIT;
    bf16_t* mix = (bf16_t*)(PWS + WS_MIX); const float* ssq = (const float*)(PWS + WS_SSQ); const float* nw = PIN(I_SNW) + (size_t)l * 2048;
    const int nth = gridDim.x * 512;
    for (int idx0 = blockIdx.x * 512 + tid; idx0 < T * 256; idx0 += 4 * nth) {
        u32x4 raw[4]; f32x4 s4[4], w0[4], w1[4];
#pragma unroll
        for (int u = 0; u < 4; ++u) { const int idx = idx0 + u * nth; if (idx < T * 256) { const int row = idx >> 8, col = (idx & 255) * 8, g = col >> 8;
            s4[u] = *(const f32x4*)(ssq + (size_t)row * 32 + 4 * g); raw[u] = *(const u32x4*)(mix + (size_t)row * DMIX + col); w0[u] = *(const f32x4*)(nw + col); w1[u] = *(const f32x4*)(nw + col + 4); } }
#pragma unroll
        for (int u = 0; u < 4; ++u) { const int idx = idx0 + u * nth; if (idx < T * 256) { const int row = idx >> 8, col = (idx & 255) * 8;
            const float rstd = rsqrtf((s4[u][0] + s4[u][1] + s4[u][2] + s4[u][3]) * (1.0f / 256.f) + EPS);
            float f[8]; unpack8(raw[u], f);
#pragma unroll
            for (int j = 0; j < 4; ++j) { f[j] *= rstd * w0[u][j]; f[4 + j] *= rstd * w1[u][j]; }
            *(u32x4*)(mix + (size_t)row * DMIX + col) = pack8(f); } }
    }
}

__device__ __forceinline__ void phase_e2(const Params& p, int l) {
    KA_INIT; TID_INIT;
    const bf16_t* up = (const bf16_t*)(PWS + WS_PROJ); bf16_t* act = (bf16_t*)(PWS + WS_MIX);
    const float* fw = PIN(I_FCW) + (size_t)l * 3 * DUP; const float* fb = PIN(I_FCB) + (size_t)l * DUP;
    const int nth = gridDim.x * 512;
    for (int idx = blockIdx.x * 512 + tid; idx < 1088 * 704; idx += nth) {
        const int f8 = idx % 704, rb = idx / 704, r0 = rb * 8, ch = f8 * 8;
        const bool sample = r0 >= TP; const int s = (r0 - TP) >> 4;
        const bool seqstart = sample ? ((r0 & 15) == 0) : ((r0 & 2047) == 0);
        const bool seqend = sample ? ((r0 & 15) == 8) : ((r0 & 2047) == 2040);
        u32x4 rg[10], rl[10];
#pragma unroll
        for (int k = 0; k < 10; ++k) { rg[k] = (u32x4){0u, 0u, 0u, 0u}; rl[k] = (u32x4){0u, 0u, 0u, 0u};
            if (k >= 2 || !seqstart) { rg[k] = *(const u32x4*)(up + (size_t)(r0 - 2 + k) * DUP + ch); rl[k] = *(const u32x4*)(up + (size_t)(r0 - 2 + k) * DUP + DFF + ch); } }
        float wg[3][8], wl[3][8], bg[8], bl[8];
#pragma unroll
        for (int k = 0; k < 3; ++k) { const f32x4 a0 = *(const f32x4*)(fw + k * DUP + ch), a1 = *(const f32x4*)(fw + k * DUP + ch + 4), c0 = *(const f32x4*)(fw + k * DUP + DFF + ch), c1 = *(const f32x4*)(fw + k * DUP + DFF + ch + 4);
#pragma unroll
            for (int j = 0; j < 4; ++j) { wg[k][j] = a0[j]; wg[k][4 + j] = a1[j]; wl[k][j] = c0[j]; wl[k][4 + j] = c1[j]; } }
        { const f32x4 a0 = *(const f32x4*)(fb + ch), a1 = *(const f32x4*)(fb + ch + 4), c0 = *(const f32x4*)(fb + DFF + ch), c1 = *(const f32x4*)(fb + DFF + ch + 4);
#pragma unroll
            for (int j = 0; j < 4; ++j) { bg[j] = a0[j]; bg[4 + j] = a1[j]; bl[j] = c0[j]; bl[4 + j] = c1[j]; } }
        float pg[2][8], pl[2][8];
#pragma unroll
        for (int k = 0; k < 2; ++k) { unpack8(rg[k], pg[k]); unpack8(rl[k], pl[k]);
            if (seqstart && sample) { const float* sp = PIN(I_SFFN) + ((size_t)(l * 32 + s) * 2 + k) * DUP + ch;
#pragma unroll
                for (int j = 0; j < 8; ++j) { pg[k][j] = sp[j]; pl[k][j] = sp[DFF + j]; } } }
#pragma unroll
        for (int rr = 0; rr < 8; ++rr) {
            float cg_[8], cl[8], o[8];
            unpack8(rg[rr + 2], cg_); unpack8(rl[rr + 2], cl);
#pragma unroll
            for (int j = 0; j < 8; ++j) {
                const float a = bg[j] + wg[0][j] * pg[0][j] + wg[1][j] * pg[1][j] + wg[2][j] * cg_[j];
                const float b = bl[j] + wl[0][j] * pl[0][j] + wl[1][j] * pl[1][j] + wl[2][j] * cl[j];
                o[j] = silu_f(a) * b;
                pg[0][j] = pg[1][j]; pg[1][j] = cg_[j]; pl[0][j] = pl[1][j]; pl[1][j] = cl[j];
            }
            *(u32x4*)(act + (size_t)(r0 + rr) * DFF + ch) = pack8(o);
            if (seqend && rr >= 6) {
                float* op = POUT + (sample ? O_SFFN + ((size_t)(l * 32 + s) * 2 + (rr - 6)) * DUP : O_PFFN + ((size_t)(l * 4 + (r0 >> 11)) * 2 + (rr - 6)) * DUP) + ch;
                *(f32x4*)op = (f32x4){cg_[0], cg_[1], cg_[2], cg_[3]}; *(f32x4*)(op + 4) = (f32x4){cg_[4], cg_[5], cg_[6], cg_[7]};
                *(f32x4*)(op + DFF) = (f32x4){cl[0], cl[1], cl[2], cl[3]}; *(f32x4*)(op + DFF + 4) = (f32x4){cl[4], cl[5], cl[6], cl[7]};
            }
        }
    }
}

__device__ __forceinline__ void run_g1(LAS unsigned char* lds, const bf16_t* A, const bf16_t* Bt, bf16_t* P, float* DT, const float* dtb) {
    pg8::StaticOrder S; S.init(T, NINP, gridDim.x, blockIdx.x); S.nkt = DM / 64; pg8::Gemm g{A, Bt, T, NINP, DM}; EpiG1 E{P, DT, dtb}; pg8::gemm_phase(lds, g, S, E); }
__device__ __forceinline__ void run_gx(LAS unsigned char* lds, const bf16_t* A, const bf16_t* Bt, float* X, float* SL, int K, int ns) {
    pg8::HybridOrder S; S.init(K, ns, gridDim.x, blockIdx.x); pg8::Gemm g{A, Bt, T, DM, K}; EpiX E{X, SL}; pg8::gemm_phase(lds, g, S, E); }
__device__ __forceinline__ void run_g3(LAS unsigned char* lds, const bf16_t* A, const bf16_t* Bt, bf16_t* U) {
    pg8::StaticOrder S; S.init(T, DUP, gridDim.x, blockIdx.x); S.nkt = DM / 64; pg8::Gemm g{A, Bt, T, DUP, DM}; EpiUp E{U}; pg8::gemm_phase(lds, g, S, E); }
#ifndef EN_PREP
#define EN_PREP 1
#endif
#ifndef EN_GEMM
#define EN_GEMM 15
#endif
#ifndef EN_SSD
#define EN_SSD 1
#endif
#ifndef EN_GMLP
#define EN_GMLP 1
#endif
#ifndef EN_SN
#define EN_SN 1
#endif
#ifndef EN_E2
#define EN_E2 1
#endif
#if PROBE
#define MARK(cls) do { if (blockIdx.x == 0 && threadIdx.x == 0) { const unsigned long long t_ = __builtin_amdgcn_s_memrealtime(); const unsigned d_ = (unsigned)(t_ - t_prev); t_prev = t_; \
    if (PROBE_A & (1 << (cls))) accA += d_; if (PROBE_B & (1 << (cls))) accB += d_; } } while (0)
#else
#define MARK(cls) do { } while (0)
#endif
#define WSP(T_, off) ((T_*)(PWS + (off)))
constexpr size_t WS_BAR = WS_END;
constexpr size_t WS_BAR_BYTES = 16384;
constexpr size_t WS_TOTAL = WS_END + WS_BAR_BYTES;
#define XB_TMO      128
#define XB_XCNT(j)  (256  + 64 * (j))
#define XB_XSUB(j)  (1280 + 64 * (j))
#define XB_XGEN(j)  (2304 + 64 * (j))
#define XB_TOP      3328
#define XB_TOPGEN   3392
#define XB_SPIN_CAP (1u << 18)
__device__ __forceinline__ unsigned xb_ld(unsigned* p)              { return __hip_atomic_load(p, __ATOMIC_RELAXED, __HIP_MEMORY_SCOPE_AGENT); }
__device__ __forceinline__ unsigned xb_add(unsigned* p, unsigned v) { return __hip_atomic_fetch_add(p, v, __ATOMIC_RELAXED, __HIP_MEMORY_SCOPE_AGENT); }
__device__ __forceinline__ unsigned xb_xcc_id() { return (unsigned)__builtin_amdgcn_s_getreg((3 << 11) | 20) & 0xFu; }
#define XB_SPIN(cond, bar) do { unsigned _sp = 0; while (cond) { __builtin_amdgcn_s_sleep(1); \
    if ((++_sp & 255u) == 0u) { if (xb_ld(&(bar)[XB_TMO])) break; if (_sp > XB_SPIN_CAP) { atomicAdd(&(bar)[XB_TMO], 1u); break; } } } } while (0)
__device__ __forceinline__ void xcd_barrier_complete(unsigned* bar, unsigned x, unsigned& nloc, unsigned& nx) {
    const unsigned G = gridDim.x;
    unsigned sum, cnt, mine, sp = 0u;
    for (;;) {
        sum = 0u; cnt = 0u; mine = 0u;
#pragma unroll
        for (unsigned j = 0; j < 16; ++j) { const unsigned c = xb_ld(&bar[XB_XCNT(j)]); sum += c; cnt += (c > 0u) ? 1u : 0u; mine = (j == x) ? c : mine; }
        if (sum == G) break;
        __builtin_amdgcn_s_sleep(1);
        if ((++sp & 255u) == 0u) { if (xb_ld(&bar[XB_TMO])) break; if (sp > XB_SPIN_CAP) { atomicAdd(&bar[XB_TMO], 1u); break; } }
    }
    nloc = mine > 0u ? mine : 1u; nx = cnt > 0u ? cnt : 1u;
}
__device__ __forceinline__ void xcd_barrier(unsigned* bar, volatile LAS unsigned* st) {
    asm volatile("s_waitcnt vmcnt(0)" ::: "memory");
    __syncthreads();
    if (threadIdx.x == 0) {
        const unsigned x = xb_xcc_id();
        __builtin_amdgcn_s_waitcnt(0);
        unsigned nloc = st[0], nx = st[1];
        if (nloc == 0u) { xcd_barrier_complete(bar, x, nloc, nx); st[0] = nloc; st[1] = nx; }
        const unsigned old = xb_add(&bar[XB_XSUB(x)], 1u);
        const unsigned gen = old / nloc;
        if (old + 1u == (gen + 1u) * nloc) {
            __builtin_amdgcn_fence(__ATOMIC_RELEASE, "agent");
            asm volatile("s_waitcnt vmcnt(0)" ::: "memory");
            const unsigned og = xb_add(&bar[XB_TOP], 1u);
            const unsigned tg = og / nx;
            if (og + 1u == (tg + 1u) * nx) xb_add(&bar[XB_TOPGEN], 1u);
            else XB_SPIN(xb_ld(&bar[XB_TOPGEN]) == tg, bar);
            __builtin_amdgcn_fence(__ATOMIC_ACQUIRE, "agent");
            xb_add(&bar[XB_XGEN(x)], 1u);
            asm volatile("s_waitcnt vmcnt(0)" ::: "memory");
        } else {
            XB_SPIN(xb_ld(&bar[XB_XGEN(x)]) == gen, bar);
            __builtin_amdgcn_fence(__ATOMIC_ACQUIRE, "agent");
            asm volatile("s_waitcnt vmcnt(0)" ::: "memory");
        }
    }
    __syncthreads();
}
#define GSYNC do { KA_INIT; xcd_barrier((unsigned*)(PWS + WS_BAR), (volatile LAS unsigned*)((LAS unsigned char*)shm + 147456)); } while (0)
__global__ void __launch_bounds__(512, 2) fwd_kernel(Params p) {
    extern __shared__ __attribute__((aligned(16))) unsigned char shm[];
    { KA_INIT;
      volatile LAS unsigned* st = (volatile LAS unsigned*)((LAS unsigned char*)shm + 147456);
      if (threadIdx.x == 0) { st[0] = 0u; st[1] = 0u; (void)xb_add(&((unsigned*)(PWS + WS_BAR))[XB_XCNT(xb_xcc_id())], 1u); }
      __syncthreads(); }
#if PROBE
    unsigned long long t_prev = __builtin_amdgcn_s_memrealtime(); unsigned accA = 0, accB = 0;
#endif
    { KA_INIT; if (PWS == nullptr) cg::this_grid().sync(); }
    for (int l = 0; l < 2; ++l) {
#if EN_PREP
        { KA_INIT;
        convert_w(PIN(I_WIN) + (size_t)l * DM * DIN, DM, DIN, WSP(bf16_t, WS_WIN), NINP, 1, shm);
        convert_w(PIN(I_WOUT) + (size_t)l * DMIX * DM, DMIX, DM, WSP(bf16_t, WS_WOUT), DM, 0, shm);
        convert_w(PIN(I_WUP) + (size_t)l * DM * DUP, DM, DUP, WSP(bf16_t, WS_WUP), DUP, 0, shm);
        convert_w(PIN(I_WDN) + (size_t)l * DFF * DM, DFF, DM, WSP(bf16_t, WS_WDN), DM, 0, shm);
        if (l == 0) phase_norm<0>(p, PIN(I_N1W), 0, shm); else phase_norm<1>(p, PIN(I_N1W) + DM, 11, shm); }
#endif
        GSYNC;
        MARK(0);
        if (EN_GEMM & 1) { KA_INIT; run_g1((LAS unsigned char*)shm, WSP(bf16_t, WS_H), WSP(bf16_t, WS_WIN), WSP(bf16_t, WS_PROJ), WSP(float, WS_DT), PIN(I_DTB) + l * 32); }
        GSYNC; MARK(1);
        {
            const int step = blockIdx.x < 128 ? (1 << 20) : (int)gridDim.x - 128;
            if (EN_SSD) for (int it = blockIdx.x; it < 1152; it += step) { const bool smp = it >= 128; ssd_chain(p, l, smp, smp ? (it - 128) >> 5 : it >> 5, it & 31, shm); }
            if (EN_GMLP) if (blockIdx.x >= 128) for (int it = blockIdx.x - 128; it < 544; it += step) { const bool smp = it >= 512; gmlp_item(p, l, smp, smp ? it - 512 : it, shm); }
        }
        GSYNC; MARK(2);
        if (EN_SN) phase_sn(p, l);
        GSYNC; MARK(3);
        if (EN_GEMM & 2) { KA_INIT; run_gx((LAS unsigned char*)shm, WSP(bf16_t, WS_MIX), WSP(bf16_t, WS_WOUT), WSP(float, WS_X), WSP(float, WS_PROJ), DMIX, 16); }
        GSYNC; MARK(4);
        { KA_INIT; phase_norm<1>(p, PIN(I_N2W) + (size_t)l * DM, 16, shm); }
        GSYNC; MARK(5);
        if (EN_GEMM & 4) { KA_INIT; run_g3((LAS unsigned char*)shm, WSP(bf16_t, WS_H), WSP(bf16_t, WS_WUP), WSP(bf16_t, WS_PROJ)); }
        GSYNC; MARK(6);
        if (EN_E2) phase_e2(p, l);
        GSYNC; MARK(7);
        if (EN_GEMM & 8) { KA_INIT; run_gx((LAS unsigned char*)shm, WSP(bf16_t, WS_MIX), WSP(bf16_t, WS_WDN), WSP(float, WS_X), WSP(float, WS_PROJ), DFF, 11); }
        GSYNC; MARK(8);
    }
#if PROBE
    float addA = 0.f;
    if (blockIdx.x == 0 && threadIdx.x == 0) { KA_INIT; addA = 10.f + (float)accA * (0.01f / 150.f); float* q_ = POUT + O_PCONV; *q_ = *q_ + 4.f + (float)accB * (0.01f / 1000.f); }
    { KA_INIT; phase_norm<2>(p, PIN(I_FNW), 11, shm, addA); }
#else
    { KA_INIT; phase_norm<2>(p, PIN(I_FNW), 11, shm); }
#endif
}

extern "C" void kernel_launch(void* const* d_in, const int* in_sizes, int n_in, void* d_out, int out_size, void* d_ws, size_t ws_size, hipStream_t stream) {
    static int grid = 0;
    if (grid == 0) {
        if (n_in != 23 || ws_size < WS_TOTAL) { fprintf(stderr, "kernel_launch: n_in %d ws %zu (need %zu)\n", n_in, ws_size, (size_t)WS_TOTAL); grid = -1; return; }
        int dev = 0, cus = 0, per_cu = 0;
        hipGetDevice(&dev); hipDeviceGetAttribute(&cus, hipDeviceAttributeMultiprocessorCount, dev);
        hipFuncSetAttribute((const void*)fwd_kernel, hipFuncAttributeMaxDynamicSharedMemorySize, LDS_BYTES);
        hipOccupancyMaxActiveBlocksPerMultiprocessor(&per_cu, (const void*)fwd_kernel, 512, LDS_BYTES);
        (void)hipGetLastError();
        if (per_cu < 1) per_cu = 1;
        grid = cus;
        if (grid < 129) { fprintf(stderr, "kernel_launch: needs > 128 CUs\n"); grid = -1; return; }
    }
    if (grid < 0) return;
    (void)hipMemsetAsync((unsigned char*)d_ws + WS_BAR, 0, WS_BAR_BYTES, stream);
    Params p{};
    for (int i = 0; i < 23; ++i) p.in[i] = (const float*)d_in[i];
    p.out = (float*)d_out; p.ws = (unsigned char*)d_ws;
    void* args[] = {&p};
    hipError_t e = hipLaunchCooperativeKernel((const void*)fwd_kernel, dim3(grid), dim3(512), args, LDS_BYTES, stream);
    if (e != hipSuccess) fprintf(stderr, "cooperative launch failed: %s (grid %d)\n", hipGetErrorString(e), grid);
}
```

```cpp
#include <hip/hip_runtime.h>
#include <hip/hip_cooperative_groups.h>
#include <cstdio>
namespace cg = cooperative_groups;

#define LAS __attribute__((address_space(3)))
typedef unsigned short bf16_t;
typedef short bf16x8 __attribute__((ext_vector_type(8)));
typedef float f32x4 __attribute__((ext_vector_type(4)));
typedef unsigned u32x4 __attribute__((ext_vector_type(4)));
typedef unsigned u32x2 __attribute__((ext_vector_type(2)));

#ifndef PROBE_A
#define PROBE_A 0
#endif
#ifndef PROBE_B
#define PROBE_B 0
#endif
#define PROBE (PROBE_A | PROBE_B)
constexpr int TP = 8192, TS = 512, T = 8704;
constexpr int DM = 2048, NPROJ = 10240, NINP = 10496, DIN = 10272;
constexpr int DMIX = 4096, DFF = 5632, DUP = 11264;
constexpr float EPS = 1e-6f;
constexpr size_t WS_WIN = 0;
constexpr size_t WS_WOUT = WS_WIN + (size_t)NINP * DM * 2;
constexpr size_t WS_WUP = WS_WOUT + (size_t)DM * DMIX * 2;
constexpr size_t WS_WDN = WS_WUP + (size_t)DUP * DM * 2;
constexpr size_t WS_X = WS_WDN + (size_t)DM * DFF * 2;
constexpr size_t WS_H = WS_X + (size_t)T * DM * 4;
constexpr size_t WS_PROJ = WS_H + (size_t)T * DM * 2;
constexpr size_t WS_MIX = WS_PROJ + (size_t)T * DUP * 2;
constexpr size_t WS_DT = WS_MIX + (size_t)T * DFF * 2;
constexpr size_t WS_SSQ = WS_DT + (size_t)T * 32 * 4;
constexpr size_t WS_END = WS_SSQ + (size_t)T * 32 * 4;
constexpr size_t O_YP = 0, O_PCONV = 17825792, O_PSSD = 17924096, O_PFFN = 20021248, O_SCONV = 20201472, O_SSSD = 20987904, O_SFFN = 37765120, O_SV = 39206912;
constexpr int LDS_BYTES = 147456 + 256;

struct Params { const float* in[23]; float* out; unsigned char* ws; };
typedef const unsigned char __attribute__((address_space(4)))* kaptr_t;
#define KA_INIT kaptr_t ka_ = (kaptr_t)__builtin_amdgcn_kernarg_segment_ptr(); asm volatile("" : "+s"(ka_))
#define PIN(i) (*(const float* const __attribute__((address_space(4)))*)(ka_ + 8 * (i)))
#define POUT ((float*)PIN(23))
#define PWS ((unsigned char*)PIN(24))
#define TID_INIT int tid = threadIdx.x; asm volatile("" : "+v"(tid))
enum { I_XP = 0, I_XS, I_SCONV, I_SSSD, I_SFFN, I_N1W, I_WIN, I_CW, I_CB, I_DTB, I_ALOG, I_D, I_SNW, I_GNW, I_GWS, I_GBS, I_WOUT, I_N2W, I_WUP, I_FCW, I_FCB, I_WDN, I_FNW };

__device__ __forceinline__ float bf2f(bf16_t b) { return __uint_as_float(((unsigned)b) << 16); }
__device__ __forceinline__ unsigned pk2(float lo, float hi) { unsigned r; asm volatile("v_cvt_pk_bf16_f32 %0, %1, %2" : "=v"(r) : "v"(lo), "v"(hi)); return r; }
__device__ __forceinline__ bf16_t f2bf(float f) { return (bf16_t)(pk2(f, 0.f) & 0xffffu); }
__device__ __forceinline__ void unpack8(u32x4 v, float* f) {
#pragma unroll
    for (int i = 0; i < 4; ++i) { f[2 * i] = __uint_as_float(v[i] << 16); f[2 * i + 1] = __uint_as_float(v[i] & 0xffff0000u); }
}
__device__ __forceinline__ u32x4 pack8(const float* f) { u32x4 r; r.x = pk2(f[0], f[1]); r.y = pk2(f[2], f[3]); r.z = pk2(f[4], f[5]); r.w = pk2(f[6], f[7]); return r; }
__device__ __forceinline__ float silu_f(float x) { return x * __builtin_amdgcn_rcpf(1.0f + __expf(-x)); }
__device__ __forceinline__ float gelu_f(float x) { const float t = 1.5957691216057308f * (x + 0.044715f * x * x * x); return x * __builtin_amdgcn_rcpf(1.0f + __expf(-t)); }
__device__ __forceinline__ float softplus_f(float x) { return x > 20.f ? x : __logf(1.0f + __expf(x)); }
__device__ __forceinline__ float wave_sum(float v) {
#pragma unroll
    for (int o = 32; o > 0; o >>= 1) v += __shfl_xor(v, o);
    return v;
}

#define LBAR asm volatile("s_waitcnt lgkmcnt(0)\n\ts_barrier" ::: "memory")
namespace pg8 {
constexpr int BM = 256, BK = 64, HALF = 128, HTB = HALF * BK * 2, NXCD = 8, WGM = 8;
__device__ __forceinline__ int lds_byte(int r, int c) { const int st = (r >> 4) * 2 + (c >> 5), rr = r & 15, cc = c & 31, ob = rr * 64 + cc * 2; return st * 1024 + (ob ^ (((ob >> 9) & 1) << 5)); }
__device__ __forceinline__ void stage_rc(int b, int& R, int& C) { const int st = b / 1024, sb = b % 1024, swz = sb ^ (((sb >> 9) & 1) << 5); R = (st >> 1) * 16 + swz / 64; C = (st & 1) * 32 + (swz % 64) / 2; }
__device__ __forceinline__ int perm32(int rho) { const int n = rho >> 4, i = rho & 15; return 8 * (i >> 2) + 4 * n + (i & 3); }
struct Unit { int pm, pn, kt0, nkt, slab; };
struct Gemm { const bf16_t* A; const bf16_t* Bt; int M, N, K; };
struct StaticOrder {
    int nM, nN, nwg, G, c, nkt;
    __device__ void init(int M, int N, int G_, int c_) { nM = M / BM; nN = N / BM; nwg = nM * nN; G = G_; c = c_; nkt = 0; }
    __device__ bool next(int i, Unit& u) const {
        const long L = (long)i * G + c; if (L >= nwg) return false;
        int wgid = (int)L; { const int q = nwg / NXCD, r = nwg % NXCD, xcd = wgid % NXCD, off = wgid / NXCD; wgid = (xcd < r ? xcd * (q + 1) : r * (q + 1) + (xcd - r) * q) + off; }
        const int nig = WGM * nN, gid = wgid / nig, fm = gid * WGM, gsz = (nM - fm) < WGM ? (nM - fm) : WGM;
        u.pm = fm + ((wgid % nig) % gsz); u.pn = (wgid % nig) / gsz; u.kt0 = 0; u.nkt = nkt; u.slab = -1; return true;
    }
};
struct HybridOrder {
    StaticOrder so; int ns, kper, c;
    __device__ void init(int K, int ns_, int G_, int c_) { so.init(TP, DM, G_, c_); so.nkt = K / BK; ns = ns_; kper = K / BK / ns_; c = c_; }
    __device__ bool next(int i, Unit& u) const {
        if (so.next(i, u)) return true;
        const int nmr = c < so.nwg ? (so.nwg - c + so.G - 1) / so.G : 0;
        const long q = (long)(i - nmr) * so.G + c;
        if (i >= nmr && q < 16 * ns) { const int s = (int)q % ns, tile = (int)q / ns; u.pm = 32 + (tile >> 3); u.pn = tile & 7; u.kt0 = s * kper; u.nkt = kper; u.slab = (tile >> 3) * ns + s; return true; }
        return false;
    }
};
template <class Epi, class Sched>
__device__ __forceinline__ void gemm_phase(LAS unsigned char* lds, const Gemm g, const Sched& S, const Epi& E) {
    int tid = threadIdx.x; asm volatile("" : "+v"(tid));
    const int wid = __builtin_amdgcn_readfirstlane(tid >> 6), lane = tid & 63, wr = wid >> 2, wc = wid & 3, fr = lane & 15, fq = lane >> 4;
    int K = __builtin_amdgcn_readfirstlane(g.K); asm volatile("" : "+s"(K));
    unsigned voffA[2], voffB[2];
#pragma unroll
    for (int i = 0; i < 2; ++i) { int R, C; stage_rc(tid * 16 + i * 8192, R, C); const int Rb = (R & ~31) + perm32(R & 31);
        voffA[i] = (unsigned)(R * K + C) * 2u; voffB[i] = (unsigned)(Rb * K + C) * 2u; }
    const size_t kstep = (size_t)(BK * 2);
    const size_t hstep = (size_t)HALF * K * 2;
    const size_t tstep = 2 * hstep;
    const unsigned ldsw = (unsigned)wid * 1024u;
    const int aoff = lds_byte(wr * 64 + fr, fq * 8), boff = lds_byte(wc * 32 + fr, fq * 8);
#define PG8_SA(b, h) (((b) * 2 + (h)) * HTB)
#define PG8_SB(b, h) ((4 + (b) * 2 + (h)) * HTB)
#define PG8_STAGE(bufoff, gbase, voff) do { _Pragma("unroll") for (int _i = 0; _i < 2; ++_i) \
        __builtin_amdgcn_global_load_lds((const unsigned*)((const char*)(gbase) + (voff)[_i]), (LAS unsigned*)(lds + (bufoff) + ldsw + _i * 8192), 16, 0, 0); } while (0)
#define PG8_LDA(dst, b, h) do { _Pragma("unroll") for (int m = 0; m < 4; ++m) _Pragma("unroll") for (int k = 0; k < 2; ++k) dst[m][k] = *(const LAS bf16x8*)(lds + PG8_SA(b, h) + aoff + m * 2048 + k * 1024); } while (0)
#define PG8_LDB(dst, b, h) do { _Pragma("unroll") for (int n = 0; n < 2; ++n) _Pragma("unroll") for (int k = 0; k < 2; ++k) dst[n][k] = *(const LAS bf16x8*)(lds + PG8_SB(b, h) + boff + n * 2048 + k * 1024); } while (0)
#define PG8_MMA(ai, bj, At, Bt) do { __builtin_amdgcn_s_setprio(1); _Pragma("unroll") for (int m = 0; m < 4; ++m) _Pragma("unroll") for (int n = 0; n < 2; ++n) _Pragma("unroll") for (int k = 0; k < 2; ++k) \
        acc[ai][bj][m][n] = __builtin_amdgcn_mfma_f32_16x16x32_bf16(Bt[n][k], At[m][k], acc[ai][bj][m][n], 0, 0, 0); __builtin_amdgcn_s_setprio(0); } while (0)
#define PG8_WAIT_V(n) asm volatile("s_waitcnt vmcnt(" #n ")" ::: "memory")
#define PG8_WAIT_L(n) asm volatile("s_waitcnt lgkmcnt(" #n ")" ::: "memory")
#define PG8_BAR __builtin_amdgcn_s_barrier()
#define PG8_SCHED __builtin_amdgcn_sched_barrier(0)
    Unit cur, nxt; int ui = 0;
    if (!S.next(0, cur)) return;
    f32x4 acc[2][2][4][2];
#pragma unroll
    for (int a = 0; a < 2; ++a)
#pragma unroll
        for (int b = 0; b < 2; ++b)
#pragma unroll
            for (int m = 0; m < 4; ++m)
#pragma unroll
                for (int n = 0; n < 2; ++n) acc[a][b][m][n] = (f32x4){0.f, 0.f, 0.f, 0.f};
    bf16x8 At[4][2], B0[2][2], B1[2][2];
    const char* cA = (const char*)g.A + (size_t)cur.pm * tstep + (size_t)cur.kt0 * kstep; const char* cB = (const char*)g.Bt + (size_t)cur.pn * tstep + (size_t)cur.kt0 * kstep;
    PG8_STAGE(PG8_SB(0, 0), cB, voffB); PG8_STAGE(PG8_SA(0, 0), cA, voffA); PG8_STAGE(PG8_SB(0, 1), cB + hstep, voffB); PG8_STAGE(PG8_SA(0, 1), cA + hstep, voffA);
    if (wr == 1) PG8_BAR;
    PG8_WAIT_V(4); PG8_BAR;
    PG8_STAGE(PG8_SB(1, 0), cB + kstep, voffB); PG8_STAGE(PG8_SA(1, 0), cA + kstep, voffA); PG8_STAGE(PG8_SB(1, 1), cB + hstep + kstep, voffB);
    PG8_WAIT_V(6); PG8_BAR;
    for (;;) {
        const bool has_next = S.next(ui + 1, nxt);
        const char* nA = has_next ? (const char*)g.A + (size_t)nxt.pm * tstep + (size_t)nxt.kt0 * kstep : cA; const char* nB = has_next ? (const char*)g.Bt + (size_t)nxt.pn * tstep + (size_t)nxt.kt0 * kstep : cB;
        const int nt = cur.nkt;
        for (int t = 0; t < nt; t += 2) {
            const bool last = (t == nt - 2);
            const char* a1 = cA + (size_t)(t + 1) * kstep;
            const char* a2 = last ? nA : cA + (size_t)(t + 2) * kstep; const char* b2 = last ? nB : cB + (size_t)(t + 2) * kstep;
            const char* a3 = a2 + kstep; const char* b3 = b2 + kstep;
            PG8_LDB(B0, 0, 0); PG8_SCHED; PG8_LDA(At, 0, 0); PG8_STAGE(PG8_SA(1, 1), a1 + hstep, voffA);
            PG8_WAIT_L(8); PG8_BAR; PG8_WAIT_L(0); PG8_MMA(0, 0, At, B0); PG8_BAR; PG8_SCHED;
            PG8_LDB(B1, 0, 1); PG8_STAGE(PG8_SB(0, 0), b2, voffB);
            PG8_BAR; PG8_WAIT_L(0); PG8_MMA(0, 1, At, B1); PG8_BAR;
            PG8_LDA(At, 0, 1); PG8_STAGE(PG8_SA(0, 0), a2, voffA);
            PG8_BAR; PG8_WAIT_L(0); PG8_MMA(1, 0, At, B0); PG8_BAR; PG8_SCHED;
            PG8_STAGE(PG8_SB(0, 1), b2 + hstep, voffB);
            PG8_WAIT_V(6); PG8_BAR; PG8_MMA(1, 1, At, B1); PG8_BAR;
            PG8_LDB(B0, 1, 0); PG8_SCHED; PG8_LDA(At, 1, 0); PG8_STAGE(PG8_SA(0, 1), a2 + hstep, voffA);
            PG8_WAIT_L(8); PG8_BAR; PG8_WAIT_L(0); PG8_MMA(0, 0, At, B0); PG8_BAR; PG8_SCHED;
            PG8_LDB(B1, 1, 1); PG8_STAGE(PG8_SB(1, 0), b3, voffB);
            PG8_BAR; PG8_WAIT_L(0); PG8_MMA(0, 1, At, B1); PG8_BAR;
            PG8_LDA(At, 1, 1); PG8_STAGE(PG8_SA(1, 0), a3, voffA);
            PG8_BAR; PG8_WAIT_L(0); PG8_MMA(1, 0, At, B0); PG8_BAR; PG8_SCHED;
            PG8_STAGE(PG8_SB(1, 1), b3 + hstep, voffB);
            PG8_WAIT_V(6); PG8_BAR; PG8_MMA(1, 1, At, B1); PG8_BAR;
        }
        E(acc, cur, wr, wc, fr, fq);
        if (!has_next) break;
#pragma unroll
        for (int a = 0; a < 2; ++a)
#pragma unroll
            for (int b = 0; b < 2; ++b)
#pragma unroll
                for (int m = 0; m < 4; ++m)
#pragma unroll
                    for (int n = 0; n < 2; ++n) acc[a][b][m][n] = (f32x4){0.f, 0.f, 0.f, 0.f};
        cur = nxt; cA = nA; cB = nB; ++ui;
    }
    PG8_WAIT_V(0);
    if (wr == 0) PG8_BAR;
    PG8_BAR;
#undef PG8_SA
#undef PG8_SB
#undef PG8_STAGE
#undef PG8_LDA
#undef PG8_LDB
#undef PG8_MMA
#undef PG8_WAIT_V
#undef PG8_WAIT_L
#undef PG8_BAR
#undef PG8_SCHED
}
}
using pg8::Unit;

struct EpiG1 {
    bf16_t* P; float* DT; const float* dtb;
    __device__ __forceinline__ void operator()(const f32x4 (&acc)[2][2][4][2], const Unit& u, int wr, int wc, int fr, int fq) const {
        const int row0 = u.pm * 256 + wr * 64 + fr;
        if (u.pn < 40) {
            const int mode = u.pn < 8 ? 1 : (u.pn < 24 ? 0 : 2);
            const int col0 = u.pn * 256 + wc * 32 + 8 * fq;
#pragma unroll
            for (int ai = 0; ai < 2; ++ai)
#pragma unroll
                for (int m = 0; m < 4; ++m) { bf16_t* rowp = P + (size_t)(row0 + ai * 128 + m * 16) * NPROJ + col0;
#pragma unroll
                    for (int bj = 0; bj < 2; ++bj) { float v[8];
#pragma unroll
                        for (int j = 0; j < 4; ++j) { v[j] = acc[ai][bj][m][0][j]; v[4 + j] = acc[ai][bj][m][1][j]; }
                        if (mode == 1) {
#pragma unroll
                            for (int j = 0; j < 8; ++j) v[j] = silu_f(v[j]); }
                        else if (mode == 2) {
#pragma unroll
                            for (int j = 0; j < 8; ++j) v[j] = gelu_f(v[j]); }
                        *(u32x4*)(rowp + bj * 128) = pack8(v); } }
        } else if (wc == 0) {
#pragma unroll
            for (int ai = 0; ai < 2; ++ai)
#pragma unroll
                for (int m = 0; m < 4; ++m) { float* rowp = DT + (size_t)(row0 + ai * 128 + m * 16) * 32 + 8 * fq;
#pragma unroll
                    for (int n = 0; n < 2; ++n) { f32x4 o;
#pragma unroll
                        for (int j = 0; j < 4; ++j) o[j] = softplus_f(acc[ai][0][m][n][j] + dtb[8 * fq + 4 * n + j]);
                        *(f32x4*)(rowp + 4 * n) = o; } }
        }
    }
};
struct EpiX {
    float* X; float* SL;
    __device__ __forceinline__ void operator()(const f32x4 (&acc)[2][2][4][2], const Unit& u, int wr, int wc, int fr, int fq) const {
        const int col0 = u.pn * 256 + wc * 32 + 8 * fq;
        if (u.slab < 0) {
            const int row0 = u.pm * 256 + wr * 64 + fr;
#pragma unroll
            for (int ai = 0; ai < 2; ++ai)
#pragma unroll
                for (int m = 0; m < 4; ++m) { float* rowp = X + (size_t)(row0 + ai * 128 + m * 16) * DM + col0;
#pragma unroll
                    for (int bj = 0; bj < 2; ++bj) { f32x4* q = (f32x4*)(rowp + bj * 128); f32x4 a = q[0], b = q[1]; q[0] = a + acc[ai][bj][m][0]; q[1] = b + acc[ai][bj][m][1]; } }
        } else {
            float* base = SL + (size_t)u.slab * 256 * DM; const int row0 = wr * 64 + fr;
#pragma unroll
            for (int ai = 0; ai < 2; ++ai)
#pragma unroll
                for (int m = 0; m < 4; ++m) { float* rowp = base + (size_t)(row0 + ai * 128 + m * 16) * DM + col0;
#pragma unroll
                    for (int bj = 0; bj < 2; ++bj) { f32x4* q = (f32x4*)(rowp + bj * 128); q[0] = acc[ai][bj][m][0]; q[1] = acc[ai][bj][m][1]; } }
        }
    }
};
struct EpiUp {
    bf16_t* U;
    __device__ __forceinline__ void operator()(const f32x4 (&acc)[2][2][4][2], const Unit& u, int wr, int wc, int fr, int fq) const {
        const int row0 = u.pm * 256 + wr * 64 + fr, col0 = u.pn * 256 + wc * 32 + 8 * fq;
#pragma unroll
        for (int ai = 0; ai < 2; ++ai)
#pragma unroll
            for (int m = 0; m < 4; ++m) { bf16_t* rowp = U + (size_t)(row0 + ai * 128 + m * 16) * DUP + col0;
#pragma unroll
                for (int bj = 0; bj < 2; ++bj) { u32x4 w; w.x = pk2(acc[ai][bj][m][0][0], acc[ai][bj][m][0][1]); w.y = pk2(acc[ai][bj][m][0][2], acc[ai][bj][m][0][3]);
                    w.z = pk2(acc[ai][bj][m][1][0], acc[ai][bj][m][1][1]); w.w = pk2(acc[ai][bj][m][1][2], acc[ai][bj][m][1][3]); *(u32x4*)(rowp + bj * 128) = w; } }
    }
};

__device__ __forceinline__ int map_col(int n, int mode) {
    if (mode == 0) return n;
    if (n < 6144) return n; if (n < 10240) return n + 32; if (n < 10272) return n - 10240 + 6144; return -1;
}
__device__ __forceinline__ void convert_w(const float* __restrict__ src, int K, int Nsrc, bf16_t* __restrict__ dst, int Ndst, int mode, unsigned char* shm) {
    float* tile = (float*)shm;
    TID_INIT;
    const int ntn = Ndst / 256, ntk = K / 64, ntile = ntn * ntk;
    const int tkk = tid >> 4, tn4 = tid & 15, wn = tid >> 3, wk8 = tid & 7;
    f32x4 v[4][2];
    int t = blockIdx.x;
#define CW_LOAD(tt_) do { const int tn_ = (tt_) % ntn, tk_ = (tt_) / ntn; \
        _Pragma("unroll") for (int s_ = 0; s_ < 4; ++s_) { const int sc_ = map_col(tn_ * 256 + 64 * s_ + 4 * tn4, mode); \
            _Pragma("unroll") for (int i_ = 0; i_ < 2; ++i_) { v[s_][i_] = (f32x4){0.f, 0.f, 0.f, 0.f}; if (sc_ >= 0) v[s_][i_] = *(const f32x4*)(src + (size_t)(tk_ * 64 + tkk + 32 * i_) * Nsrc + sc_); } } } while (0)
    if (t < ntile) CW_LOAD(t);
    for (; t < ntile; t += gridDim.x) {
        const int tn = t % ntn, tk = t / ntn, n0 = tn * 256, k0 = tk * 64;
#pragma unroll
        for (int s_ = 0; s_ < 4; ++s_)
#pragma unroll
            for (int i = 0; i < 2; ++i)
#pragma unroll
                for (int j = 0; j < 4; ++j) tile[(tkk + 32 * i) * 257 + 64 * s_ + 4 * tn4 + j] = v[s_][i][j];
        LBAR;
        if (t + (int)gridDim.x < ntile) CW_LOAD(t + (int)gridDim.x);
#pragma unroll
        for (int s_ = 0; s_ < 4; ++s_) { float f[8];
#pragma unroll
            for (int j = 0; j < 8; ++j) f[j] = tile[(8 * wk8 + j) * 257 + 64 * s_ + wn];
            *(u32x4*)(dst + (size_t)(n0 + 64 * s_ + wn) * K + k0 + 8 * wk8) = pack8(f); }
        LBAR;
    }
#undef CW_LOAD
}

template <int MODE>
__device__ __forceinline__ void phase_norm(const Params& p, const float* __restrict__ w, int ns, unsigned char* shm, float addA = 0.f) {
    KA_INIT; TID_INIT;
    const int lane = tid & 63, wv_ = tid >> 6, gw = blockIdx.x * 8 + wv_, nw = gridDim.x * 8;
    float* X = (float*)(PWS + WS_X); bf16_t* H = (bf16_t*)(PWS + WS_H);
    const int nrows = ns > 0 ? TP : T;
    for (int row = gw; row < nrows; row += nw) {
        const float* src = MODE == 0 ? (row < TP ? PIN(I_XP) + (size_t)row * DM : PIN(I_XS) + (size_t)(row - TP) * DM) : X + (size_t)row * DM;
        f32x4 v[8]; float ss = 0.f;
#pragma unroll
        for (int i = 0; i < 8; ++i) { v[i] = *(const f32x4*)(src + i * 256 + lane * 4); ss += v[i][0] * v[i][0] + v[i][1] * v[i][1] + v[i][2] * v[i][2] + v[i][3] * v[i][3]; }
        ss = wave_sum(ss);
        const float rstd = rsqrtf(ss * (1.0f / DM) + EPS);
#pragma unroll
        for (int i = 0; i < 8; ++i) { const int c = i * 256 + lane * 4; const f32x4 wv = *(const f32x4*)(w + c);
            if (MODE == 0) *(f32x4*)(X + (size_t)row * DM + c) = v[i];
            f32x4 o = v[i] * rstd * wv;
            if (MODE == 2) { if (PROBE && row == 0 && i == 0 && lane == 0) o[0] += addA; *(f32x4*)(POUT + O_YP + (size_t)row * DM + c) = o; }
            else { u32x2 pk; pk.x = pk2(o[0], o[1]); pk.y = pk2(o[2], o[3]); *(u32x2*)(H + (size_t)row * DM + c) = pk; } }
    }
    if (ns > 0) {
        float* red = (float*)shm; const float* SL = (const float*)(PWS + WS_PROJ);
        for (int r = blockIdx.x; r < TS; r += gridDim.x) {
            const int row = TP + r, pmi = r >> 8, rr = r & 255, c = wv_ * 256 + lane * 4;
            f32x4 v = *(const f32x4*)(X + (size_t)row * DM + c);
            { f32x4 sl[16];
#pragma unroll
              for (int s = 0; s < 16; ++s) { sl[s] = (f32x4){0.f, 0.f, 0.f, 0.f}; if (s < ns) sl[s] = *(const f32x4*)(SL + ((size_t)(pmi * ns + s) * 256 + rr) * DM + c); }
#pragma unroll
              for (int s = 0; s < 16; s += 4) v += (sl[s] + sl[s + 1]) + (sl[s + 2] + sl[s + 3]); }
            float ss = wave_sum(v[0] * v[0] + v[1] * v[1] + v[2] * v[2] + v[3] * v[3]);
            if (lane == 0) red[wv_] = ss;
            __syncthreads();
            ss = red[0] + red[1] + red[2] + red[3] + red[4] + red[5] + red[6] + red[7];
            const float rstd = rsqrtf(ss * (1.0f / DM) + EPS);
            *(f32x4*)(X + (size_t)row * DM + c) = v;
            const f32x4 o = v * rstd * *(const f32x4*)(w + c);
            if (MODE == 2) *(f32x4*)(POUT + O_YP + (size_t)row * DM + c) = o;
            else { u32x2 pk; pk.x = pk2(o[0], o[1]); pk.y = pk2(o[2], o[3]); *(u32x2*)(H + (size_t)row * DM + c) = pk; }
            __syncthreads();
        }
    }
}

__device__ __forceinline__ bf16x8 ldfrag(const bf16_t* base, int ld, int row0, int k0, int lane) { return *(const bf16x8*)(base + (row0 + (lane & 15)) * ld + k0 + (lane >> 4) * 8); }
__device__ __forceinline__ f32x4 mma16(bf16x8 x, bf16x8 y, f32x4 c) { return __builtin_amdgcn_mfma_f32_16x16x32_bf16(x, y, c, 0, 0, 0); }

__device__ __forceinline__ float wave_scan_incl(float s) {
#define DPP_ADD_(ctrl, rmask) { const int t_ = __builtin_amdgcn_update_dpp(0, __float_as_int(s), ctrl, rmask, 0xf, true); s += __int_as_float(t_); }
    DPP_ADD_(0x111, 0xf) DPP_ADD_(0x112, 0xf) DPP_ADD_(0x114, 0xf) DPP_ADD_(0x118, 0xf) DPP_ADD_(0x142, 0xa) DPP_ADD_(0x143, 0xc)
#undef DPP_ADD_
    return s;
}
__device__ __forceinline__ void ssd_chain(const Params& p, int l, bool sample, int seq, int hd, unsigned char* shm) {
    KA_INIT; TID_INIT;
    const int lane = tid & 63, w = __builtin_amdgcn_readfirstlane(tid >> 6), r = lane & 15, q = lane >> 4;
    bf16_t* Cs = (bf16_t*)(shm + 0);
    bf16_t* Bs = (bf16_t*)(shm + 17408);
    bf16_t* BT = (bf16_t*)(shm + 34816);
    bf16_t* XT = (bf16_t*)(shm + 53248);
    bf16_t* Ms = (bf16_t*)(shm + 62464);
    bf16_t* Hs = (bf16_t*)(shm + 71680);
    float* dts = (float*)(shm + 89088);
    float* acss = dts + 64; float* scs = acss + 64; float* part = scs + 64;
    bf16_t* RAW = (bf16_t*)(shm + 90624);
    bf16_t* HALO = (bf16_t*)(shm + 132608);
    float* CWs = (float*)(shm + 136704);
    const bf16_t* proj = (const bf16_t*)(PWS + WS_PROJ); const float* DT = (const float*)(PWS + WS_DT);
    bf16_t* mix = (bf16_t*)(PWS + WS_MIX); float* ssq = (float*)(PWS + WS_SSQ);
    const int g = hd >> 2, nchunk = sample ? 1 : 32, nvalid = sample ? 16 : 64;
    const int rowbase = sample ? TP + seq * 16 : seq * 2048;
    const float Dh = PIN(I_D)[l * 32 + hd];
    const float a_neg = -__expf(PIN(I_ALOG)[l * 32 + hd]);
    const int ib = w >> 1, pb0 = 2 * (w & 1), pbS = w >> 1, nb0 = 4 * (w & 1);
#define SSD_CH(cv) ((cv) < 8 ? hd * 64 + (cv) * 8 : ((cv) < 24 ? 2048 + g * 128 + ((cv) - 8) * 8 : 3072 + g * 128 + ((cv) - 24) * 8))
    typedef const float __attribute__((address_space(4)))* cptr4_t;
    const cptr4_t cw4 = (cptr4_t)(PIN(I_CW) + (size_t)l * 4 * 4096); const cptr4_t cb4 = (cptr4_t)(PIN(I_CB) + (size_t)l * 4096);
    if (tid >= 384 && tid < 384 + 120) { const int e = tid - 384, hr = e / 40, cvv = e % 40; u32x4 hv = (u32x4){0u, 0u, 0u, 0u};
        if (sample) { const float* sp = PIN(I_SCONV) + ((size_t)(l * 32 + seq) * 3 + hr) * 4096 + SSD_CH(cvv); const f32x4 a = *(const f32x4*)sp, b = *(const f32x4*)(sp + 4);
            hv.x = pk2(a[0], a[1]); hv.y = pk2(a[2], a[3]); hv.z = pk2(b[0], b[1]); hv.w = pk2(b[2], b[3]); }
        *(u32x4*)(HALO + (3 + hr) * 328 + cvv * 8) = hv; }
    f32x4 hacc[4];
    {
        const size_t hoff = ((size_t)((l * 32 + seq) * 32 + hd) * 64 + 16 * pbS + r) * 128;
#pragma unroll
        for (int tt = 0; tt < 4; ++tt) {
            f32x4 h = (f32x4){0.f, 0.f, 0.f, 0.f};
            if (sample) h = *(const f32x4*)(PIN(I_SSSD) + hoff + 16 * (nb0 + tt) + 4 * q);
            hacc[tt] = h;
            u32x2 pk; pk.x = pk2(h[0], h[1]); pk.y = pk2(h[2], h[3]);
            *(u32x2*)(Hs + (16 * pbS + r) * 136 + 16 * (nb0 + tt) + 4 * q) = pk;
        }
    }
    u32x4 rawreg[5]; float dtreg = 0.f;
    int goff[5], loff[5];
#pragma unroll
    for (int it = 0; it < 5; ++it) { const int v_ = it * 512 + tid, prow = v_ / 40, pcv = v_ - prow * 40; goff[it] = prow * NPROJ + 2048 + SSD_CH(pcv); loff[it] = prow * 328 + pcv * 8; }
#pragma unroll
    for (int it = 0; it < 5; ++it) { rawreg[it] = (u32x4){0u, 0u, 0u, 0u};
        if (it * 512 + tid < nvalid * 40) rawreg[it] = *(const u32x4*)(proj + (size_t)rowbase * NPROJ + goff[it]); }
    if (w == 7 && lane < nvalid) dtreg = DT[(size_t)(rowbase + lane) * 32 + hd];
    for (int c = 0; c < nchunk; ++c) {
        const int R0 = rowbase + c * 64;
#pragma unroll
        for (int it = 0; it < 5; ++it) *(u32x4*)(RAW + loff[it]) = rawreg[it];
        if (tid >= 392) *(u32x4*)(HALO + ((c & 1) * 3 - 61) * 328 + loff[4]) = rawreg[4];
        if (w == 7) {
            const float dtv = dtreg; const float s = wave_scan_incl(dtv * a_neg);
            const float lastv = __int_as_float(__builtin_amdgcn_readlane(__float_as_int(s), 63));
            dts[lane] = dtv; acss[lane] = s; scs[lane] = dtv * __expf(lastv - s);
        }
        u32x2 gz[2];
        {
            const int i = 16 * ib + r;
#pragma unroll
            for (int tt = 0; tt < 2; ++tt) { gz[tt] = (u32x2){0u, 0u}; if (i < nvalid) gz[tt] = *(const u32x2*)(proj + (size_t)(R0 + i) * NPROJ + hd * 64 + 16 * (pb0 + tt) + 4 * q); }
        }
        if (c + 1 < nchunk) {
#pragma unroll
            for (int it = 0; it < 5; ++it) rawreg[it] = *(const u32x4*)(proj + (size_t)(R0 + 64) * NPROJ + goff[it]);
            if (w == 7) dtreg = DT[(size_t)(R0 + 64 + lane) * 32 + hd];
        }
        LBAR;
        {
            const int t = lane; const int haloff = 132608 + (((c + 1) & 1) * 3 + 3) * 656;
            u32x4 rws[5][4];
#pragma unroll
            for (int it = 0; it < 5; ++it)
#pragma unroll
                for (int k = 0; k < 4; ++k) { const int tt = t - 3 + k; const int off = (tt >= 0 ? 90624 : haloff) + tt * 656 + (5 * w + it) * 16; rws[it][k] = *(const u32x4*)(shm + off); }
#pragma unroll
            for (int it = 0; it < 5; ++it) {
                const int cv = 5 * w + it; const int ch = SSD_CH(cv);
                float v[8];
#pragma unroll
                for (int j = 0; j < 8; ++j) v[j] = cb4[ch + j];
#pragma unroll
                for (int k = 0; k < 4; ++k) { float rw[8]; unpack8(rws[it][k], rw);
#pragma unroll
                    for (int j = 0; j < 8; ++j) v[j] += cw4[k * 4096 + ch + j] * rw[j]; }
#pragma unroll
                for (int j = 0; j < 8; ++j) { const float sv = silu_f(v[j]); v[j] = t < nvalid ? sv : 0.f; }
                if (cv < 8) {
#pragma unroll
                    for (int j = 0; j < 8; ++j) XT[(cv * 8 + j) * 72 + t] = f2bf(v[j]);
                } else if (cv < 24) {
                    const int cc = (cv - 8) * 8; const u32x4 pk = pack8(v);
                    *(u32x4*)(Bs + t * 136 + cc) = pk;
#pragma unroll
                    for (int j = 0; j < 8; ++j) BT[(cc + j) * 72 + t] = (bf16_t)((j & 1) ? (pk[j >> 1] >> 16) : (pk[j >> 1] & 0xffffu));
                } else {
                    const int cc = (cv - 24) * 8;
                    *(u32x4*)(Cs + t * 136 + cc) = pack8(v);
                }
            }
        }
        LBAR;
        f32x4 yo[2] = {(f32x4){0.f, 0.f, 0.f, 0.f}, (f32x4){0.f, 0.f, 0.f, 0.f}};
        {
            const int i = 16 * ib + r;
            bf16x8 fC[4], fH[2][4], fB[2][4], fXT[2], fBT[4][2]; f32x4 aj[2], dj[2], sc[2][2];
#pragma unroll
            for (int ks = 0; ks < 4; ++ks) { fC[ks] = ldfrag(Cs, 136, 16 * ib, 32 * ks, lane);
#pragma unroll
                for (int tt = 0; tt < 2; ++tt) { fH[tt][ks] = ldfrag(Hs, 136, 16 * (pb0 + tt), 32 * ks, lane); fB[tt][ks] = ldfrag(Bs, 136, 16 * (pb0 + tt), 32 * ks, lane); } }
#pragma unroll
            for (int ks = 0; ks < 2; ++ks) { fXT[ks] = ldfrag(XT, 72, 16 * pbS, 32 * ks, lane); sc[ks][0] = *(const f32x4*)(scs + 32 * ks + 8 * q); sc[ks][1] = *(const f32x4*)(scs + 32 * ks + 8 * q + 4);
#pragma unroll
                for (int tt = 0; tt < 4; ++tt) fBT[tt][ks] = ldfrag(BT, 72, 16 * (nb0 + tt), 32 * ks, lane); }
#pragma unroll
            for (int tt = 0; tt < 2; ++tt) { aj[tt] = *(const f32x4*)(acss + 16 * (pb0 + tt) + 4 * q); dj[tt] = *(const f32x4*)(dts + 16 * (pb0 + tt) + 4 * q); }
            const float ai = acss[i]; const float cd = __expf(acss[63]);
            asm volatile("" ::: "memory");
            f32x4 gg[2] = {(f32x4){0.f, 0.f, 0.f, 0.f}, (f32x4){0.f, 0.f, 0.f, 0.f}};
#pragma unroll
            for (int ks = 0; ks < 4; ++ks)
#pragma unroll
                for (int tt = 0; tt < 2; ++tt) { yo[tt] = mma16(fH[tt][ks], fC[ks], yo[tt]); gg[tt] = mma16(fB[tt][ks], fC[ks], gg[tt]); }
#pragma unroll
            for (int tt = 0; tt < 4; ++tt) hacc[tt] *= cd;
#pragma unroll
            for (int ks = 0; ks < 2; ++ks) {
                const bf16x8 xr = fXT[ks];
                float xf[8]; u32x4 xu; xu.x = (unsigned)(unsigned short)xr[0] | ((unsigned)(unsigned short)xr[1] << 16); xu.y = (unsigned)(unsigned short)xr[2] | ((unsigned)(unsigned short)xr[3] << 16);
                xu.z = (unsigned)(unsigned short)xr[4] | ((unsigned)(unsigned short)xr[5] << 16); xu.w = (unsigned)(unsigned short)xr[6] | ((unsigned)(unsigned short)xr[7] << 16);
                unpack8(xu, xf);
#pragma unroll
                for (int e = 0; e < 4; ++e) { xf[e] *= sc[ks][0][e]; xf[4 + e] *= sc[ks][1][e]; }
                const u32x4 xs = pack8(xf); bf16x8 yf;
#pragma unroll
                for (int e = 0; e < 4; ++e) { yf[2 * e] = (short)(xs[e] & 0xffffu); yf[2 * e + 1] = (short)(xs[e] >> 16); }
#pragma unroll
                for (int tt = 0; tt < 4; ++tt) hacc[tt] = mma16(fBT[tt][ks], yf, hacc[tt]);
            }
#pragma unroll
            for (int tt = 0; tt < 2; ++tt) { const int jb = pb0 + tt; float mv[4];
#pragma unroll
                for (int jj = 0; jj < 4; ++jj) { const int j = 16 * jb + 4 * q + jj; mv[jj] = (j <= i) ? gg[tt][jj] * __expf(fminf(ai - aj[tt][jj], 0.f)) * dj[tt][jj] : 0.f; }
                u32x2 pk; pk.x = pk2(mv[0], mv[1]); pk.y = pk2(mv[2], mv[3]);
                *(u32x2*)(Ms + i * 72 + 16 * jb + 4 * q) = pk; }
        }
        LBAR;
        {
            f32x4 yd[2] = {(f32x4){0.f, 0.f, 0.f, 0.f}, (f32x4){0.f, 0.f, 0.f, 0.f}};
            const int i = 16 * ib + r;
            bf16x8 fM[2], fX2[2][2]; bf16_t xe[2][4];
#pragma unroll
            for (int ks = 0; ks < 2; ++ks) { fM[ks] = ldfrag(Ms, 72, 16 * ib, 32 * ks, lane);
#pragma unroll
                for (int tt = 0; tt < 2; ++tt) fX2[tt][ks] = ldfrag(XT, 72, 16 * (pb0 + tt), 32 * ks, lane); }
#pragma unroll
            for (int tt = 0; tt < 2; ++tt)
#pragma unroll
                for (int jj = 0; jj < 4; ++jj) xe[tt][jj] = XT[(16 * (pb0 + tt) + 4 * q + jj) * 72 + i];
            const float ea = __expf(acss[i]);
            asm volatile("" ::: "memory");
#pragma unroll
            for (int ks = 0; ks < 2; ++ks)
#pragma unroll
                for (int tt = 0; tt < 2; ++tt) yd[tt] = mma16(fX2[tt][ks], fM[ks], yd[tt]);
            const bool valid = i < nvalid; const size_t row = (size_t)(R0 + i);
            float ss = 0.f;
#pragma unroll
            for (int tt = 0; tt < 2; ++tt) { const int pc = 16 * (pb0 + tt) + 4 * q;
                const float gate[4] = {__uint_as_float(gz[tt].x << 16), __uint_as_float(gz[tt].x & 0xffff0000u), __uint_as_float(gz[tt].y << 16), __uint_as_float(gz[tt].y & 0xffff0000u)};
                float y[4];
#pragma unroll
                for (int jj = 0; jj < 4; ++jj) { const float xv = bf2f(xe[tt][jj]); y[jj] = (yd[tt][jj] + ea * yo[tt][jj] + Dh * xv) * gate[jj]; ss += y[jj] * y[jj]; }
                if (valid) { u32x2 pk; pk.x = pk2(y[0], y[1]); pk.y = pk2(y[2], y[3]); *(u32x2*)(mix + row * DMIX + hd * 64 + pc) = pk; } }
            ss += __shfl_xor(ss, 16); ss += __shfl_xor(ss, 32);
            if (q == 0) part[i * 2 + (w & 1)] = ss;
#pragma unroll
            for (int tt = 0; tt < 4; ++tt) { u32x2 pk; pk.x = pk2(hacc[tt][0], hacc[tt][1]); pk.y = pk2(hacc[tt][2], hacc[tt][3]); *(u32x2*)(Hs + (16 * pbS + r) * 136 + 16 * (nb0 + tt) + 4 * q) = pk; }
        }
        LBAR;
        if (tid < nvalid) ssq[(size_t)(R0 + tid) * 32 + hd] = part[2 * tid] + part[2 * tid + 1];
    }
    if (tid < 120) { const int hr = tid / 40, cvv = tid % 40;
        if (cvv < 8 || (hd & 3) == 0) { float f[8]; unpack8(*(const u32x4*)(RAW + (nvalid - 3 + hr) * 328 + cvv * 8), f);
            float* op = POUT + (sample ? O_SCONV + ((size_t)(l * 32 + seq) * 3 + hr) * 4096 : O_PCONV + ((size_t)(l * 4 + seq) * 3 + hr) * 4096) + SSD_CH(cvv);
            *(f32x4*)op = (f32x4){f[0], f[1], f[2], f[3]}; *(f32x4*)(op + 4) = (f32x4){f[4], f[5], f[6], f[7]}; } }
    {
        float* op = POUT + (sample ? O_SSSD + ((size_t)((l * 32 + seq) * 32 + hd) * 64) * 128 : O_PSSD + ((size_t)((l * 4 + seq) * 32 + hd) * 64) * 128);
#pragma unroll
        for (int tt = 0; tt < 4; ++tt) *(f32x4*)(op + (size_t)(16 * pbS + r) * 128 + 16 * (nb0 + tt) + 4 * q) = hacc[tt];
    }
    LBAR;
#undef SSD_CH
}

__device__ __forceinline__ void gmlp_item(const Params& p, int l, bool sample, int idx, unsigned char* shm) {
    KA_INIT; TID_INIT;
    const int lane = tid & 63, w = tid >> 6, r = lane & 15, q = lane >> 4;
    bf16_t* Ws = (bf16_t*)shm;
    bf16_t* VT = (bf16_t*)(shm + 34816);
    float* rs = (float*)(shm + 104448);
    float* pp = rs + 128;
    const bf16_t* proj = (const bf16_t*)(PWS + WS_PROJ); bf16_t* mix = (bf16_t*)(PWS + WS_MIX);
    const int g = idx & 7, blk = idx >> 3, R0 = sample ? TP + blk * 128 : blk * 128;
    const float* wv = PIN(I_GNW) + (size_t)l * 2048 + g * 256;
#pragma unroll
    for (int hh = 0; hh < 2; ++hh) { const int j = hh * 64 + lane; float ss = 0.f;
#pragma unroll
        for (int cc = 0; cc < 4; ++cc) { const int cv = 4 * w + cc; const u32x4 raw = *(const u32x4*)(proj + (size_t)(R0 + j) * NPROJ + 8192 + g * 256 + 8 * cv);
            float f[8]; unpack8(raw, f);
#pragma unroll
            for (int e = 0; e < 8; ++e) { ss += f[e] * f[e]; VT[(8 * cv + e) * 136 + j] = (bf16_t)((e & 1) ? (raw[e >> 1] >> 16) : (raw[e >> 1] & 0xffffu)); } }
        pp[j * 8 + w] = ss; }
    LBAR;
    if (tid < 128) { float s = 0.f;
#pragma unroll
        for (int k = 0; k < 8; ++k) s += pp[tid * 8 + k];
        rs[tid] = rsqrtf(s * (1.0f / 256.f) + EPS); }
    LBAR;
    {
        const int i = tid >> 2, jq = (tid & 3) * 32;
        const float* wsrc = PIN(I_GWS) + (size_t)(l * 8 + g) * 128 * 128;
#pragma unroll
        for (int jv = 0; jv < 8; ++jv) { const int j = jq + 4 * jv; f32x4 w4 = (f32x4){0.f, 0.f, 0.f, 0.f};
            if (!sample) { if ((j >> 6) <= (i >> 6)) w4 = *(const f32x4*)(wsrc + i * 128 + j); }
            else { if ((j >> 4) == (i >> 4)) w4 = *(const f32x4*)(wsrc + (i & 15) * 128 + (j & 15)); }
            u32x2 pk; pk.x = pk2(w4[0] * rs[j], w4[1] * rs[j + 1]); pk.y = pk2(w4[2] * rs[j + 2], w4[3] * rs[j + 3]);
            *(u32x2*)(Ws + i * 136 + j) = pk; }
        if (sample) {
#pragma unroll 1
            for (int k = 0; k < 8; ++k) { const int cvv = tid & 31, j = (tid >> 5) + 16 * k; const u32x4 raw = *(const u32x4*)(proj + (size_t)(R0 + j) * NPROJ + 8192 + g * 256 + 8 * cvv);
                float f[8]; unpack8(raw, f); const float rj = rs[j]; const int s = blk * 8 + (j >> 4), t = j & 15;
                float* op = POUT + O_SV + ((size_t)((l * 32 + s) * 16 + t)) * 2048 + g * 256 + 8 * cvv;
                const f32x4 w0 = *(const f32x4*)(wv + 8 * cvv), w1 = *(const f32x4*)(wv + 8 * cvv + 4);
                *(f32x4*)op = (f32x4){f[0] * rj * w0[0], f[1] * rj * w0[1], f[2] * rj * w0[2], f[3] * rj * w0[3]};
                *(f32x4*)(op + 4) = (f32x4){f[4] * rj * w1[0], f[5] * rj * w1[1], f[6] * rj * w1[2], f[7] * rj * w1[3]}; }
        }
    }
    LBAR;
    {
        const int ib = w, i = 16 * ib + r; const size_t row = (size_t)(R0 + i);
        const int nks = (!sample && ib < 4) ? 2 : 4;
        bf16x8 yf[4];
#pragma unroll
        for (int ks = 0; ks < 4; ++ks) yf[ks] = ldfrag(Ws, 136, 16 * ib, 32 * ks, lane);
        const float bias = PIN(I_GBS)[(size_t)(l * 8 + g) * 128 + (sample ? (i & 15) : i)];
#pragma unroll 2
        for (int db = 0; db < 16; ++db) { f32x4 acc = (f32x4){0.f, 0.f, 0.f, 0.f};
#pragma unroll
            for (int ks = 0; ks < 4; ++ks) if (ks < nks) acc = mma16(ldfrag(VT, 136, 16 * db, 32 * ks, lane), yf[ks], acc);
            const int d = 16 * db + 4 * q; const f32x4 w4 = *(const f32x4*)(wv + d);
            const u32x2 uz = *(const u32x2*)(proj + row * NPROJ + 6144 + g * 256 + d);
            const float uu[4] = {__uint_as_float(uz.x << 16), __uint_as_float(uz.x & 0xffff0000u), __uint_as_float(uz.y << 16), __uint_as_float(uz.y & 0xffff0000u)};
            float y[4];
#pragma unroll
            for (int jj = 0; jj < 4; ++jj) y[jj] = (acc[jj] * w4[jj] + bias) * uu[jj];
            u32x2 pk; pk.x = pk2(y[0], y[1]); pk.y = pk2(y[2], y[3]);
            *(u32x2*)(mix + row * DMIX + 2048 + g * 256 + d) = pk; }
    }
    LBAR;
}

__device__ __forceinline__ void phase_sn(const Params& p, int l) {
    KA_INIT; TID_INIT;
    bf16_t* mix = (bf16_t*)(PWS + WS_MIX); const float* ssq = (const float*)(PWS + WS_SSQ); const float* nw = PIN(I_SNW) + (size_t)l * 2048;
    const int nth = gridDim.x * 512;
    for (int idx0 = blockIdx.x * 512 + tid; idx0 < T * 256; idx0 += 4 * nth) {
        u32x4 raw[4]; f32x4 s4[4], w0[4], w1[4];
#pragma unroll
        for (int u = 0; u < 4; ++u) { const int idx = idx0 + u * nth; if (idx < T * 256) { const int row = idx >> 8, col = (idx & 255) * 8, g = col >> 8;
            s4[u] = *(const f32x4*)(ssq + (size_t)row * 32 + 4 * g); raw[u] = *(const u32x4*)(mix + (size_t)row * DMIX + col); w0[u] = *(const f32x4*)(nw + col); w1[u] = *(const f32x4*)(nw + col + 4); } }
#pragma unroll
        for (int u = 0; u < 4; ++u) { const int idx = idx0 + u * nth; if (idx < T * 256) { const int row = idx >> 8, col = (idx & 255) * 8;
            const float rstd = rsqrtf((s4[u][0] + s4[u][1] + s4[u][2] + s4[u][3]) * (1.0f / 256.f) + EPS);
            float f[8]; unpack8(raw[u], f);
#pragma unroll
            for (int j = 0; j < 4; ++j) { f[j] *= rstd * w0[u][j]; f[4 + j] *= rstd * w1[u][j]; }
            *(u32x4*)(mix + (size_t)row * DMIX + col) = pack8(f); } }
    }
}

__device__ __forceinline__ void phase_e2(const Params& p, int l) {
    KA_INIT; TID_INIT;
    const bf16_t* up = (const bf16_t*)(PWS + WS_PROJ); bf16_t* act = (bf16_t*)(PWS + WS_MIX);
    const float* fw = PIN(I_FCW) + (size_t)l * 3 * DUP; const float* fb = PIN(I_FCB) + (size_t)l * DUP;
    const int nth = gridDim.x * 512;
    for (int idx = blockIdx.x * 512 + tid; idx < 1088 * 704; idx += nth) {
        const int f8 = idx % 704, rb = idx / 704, r0 = rb * 8, ch = f8 * 8;
        const bool sample = r0 >= TP; const int s = (r0 - TP) >> 4;
        const bool seqstart = sample ? ((r0 & 15) == 0) : ((r0 & 2047) == 0);
        const bool seqend = sample ? ((r0 & 15) == 8) : ((r0 & 2047) == 2040);
        u32x4 rg[10], rl[10];
#pragma unroll
        for (int k = 0; k < 10; ++k) { rg[k] = (u32x4){0u, 0u, 0u, 0u}; rl[k] = (u32x4){0u, 0u, 0u, 0u};
            if (k >= 2 || !seqstart) { rg[k] = *(const u32x4*)(up + (size_t)(r0 - 2 + k) * DUP + ch); rl[k] = *(const u32x4*)(up + (size_t)(r0 - 2 + k) * DUP + DFF + ch); } }
        float wg[3][8], wl[3][8], bg[8], bl[8];
#pragma unroll
        for (int k = 0; k < 3; ++k) { const f32x4 a0 = *(const f32x4*)(fw + k * DUP + ch), a1 = *(const f32x4*)(fw + k * DUP + ch + 4), c0 = *(const f32x4*)(fw + k * DUP + DFF + ch), c1 = *(const f32x4*)(fw + k * DUP + DFF + ch + 4);
#pragma unroll
            for (int j = 0; j < 4; ++j) { wg[k][j] = a0[j]; wg[k][4 + j] = a1[j]; wl[k][j] = c0[j]; wl[k][4 + j] = c1[j]; } }
        { const f32x4 a0 = *(const f32x4*)(fb + ch), a1 = *(const f32x4*)(fb + ch + 4), c0 = *(const f32x4*)(fb + DFF + ch), c1 = *(const f32x4*)(fb + DFF + ch + 4);
#pragma unroll
            for (int j = 0; j < 4; ++j) { bg[j] = a0[j]; bg[4 + j] = a1[j]; bl[j] = c0[j]; bl[4 + j] = c1[j]; } }
        float pg[2][8], pl[2][8];
#pragma unroll
        for (int k = 0; k < 2; ++k) { unpack8(rg[k], pg[k]); unpack8(rl[k], pl[k]);
            if (seqstart && sample) { const float* sp = PIN(I_SFFN) + ((size_t)(l * 32 + s) * 2 + k) * DUP + ch;
#pragma unroll
                for (int j = 0; j < 8; ++j) { pg[k][j] = sp[j]; pl[k][j] = sp[DFF + j]; } } }
#pragma unroll
        for (int rr = 0; rr < 8; ++rr) {
            float cg_[8], cl[8], o[8];
            unpack8(rg[rr + 2], cg_); unpack8(rl[rr + 2], cl);
#pragma unroll
            for (int j = 0; j < 8; ++j) {
                const float a = bg[j] + wg[0][j] * pg[0][j] + wg[1][j] * pg[1][j] + wg[2][j] * cg_[j];
                const float b = bl[j] + wl[0][j] * pl[0][j] + wl[1][j] * pl[1][j] + wl[2][j] * cl[j];
                o[j] = silu_f(a) * b;
                pg[0][j] = pg[1][j]; pg[1][j] = cg_[j]; pl[0][j] = pl[1][j]; pl[1][j] = cl[j];
            }
            *(u32x4*)(act + (size_t)(r0 + rr) * DFF + ch) = pack8(o);
            if (seqend && rr >= 6) {
                float* op = POUT + (sample ? O_SFFN + ((size_t)(l * 32 + s) * 2 + (rr - 6)) * DUP : O_PFFN + ((size_t)(l * 4 + (r0 >> 11)) * 2 + (rr - 6)) * DUP) + ch;
                *(f32x4*)op = (f32x4){cg_[0], cg_[1], cg_[2], cg_[3]}; *(f32x4*)(op + 4) = (f32x4){cg_[4], cg_[5], cg_[6], cg_[7]};
                *(f32x4*)(op + DFF) = (f32x4){cl[0], cl[1], cl[2], cl[3]}; *(f32x4*)(op + DFF + 4) = (f32x4){cl[4], cl[5], cl[6], cl[7]};
            }
        }
    }
}

__device__ __forceinline__ void run_g1(LAS unsigned char* lds, const bf16_t* A, const bf16_t* Bt, bf16_t* P, float* DT, const float* dtb) {
    pg8::StaticOrder S; S.init(T, NINP, gridDim.x, blockIdx.x); S.nkt = DM / 64; pg8::Gemm g{A, Bt, T, NINP, DM}; EpiG1 E{P, DT, dtb}; pg8::gemm_phase(lds, g, S, E); }
__device__ __forceinline__ void run_gx(LAS unsigned char* lds, const bf16_t* A, const bf16_t* Bt, float* X, float* SL, int K, int ns) {
    pg8::HybridOrder S; S.init(K, ns, gridDim.x, blockIdx.x); pg8::Gemm g{A, Bt, T, DM, K}; EpiX E{X, SL}; pg8::gemm_phase(lds, g, S, E); }
__device__ __forceinline__ void run_g3(LAS unsigned char* lds, const bf16_t* A, const bf16_t* Bt, bf16_t* U) {
    pg8::StaticOrder S; S.init(T, DUP, gridDim.x, blockIdx.x); S.nkt = DM / 64; pg8::Gemm g{A, Bt, T, DUP, DM}; EpiUp E{U}; pg8::gemm_phase(lds, g, S, E); }
#ifndef EN_PREP
#define EN_PREP 1
#endif
#ifndef EN_GEMM
#define EN_GEMM 15
#endif
#ifndef EN_SSD
#define EN_SSD 1
#endif
#ifndef EN_GMLP
#define EN_GMLP 1
#endif
#ifndef EN_SN
#define EN_SN 1
#endif
#ifndef EN_E2
#define EN_E2 1
#endif
#if PROBE
#define MARK(cls) do { if (blockIdx.x == 0 && threadIdx.x == 0) { const unsigned long long t_ = __builtin_amdgcn_s_memrealtime(); const unsigned d_ = (unsigned)(t_ - t_prev); t_prev = t_; \
    if (PROBE_A & (1 << (cls))) accA += d_; if (PROBE_B & (1 << (cls))) accB += d_; } } while (0)
#else
#define MARK(cls) do { } while (0)
#endif
#define WSP(T_, off) ((T_*)(PWS + (off)))
constexpr size_t WS_BAR = WS_END;
constexpr size_t WS_BAR_BYTES = 16384;
constexpr size_t WS_TOTAL = WS_END + WS_BAR_BYTES;
#define XB_TMO      128
#define XB_XCNT(j)  (256  + 64 * (j))
#define XB_XSUB(j)  (1280 + 64 * (j))
#define XB_XGEN(j)  (2304 + 64 * (j))
#define XB_TOP      3328
#define XB_TOPGEN   3392
#define XB_SPIN_CAP (1u << 18)
__device__ __forceinline__ unsigned xb_ld(unsigned* p)              { return __hip_atomic_load(p, __ATOMIC_RELAXED, __HIP_MEMORY_SCOPE_AGENT); }
__device__ __forceinline__ unsigned xb_add(unsigned* p, unsigned v) { return __hip_atomic_fetch_add(p, v, __ATOMIC_RELAXED, __HIP_MEMORY_SCOPE_AGENT); }
__device__ __forceinline__ unsigned xb_xcc_id() { return (unsigned)__builtin_amdgcn_s_getreg((3 << 11) | 20) & 0xFu; }
#define XB_SPIN(cond, bar) do { unsigned _sp = 0; while (cond) { __builtin_amdgcn_s_sleep(1); \
    if ((++_sp & 255u) == 0u) { if (xb_ld(&(bar)[XB_TMO])) break; if (_sp > XB_SPIN_CAP) { atomicAdd(&(bar)[XB_TMO], 1u); break; } } } } while (0)
__device__ __forceinline__ void xcd_barrier_complete(unsigned* bar, unsigned x, unsigned& nloc, unsigned& nx) {
    const unsigned G = gridDim.x;
    unsigned sum, cnt, mine, sp = 0u;
    for (;;) {
        sum = 0u; cnt = 0u; mine = 0u;
#pragma unroll
        for (unsigned j = 0; j < 16; ++j) { const unsigned c = xb_ld(&bar[XB_XCNT(j)]); sum += c; cnt += (c > 0u) ? 1u : 0u; mine = (j == x) ? c : mine; }
        if (sum == G) break;
        __builtin_amdgcn_s_sleep(1);
        if ((++sp & 255u) == 0u) { if (xb_ld(&bar[XB_TMO])) break; if (sp > XB_SPIN_CAP) { atomicAdd(&bar[XB_TMO], 1u); break; } }
    }
    nloc = mine > 0u ? mine : 1u; nx = cnt > 0u ? cnt : 1u;
}
__device__ __forceinline__ void xcd_barrier(unsigned* bar, volatile LAS unsigned* st) {
    asm volatile("s_waitcnt vmcnt(0)" ::: "memory");
    __syncthreads();
    if (threadIdx.x == 0) {
        const unsigned x = xb_xcc_id();
        __builtin_amdgcn_s_waitcnt(0);
        unsigned nloc = st[0], nx = st[1];
        if (nloc == 0u) { xcd_barrier_complete(bar, x, nloc, nx); st[0] = nloc; st[1] = nx; }
        const unsigned old = xb_add(&bar[XB_XSUB(x)], 1u);
        const unsigned gen = old / nloc;
        if (old + 1u == (gen + 1u) * nloc) {
            __builtin_amdgcn_fence(__ATOMIC_RELEASE, "agent");
            asm volatile("s_waitcnt vmcnt(0)" ::: "memory");
            const unsigned og = xb_add(&bar[XB_TOP], 1u);
            const unsigned tg = og / nx;
            if (og + 1u == (tg + 1u) * nx) xb_add(&bar[XB_TOPGEN], 1u);
            else XB_SPIN(xb_ld(&bar[XB_TOPGEN]) == tg, bar);
            __builtin_amdgcn_fence(__ATOMIC_ACQUIRE, "agent");
            xb_add(&bar[XB_XGEN(x)], 1u);
            asm volatile("s_waitcnt vmcnt(0)" ::: "memory");
        } else {
            XB_SPIN(xb_ld(&bar[XB_XGEN(x)]) == gen, bar);
            __builtin_amdgcn_fence(__ATOMIC_ACQUIRE, "agent");
            asm volatile("s_waitcnt vmcnt(0)" ::: "memory");
        }
    }
    __syncthreads();
}
#define GSYNC do { KA_INIT; xcd_barrier((unsigned*)(PWS + WS_BAR), (volatile LAS unsigned*)((LAS unsigned char*)shm + 147456)); } while (0)
__global__ void __launch_bounds__(512, 2) fwd_kernel(Params p) {
    extern __shared__ __attribute__((aligned(16))) unsigned char shm[];
    { KA_INIT;
      volatile LAS unsigned* st = (volatile LAS unsigned*)((LAS unsigned char*)shm + 147456);
      if (threadIdx.x == 0) { st[0] = 0u; st[1] = 0u; (void)xb_add(&((unsigned*)(PWS + WS_BAR))[XB_XCNT(xb_xcc_id())], 1u); }
      __syncthreads(); }
#if PROBE
    unsigned long long t_prev = __builtin_amdgcn_s_memrealtime(); unsigned accA = 0, accB = 0;
#endif
    { KA_INIT; if (PWS == nullptr) cg::this_grid().sync(); }
    for (int l = 0; l < 2; ++l) {
#if EN_PREP
        { KA_INIT;
        convert_w(PIN(I_WIN) + (size_t)l * DM * DIN, DM, DIN, WSP(bf16_t, WS_WIN), NINP, 1, shm);
        convert_w(PIN(I_WOUT) + (size_t)l * DMIX * DM, DMIX, DM, WSP(bf16_t, WS_WOUT), DM, 0, shm);
        convert_w(PIN(I_WUP) + (size_t)l * DM * DUP, DM, DUP, WSP(bf16_t, WS_WUP), DUP, 0, shm);
        convert_w(PIN(I_WDN) + (size_t)l * DFF * DM, DFF, DM, WSP(bf16_t, WS_WDN), DM, 0, shm);
        if (l == 0) phase_norm<0>(p, PIN(I_N1W), 0, shm); else phase_norm<1>(p, PIN(I_N1W) + DM, 11, shm); }
#endif
        GSYNC;
        MARK(0);
        if (EN_GEMM & 1) { KA_INIT; run_g1((LAS unsigned char*)shm, WSP(bf16_t, WS_H), WSP(bf16_t, WS_WIN), WSP(bf16_t, WS_PROJ), WSP(float, WS_DT), PIN(I_DTB) + l * 32); }
        GSYNC; MARK(1);
        {
            const int step = blockIdx.x < 128 ? (1 << 20) : (int)gridDim.x - 128;
            if (EN_SSD) for (int it = blockIdx.x; it < 1152; it += step) { const bool smp = it >= 128; ssd_chain(p, l, smp, smp ? (it - 128) >> 5 : it >> 5, it & 31, shm); }
            if (EN_GMLP) if (blockIdx.x >= 128) for (int it = blockIdx.x - 128; it < 544; it += step) { const bool smp = it >= 512; gmlp_item(p, l, smp, smp ? it - 512 : it, shm); }
        }
        GSYNC; MARK(2);
        if (EN_SN) phase_sn(p, l);
        GSYNC; MARK(3);
        if (EN_GEMM & 2) { KA_INIT; run_gx((LAS unsigned char*)shm, WSP(bf16_t, WS_MIX), WSP(bf16_t, WS_WOUT), WSP(float, WS_X), WSP(float, WS_PROJ), DMIX, 16); }
        GSYNC; MARK(4);
        { KA_INIT; phase_norm<1>(p, PIN(I_N2W) + (size_t)l * DM, 16, shm); }
        GSYNC; MARK(5);
        if (EN_GEMM & 4) { KA_INIT; run_g3((LAS unsigned char*)shm, WSP(bf16_t, WS_H), WSP(bf16_t, WS_WUP), WSP(bf16_t, WS_PROJ)); }
        GSYNC; MARK(6);
        if (EN_E2) phase_e2(p, l);
        GSYNC; MARK(7);
        if (EN_GEMM & 8) { KA_INIT; run_gx((LAS unsigned char*)shm, WSP(bf16_t, WS_MIX), WSP(bf16_t, WS_WDN), WSP(float, WS_X), WSP(float, WS_PROJ), DFF, 11); }
        GSYNC; MARK(8);
    }
#if PROBE
    float addA = 0.f;
    if (blockIdx.x == 0 && threadIdx.x == 0) { KA_INIT; addA = 10.f + (float)accA * (0.01f / 150.f); float* q_ = POUT + O_PCONV; *q_ = *q_ + 4.f + (float)accB * (0.01f / 1000.f); }
    { KA_INIT; phase_norm<2>(p, PIN(I_FNW), 11, shm, addA); }
#else
    { KA_INIT; phase_norm<2>(p, PIN(I_FNW), 11, shm); }
#endif
}

extern "C" void kernel_launch(void* const* d_in, const int* in_sizes, int n_in, void* d_out, int out_size, void* d_ws, size_t ws_size, hipStream_t stream) {
    static int grid = 0;
    if (grid == 0) {
        if (n_in != 23 || ws_size < WS_TOTAL) { fprintf(stderr, "kernel_launch: n_in %d ws %zu (need %zu)\n", n_in, ws_size, (size_t)WS_TOTAL); grid = -1; return; }
        int dev = 0, cus = 0, per_cu = 0;
        hipGetDevice(&dev); hipDeviceGetAttribute(&cus, hipDeviceAttributeMultiprocessorCount, dev);
        hipFuncSetAttribute((const void*)fwd_kernel, hipFuncAttributeMaxDynamicSharedMemorySize, LDS_BYTES);
        hipOccupancyMaxActiveBlocksPerMultiprocessor(&per_cu, (const void*)fwd_kernel, 512, LDS_BYTES);
        (void)hipGetLastError();
        if (per_cu < 1) per_cu = 1;
        grid = cus;
        if (grid < 129) { fprintf(stderr, "kernel_launch: needs > 128 CUs\n"); grid = -1; return; }
    }
    if (grid < 0) return;
    (void)hipMemsetAsync((unsigned char*)d_ws + WS_BAR, 0, WS_BAR_BYTES, stream);
    Params p{};
    for (int i = 0; i < 23; ++i) p.in[i] = (const float*)d_in[i];
    p.out = (float*)d_out; p.ws = (unsigned char*)d_ws;
    void* args[] = {&p};
    hipError_t e = hipLaunchCooperativeKernel((const void*)fwd_kernel, dim3(grid), dim3(512), args, LDS_BYTES, stream);
    if (e != hipSuccess) fprintf(stderr, "cooperative launch failed: %s (grid %d)\n", hipGetErrorString(e), grid);
}
```

```cpp
#include <hip/hip_runtime.h>
#include <hip/hip_cooperative_groups.h>
#include <cstdio>
namespace cg = cooperative_groups;

#define LAS __attribute__((address_space(3)))
typedef unsigned short bf16_t;
typedef short bf16x8 __attribute__((ext_vector_type(8)));
typedef float f32x4 __attribute__((ext_vector_type(4)));
typedef unsigned u32x4 __attribute__((ext_vector_type(4)));
typedef unsigned u32x2 __attribute__((ext_vector_type(2)));

#ifndef PROBE_A
#define PROBE_A 0
#endif
#ifndef PROBE_B
#define PROBE_B 0
#endif
#define PROBE (PROBE_A | PROBE_B)
constexpr int TP = 8192, TS = 512, T = 8704;
constexpr int DM = 2048, NPROJ = 10240, NINP = 10496, DIN = 10272;
constexpr int DMIX = 4096, DFF = 5632, DUP = 11264;
constexpr float EPS = 1e-6f;
constexpr size_t WS_WIN = 0;
constexpr size_t WS_WOUT = WS_WIN + (size_t)NINP * DM * 2;
constexpr size_t WS_WUP = WS_WOUT + (size_t)DM * DMIX * 2;
constexpr size_t WS_WDN = WS_WUP + (size_t)DUP * DM * 2;
constexpr size_t WS_X = WS_WDN + (size_t)DM * DFF * 2;
constexpr size_t WS_H = WS_X + (size_t)T * DM * 4;
constexpr size_t WS_PROJ = WS_H + (size_t)T * DM * 2;
constexpr size_t WS_MIX = WS_PROJ + (size_t)T * DUP * 2;
constexpr size_t WS_DT = WS_MIX + (size_t)T * DFF * 2;
constexpr size_t WS_SSQ = WS_DT + (size_t)T * 32 * 4;
constexpr size_t WS_END = WS_SSQ + (size_t)T * 32 * 4;
constexpr size_t O_YP = 0, O_PCONV = 17825792, O_PSSD = 17924096, O_PFFN = 20021248, O_SCONV = 20201472, O_SSSD = 20987904, O_SFFN = 37765120, O_SV = 39206912;
constexpr int LDS_BYTES = 147456 + 256;

struct Params { const float* in[23]; float* out; unsigned char* ws; };
typedef const unsigned char __attribute__((address_space(4)))* kaptr_t;
#define KA_INIT kaptr_t ka_ = (kaptr_t)__builtin_amdgcn_kernarg_segment_ptr(); asm volatile("" : "+s"(ka_))
#define PIN(i) (*(const float* const __attribute__((address_space(4)))*)(ka_ + 8 * (i)))
#define POUT ((float*)PIN(23))
#define PWS ((unsigned char*)PIN(24))
#define TID_INIT int tid = threadIdx.x; asm volatile("" : "+v"(tid))
enum { I_XP = 0, I_XS, I_SCONV, I_SSSD, I_SFFN, I_N1W, I_WIN, I_CW, I_CB, I_DTB, I_ALOG, I_D, I_SNW, I_GNW, I_GWS, I_GBS, I_WOUT, I_N2W, I_WUP, I_FCW, I_FCB, I_WDN, I_FNW };

__device__ __forceinline__ float bf2f(bf16_t b) { return __uint_as_float(((unsigned)b) << 16); }
__device__ __forceinline__ unsigned pk2(float lo, float hi) { unsigned r; asm volatile("v_cvt_pk_bf16_f32 %0, %1, %2" : "=v"(r) : "v"(lo), "v"(hi)); return r; }
__device__ __forceinline__ bf16_t f2bf(float f) { return (bf16_t)(pk2(f, 0.f) & 0xffffu); }
__device__ __forceinline__ void unpack8(u32x4 v, float* f) {
#pragma unroll
    for (int i = 0; i < 4; ++i) { f[2 * i] = __uint_as_float(v[i] << 16); f[2 * i + 1] = __uint_as_float(v[i] & 0xffff0000u); }
}
__device__ __forceinline__ u32x4 pack8(const float* f) { u32x4 r; r.x = pk2(f[0], f[1]); r.y = pk2(f[2], f[3]); r.z = pk2(f[4], f[5]); r.w = pk2(f[6], f[7]); return r; }
__device__ __forceinline__ float silu_f(float x) { return x * __builtin_amdgcn_rcpf(1.0f + __expf(-x)); }
__device__ __forceinline__ float gelu_f(float x) { const float t = 1.5957691216057308f * (x + 0.044715f * x * x * x); return x * __builtin_amdgcn_rcpf(1.0f + __expf(-t)); }
__device__ __forceinline__ float softplus_f(float x) { return x > 20.f ? x : __logf(1.0f + __expf(x)); }
__device__ __forceinline__ float wave_sum(float v) {
#pragma unroll
    for (int o = 32; o > 0; o >>= 1) v += __shfl_xor(v, o);
    return v;
}

#define LBAR asm volatile("s_waitcnt lgkmcnt(0)\n\ts_barrier" ::: "memory")
namespace pg8 {
constexpr int BM = 256, BK = 64, HALF = 128, HTB = HALF * BK * 2, NXCD = 8, WGM = 8;
__device__ __forceinline__ int lds_byte(int r, int c) { const int st = (r >> 4) * 2 + (c >> 5), rr = r & 15, cc = c & 31, ob = rr * 64 + cc * 2; return st * 1024 + (ob ^ (((ob >> 9) & 1) << 5)); }
__device__ __forceinline__ void stage_rc(int b, int& R, int& C) { const int st = b / 1024, sb = b % 1024, swz = sb ^ (((sb >> 9) & 1) << 5); R = (st >> 1) * 16 + swz / 64; C = (st & 1) * 32 + (swz % 64) / 2; }
__device__ __forceinline__ int perm32(int rho) { const int n = rho >> 4, i = rho & 15; return 8 * (i >> 2) + 4 * n + (i & 3); }
struct Unit { int pm, pn, kt0, nkt, slab; };
struct Gemm { const bf16_t* A; const bf16_t* Bt; int M, N, K; };
struct StaticOrder {
    int nM, nN, nwg, G, c, nkt;
    __device__ void init(int M, int N, int G_, int c_) { nM = M / BM; nN = N / BM; nwg = nM * nN; G = G_; c = c_; nkt = 0; }
    __device__ bool next(int i, Unit& u) const {
        const long L = (long)i * G + c; if (L >= nwg) return false;
        int wgid = (int)L; { const int q = nwg / NXCD, r = nwg % NXCD, xcd = wgid % NXCD, off = wgid / NXCD; wgid = (xcd < r ? xcd * (q + 1) : r * (q + 1) + (xcd - r) * q) + off; }
        const int nig = WGM * nN, gid = wgid / nig, fm = gid * WGM, gsz = (nM - fm) < WGM ? (nM - fm) : WGM;
        u.pm = fm + ((wgid % nig) % gsz); u.pn = (wgid % nig) / gsz; u.kt0 = 0; u.nkt = nkt; u.slab = -1; return true;
    }
};
struct HybridOrder {
    StaticOrder so; int ns, kper, c;
    __device__ void init(int K, int ns_, int G_, int c_) { so.init(TP, DM, G_, c_); so.nkt = K / BK; ns = ns_; kper = K / BK / ns_; c = c_; }
    __device__ bool next(int i, Unit& u) const {
        if (so.next(i, u)) return true;
        const int nmr = c < so.nwg ? (so.nwg - c + so.G - 1) / so.G : 0;
        const long q = (long)(i - nmr) * so.G + c;
        if (i >= nmr && q < 16 * ns) { const int s = (int)q % ns, tile = (int)q / ns; u.pm = 32 + (tile >> 3); u.pn = tile & 7; u.kt0 = s * kper; u.nkt = kper; u.slab = (tile >> 3) * ns + s; return true; }
        return false;
    }
};
template <class Epi, class Sched>
__device__ __forceinline__ void gemm_phase(LAS unsigned char* lds, const Gemm g, const Sched& S, const Epi& E) {
    int tid = threadIdx.x; asm volatile("" : "+v"(tid));
    const int wid = __builtin_amdgcn_readfirstlane(tid >> 6), lane = tid & 63, wr = wid >> 2, wc = wid & 3, fr = lane & 15, fq = lane >> 4;
    int K = __builtin_amdgcn_readfirstlane(g.K); asm volatile("" : "+s"(K));
    unsigned voffA[2], voffB[2];
#pragma unroll
    for (int i = 0; i < 2; ++i) { int R, C; stage_rc(tid * 16 + i * 8192, R, C); const int Rb = (R & ~31) + perm32(R & 31);
        voffA[i] = (unsigned)(R * K + C) * 2u; voffB[i] = (unsigned)(Rb * K + C) * 2u; }
    const size_t kstep = (size_t)(BK * 2);
    const size_t hstep = (size_t)HALF * K * 2;
    const size_t tstep = 2 * hstep;
    const unsigned ldsw = (unsigned)wid * 1024u;
    const int aoff = lds_byte(wr * 64 + fr, fq * 8), boff = lds_byte(wc * 32 + fr, fq * 8);
#define PG8_SA(b, h) (((b) * 2 + (h)) * HTB)
#define PG8_SB(b, h) ((4 + (b) * 2 + (h)) * HTB)
#define PG8_STAGE(bufoff, gbase, voff) do { _Pragma("unroll") for (int _i = 0; _i < 2; ++_i) \
        __builtin_amdgcn_global_load_lds((const unsigned*)((const char*)(gbase) + (voff)[_i]), (LAS unsigned*)(lds + (bufoff) + ldsw + _i * 8192), 16, 0, 0); } while (0)
#define PG8_LDA(dst, b, h) do { _Pragma("unroll") for (int m = 0; m < 4; ++m) _Pragma("unroll") for (int k = 0; k < 2; ++k) dst[m][k] = *(const LAS bf16x8*)(lds + PG8_SA(b, h) + aoff + m * 2048 + k * 1024); } while (0)
#define PG8_LDB(dst, b, h) do { _Pragma("unroll") for (int n = 0; n < 2; ++n) _Pragma("unroll") for (int k = 0; k < 2; ++k) dst[n][k] = *(const LAS bf16x8*)(lds + PG8_SB(b, h) + boff + n * 2048 + k * 1024); } while (0)
#define PG8_MMA(ai, bj, At, Bt) do { __builtin_amdgcn_s_setprio(1); _Pragma("unroll") for (int m = 0; m < 4; ++m) _Pragma("unroll") for (int n = 0; n < 2; ++n) _Pragma("unroll") for (int k = 0; k < 2; ++k) \
        acc[ai][bj][m][n] = __builtin_amdgcn_mfma_f32_16x16x32_bf16(Bt[n][k], At[m][k], acc[ai][bj][m][n], 0, 0, 0); __builtin_amdgcn_s_setprio(0); } while (0)
#define PG8_WAIT_V(n) asm volatile("s_waitcnt vmcnt(" #n ")" ::: "memory")
#define PG8_WAIT_L(n) asm volatile("s_waitcnt lgkmcnt(" #n ")" ::: "memory")
#define PG8_BAR __builtin_amdgcn_s_barrier()
#define PG8_SCHED __builtin_amdgcn_sched_barrier(0)
    Unit cur, nxt; int ui = 0;
    if (!S.next(0, cur)) return;
    f32x4 acc[2][2][4][2];
#pragma unroll
    for (int a = 0; a < 2; ++a)
#pragma unroll
        for (int b = 0; b < 2; ++b)
#pragma unroll
            for (int m = 0; m < 4; ++m)
#pragma unroll
                for (int n = 0; n < 2; ++n) acc[a][b][m][n] = (f32x4){0.f, 0.f, 0.f, 0.f};
    bf16x8 At[4][2], B0[2][2], B1[2][2];
    const char* cA = (const char*)g.A + (size_t)cur.pm * tstep + (size_t)cur.kt0 * kstep; const char* cB = (const char*)g.Bt + (size_t)cur.pn * tstep + (size_t)cur.kt0 * kstep;
    PG8_STAGE(PG8_SB(0, 0), cB, voffB); PG8_STAGE(PG8_SA(0, 0), cA, voffA); PG8_STAGE(PG8_SB(0, 1), cB + hstep, voffB); PG8_STAGE(PG8_SA(0, 1), cA + hstep, voffA);
    if (wr == 1) PG8_BAR;
    PG8_WAIT_V(4); PG8_BAR;
    PG8_STAGE(PG8_SB(1, 0), cB + kstep, voffB); PG8_STAGE(PG8_SA(1, 0), cA + kstep, voffA); PG8_STAGE(PG8_SB(1, 1), cB + hstep + kstep, voffB);
    PG8_WAIT_V(6); PG8_BAR;
    for (;;) {
        const bool has_next = S.next(ui + 1, nxt);
        const char* nA = has_next ? (const char*)g.A + (size_t)nxt.pm * tstep + (size_t)nxt.kt0 * kstep : cA; const char* nB = has_next ? (const char*)g.Bt + (size_t)nxt.pn * tstep + (size_t)nxt.kt0 * kstep : cB;
        const int nt = cur.nkt;
        for (int t = 0; t < nt; t += 2) {
            const bool last = (t == nt - 2);
            const char* a1 = cA + (size_t)(t + 1) * kstep;
            const char* a2 = last ? nA : cA + (size_t)(t + 2) * kstep; const char* b2 = last ? nB : cB + (size_t)(t + 2) * kstep;
            const char* a3 = a2 + kstep; const char* b3 = b2 + kstep;
            PG8_LDB(B0, 0, 0); PG8_SCHED; PG8_LDA(At, 0, 0); PG8_STAGE(PG8_SA(1, 1), a1 + hstep, voffA);
            PG8_WAIT_L(8); PG8_BAR; PG8_WAIT_L(0); PG8_MMA(0, 0, At, B0); PG8_BAR; PG8_SCHED;
            PG8_LDB(B1, 0, 1); PG8_STAGE(PG8_SB(0, 0), b2, voffB);
            PG8_BAR; PG8_WAIT_L(0); PG8_MMA(0, 1, At, B1); PG8_BAR;
            PG8_LDA(At, 0, 1); PG8_STAGE(PG8_SA(0, 0), a2, voffA);
            PG8_BAR; PG8_WAIT_L(0); PG8_MMA(1, 0, At, B0); PG8_BAR; PG8_SCHED;
            PG8_STAGE(PG8_SB(0, 1), b2 + hstep, voffB);
            PG8_WAIT_V(6); PG8_BAR; PG8_MMA(1, 1, At, B1); PG8_BAR;
            PG8_LDB(B0, 1, 0); PG8_SCHED; PG8_LDA(At, 1, 0); PG8_STAGE(PG8_SA(0, 1), a2 + hstep, voffA);
            PG8_WAIT_L(8); PG8_BAR; PG8_WAIT_L(0); PG8_MMA(0, 0, At, B0); PG8_BAR; PG8_SCHED;
            PG8_LDB(B1, 1, 1); PG8_STAGE(PG8_SB(1, 0), b3, voffB);
            PG8_BAR; PG8_WAIT_L(0); PG8_MMA(0, 1, At, B1); PG8_BAR;
            PG8_LDA(At, 1, 1); PG8_STAGE(PG8_SA(1, 0), a3, voffA);
            PG8_BAR; PG8_WAIT_L(0); PG8_MMA(1, 0, At, B0); PG8_BAR; PG8_SCHED;
            PG8_STAGE(PG8_SB(1, 1), b3 + hstep, voffB);
            PG8_WAIT_V(6); PG8_BAR; PG8_MMA(1, 1, At, B1); PG8_BAR;
        }
        E(acc, cur, wr, wc, fr, fq);
        if (!has_next) break;
#pragma unroll
        for (int a = 0; a < 2; ++a)
#pragma unroll
            for (int b = 0; b < 2; ++b)
#pragma unroll
                for (int m = 0; m < 4; ++m)
#pragma unroll
                    for (int n = 0; n < 2; ++n) acc[a][b][m][n] = (f32x4){0.f, 0.f, 0.f, 0.f};
        cur = nxt; cA = nA; cB = nB; ++ui;
    }
    PG8_WAIT_V(0);
    if (wr == 0) PG8_BAR;
    PG8_BAR;
#undef PG8_SA
#undef PG8_SB
#undef PG8_STAGE
#undef PG8_LDA
#undef PG8_LDB
#undef PG8_MMA
#undef PG8_WAIT_V
#undef PG8_WAIT_L
#undef PG8_BAR
#undef PG8_SCHED
}
}
using pg8::Unit;

struct EpiG1 {
    bf16_t* P; float* DT; const float* dtb;
    __device__ __forceinline__ void operator()(const f32x4 (&acc)[2][2][4][2], const Unit& u, int wr, int wc, int fr, int fq) const {
        const int row0 = u.pm * 256 + wr * 64 + fr;
        if (u.pn < 40) {
            const int mode = u.pn < 8 ? 1 : (u.pn < 24 ? 0 : 2);
            const int col0 = u.pn * 256 + wc * 32 + 8 * fq;
#pragma unroll
            for (int ai = 0; ai < 2; ++ai)
#pragma unroll
                for (int m = 0; m < 4; ++m) { bf16_t* rowp = P + (size_t)(row0 + ai * 128 + m * 16) * NPROJ + col0;
#pragma unroll
                    for (int bj = 0; bj < 2; ++bj) { float v[8];
#pragma unroll
                        for (int j = 0; j < 4; ++j) { v[j] = acc[ai][bj][m][0][j]; v[4 + j] = acc[ai][bj][m][1][j]; }
                        if (mode == 1) {
#pragma unroll
                            for (int j = 0; j < 8; ++j) v[j] = silu_f(v[j]); }
                        else if (mode == 2) {
#pragma unroll
                            for (int j = 0; j < 8; ++j) v[j] = gelu_f(v[j]); }
                        *(u32x4*)(rowp + bj * 128) = pack8(v); } }
        } else if (wc == 0) {
#pragma unroll
            for (int ai = 0; ai < 2; ++ai)
#pragma unroll
                for (int m = 0; m < 4; ++m) { float* rowp = DT + (size_t)(row0 + ai * 128 + m * 16) * 32 + 8 * fq;
#pragma unroll
                    for (int n = 0; n < 2; ++n) { f32x4 o;
#pragma unroll
                        for (int j = 0; j < 4; ++j) o[j] = softplus_f(acc[ai][0][m][n][j] + dtb[8 * fq + 4 * n + j]);
                        *(f32x4*)(rowp + 4 * n) = o; } }
        }
    }
};
struct EpiX {
    float* X; float* SL;
    __device__ __forceinline__ void operator()(const f32x4 (&acc)[2][2][4][2], const Unit& u, int wr, int wc, int fr, int fq) const {
        const int col0 = u.pn * 256 + wc * 32 + 8 * fq;
        if (u.slab < 0) {
            const int row0 = u.pm * 256 + wr * 64 + fr;
#pragma unroll
            for (int ai = 0; ai < 2; ++ai)
#pragma unroll
                for (int m = 0; m < 4; ++m) { float* rowp = X + (size_t)(row0 + ai * 128 + m * 16) * DM + col0;
#pragma unroll
                    for (int bj = 0; bj < 2; ++bj) { f32x4* q = (f32x4*)(rowp + bj * 128); f32x4 a = q[0], b = q[1]; q[0] = a + acc[ai][bj][m][0]; q[1] = b + acc[ai][bj][m][1]; } }
        } else {
            float* base = SL + (size_t)u.slab * 256 * DM; const int row0 = wr * 64 + fr;
#pragma unroll
            for (int ai = 0; ai < 2; ++ai)
#pragma unroll
                for (int m = 0; m < 4; ++m) { float* rowp = base + (size_t)(row0 + ai * 128 + m * 16) * DM + col0;
#pragma unroll
                    for (int bj = 0; bj < 2; ++bj) { f32x4* q = (f32x4*)(rowp + bj * 128); q[0] = acc[ai][bj][m][0]; q[1] = acc[ai][bj][m][1]; } }
        }
    }
};
struct EpiUp {
    bf16_t* U;
    __device__ __forceinline__ void operator()(const f32x4 (&acc)[2][2][4][2], const Unit& u, int wr, int wc, int fr, int fq) const {
        const int row0 = u.pm * 256 + wr * 64 + fr, col0 = u.pn * 256 + wc * 32 + 8 * fq;
#pragma unroll
        for (int ai = 0; ai < 2; ++ai)
#pragma unroll
            for (int m = 0; m < 4; ++m) { bf16_t* rowp = U + (size_t)(row0 + ai * 128 + m * 16) * DUP + col0;
#pragma unroll
                for (int bj = 0; bj < 2; ++bj) { u32x4 w; w.x = pk2(acc[ai][bj][m][0][0], acc[ai][bj][m][0][1]); w.y = pk2(acc[ai][bj][m][0][2], acc[ai][bj][m][0][3]);
                    w.z = pk2(acc[ai][bj][m][1][0], acc[ai][bj][m][1][1]); w.w = pk2(acc[ai][bj][m][1][2], acc[ai][bj][m][1][3]); *(u32x4*)(rowp + bj * 128) = w; } }
    }
};

__device__ __forceinline__ int map_col(int n, int mode) {
    if (mode == 0) return n;
    if (n < 6144) return n; if (n < 10240) return n + 32; if (n < 10272) return n - 10240 + 6144; return -1;
}
__device__ __forceinline__ void convert_w(const float* __restrict__ src, int K, int Nsrc, bf16_t* __restrict__ dst, int Ndst, int mode, unsigned char* shm) {
    float* tile = (float*)shm;
    TID_INIT;
    const int ntn = Ndst / 256, ntk = K / 64, ntile = ntn * ntk;
    const int tkk = tid >> 4, tn4 = tid & 15, wn = tid >> 3, wk8 = tid & 7;
    f32x4 v[4][2];
    int t = blockIdx.x;
#define CW_LOAD(tt_) do { const int tn_ = (tt_) % ntn, tk_ = (tt_) / ntn; \
        _Pragma("unroll") for (int s_ = 0; s_ < 4; ++s_) { const int sc_ = map_col(tn_ * 256 + 64 * s_ + 4 * tn4, mode); \
            _Pragma("unroll") for (int i_ = 0; i_ < 2; ++i_) { v[s_][i_] = (f32x4){0.f, 0.f, 0.f, 0.f}; if (sc_ >= 0) v[s_][i_] = *(const f32x4*)(src + (size_t)(tk_ * 64 + tkk + 32 * i_) * Nsrc + sc_); } } } while (0)
    if (t < ntile) CW_LOAD(t);
    for (; t < ntile; t += gridDim.x) {
        const int tn = t % ntn, tk = t / ntn, n0 = tn * 256, k0 = tk * 64;
#pragma unroll
        for (int s_ = 0; s_ < 4; ++s_)
#pragma unroll
            for (int i = 0; i < 2; ++i)
#pragma unroll
                for (int j = 0; j < 4; ++j) tile[(tkk + 32 * i) * 257 + 64 * s_ + 4 * tn4 + j] = v[s_][i][j];
        LBAR;
        if (t + (int)gridDim.x < ntile) CW_LOAD(t + (int)gridDim.x);
#pragma unroll
        for (int s_ = 0; s_ < 4; ++s_) { float f[8];
#pragma unroll
            for (int j = 0; j < 8; ++j) f[j] = tile[(8 * wk8 + j) * 257 + 64 * s_ + wn];
            *(u32x4*)(dst + (size_t)(n0 + 64 * s_ + wn) * K + k0 + 8 * wk8) = pack8(f); }
        LBAR;
    }
#undef CW_LOAD
}

constexpr int CVT_REST_TILES = 2624;
struct CvtTile { const float* src; bf16_t* dst; int K, Nsrc, n0, k0; };
__device__ __forceinline__ CvtTile cvt_decode(int t, int l, kaptr_t ka_) {
    CvtTile c; int ntn, tt;
    if (t < 512) { ntn = 8; tt = t; c.src = PIN(I_WOUT) + (size_t)l * DMIX * DM; c.K = DMIX; c.Nsrc = DM; c.dst = (bf16_t*)(PWS + WS_WOUT); }
    else if (t < 1920) { ntn = 44; tt = t - 512; c.src = PIN(I_WUP) + (size_t)l * DM * DUP; c.K = DM; c.Nsrc = DUP; c.dst = (bf16_t*)(PWS + WS_WUP); }
    else { ntn = 8; tt = t - 1920; c.src = PIN(I_WDN) + (size_t)l * DFF * DM; c.K = DFF; c.Nsrc = DM; c.dst = (bf16_t*)(PWS + WS_WDN); }
    c.n0 = (tt % ntn) * 256; c.k0 = (tt / ntn) * 64; return c;
}
__device__ __forceinline__ void convert_list(int l, int t0, int stride, int niter, unsigned char* shm) {
    KA_INIT; TID_INIT;
    float* tile = (float*)shm;
    const int tkk = tid >> 4, tn4 = tid & 15, wn = tid >> 3, wk8 = tid & 7;
    f32x4 v[4][2];
    int t = t0; asm volatile("" : "+s"(t));
#define CL_LOAD(tt_) do { const CvtTile c_ = cvt_decode((tt_), l, ka_); \
        _Pragma("unroll") for (int s_ = 0; s_ < 4; ++s_) _Pragma("unroll") for (int i_ = 0; i_ < 2; ++i_) \
            v[s_][i_] = *(const f32x4*)(c_.src + (size_t)(c_.k0 + tkk + 32 * i_) * c_.Nsrc + c_.n0 + 64 * s_ + 4 * tn4); } while (0)
    if (niter > 0 && t < CVT_REST_TILES) CL_LOAD(t);
    for (int k = 0; k < niter && t < CVT_REST_TILES; ++k, t += stride) {
        const CvtTile c = cvt_decode(t, l, ka_);
#pragma unroll
        for (int s_ = 0; s_ < 4; ++s_)
#pragma unroll
            for (int i = 0; i < 2; ++i)
#pragma unroll
                for (int j = 0; j < 4; ++j) tile[(tkk + 32 * i) * 257 + 64 * s_ + 4 * tn4 + j] = v[s_][i][j];
        LBAR;
        if (k + 1 < niter && t + stride < CVT_REST_TILES) CL_LOAD(t + stride);
#pragma unroll
        for (int s_ = 0; s_ < 4; ++s_) { float f[8];
#pragma unroll
            for (int j = 0; j < 8; ++j) f[j] = tile[(8 * wk8 + j) * 257 + 64 * s_ + wn];
            *(u32x4*)(c.dst + (size_t)(c.n0 + 64 * s_ + wn) * c.K + c.k0 + 8 * wk8) = pack8(f); }
        LBAR;
    }
#undef CL_LOAD
}

template <int MODE>
__device__ __forceinline__ void phase_norm(const Params& p, const float* __restrict__ w, int ns, unsigned char* shm, float addA = 0.f) {
    KA_INIT; TID_INIT;
    const int lane = tid & 63, wv_ = tid >> 6, gw = blockIdx.x * 8 + wv_, nw = gridDim.x * 8;
    float* X = (float*)(PWS + WS_X); bf16_t* H = (bf16_t*)(PWS + WS_H);
    const int nrows = ns > 0 ? TP : T;
    for (int row = gw; row < nrows; row += nw) {
        const float* src = MODE == 0 ? (row < TP ? PIN(I_XP) + (size_t)row * DM : PIN(I_XS) + (size_t)(row - TP) * DM) : X + (size_t)row * DM;
        f32x4 v[8]; float ss = 0.f;
#pragma unroll
        for (int i = 0; i < 8; ++i) { v[i] = *(const f32x4*)(src + i * 256 + lane * 4); ss += v[i][0] * v[i][0] + v[i][1] * v[i][1] + v[i][2] * v[i][2] + v[i][3] * v[i][3]; }
        ss = wave_sum(ss);
        const float rstd = rsqrtf(ss * (1.0f / DM) + EPS);
#pragma unroll
        for (int i = 0; i < 8; ++i) { const int c = i * 256 + lane * 4; const f32x4 wv = *(const f32x4*)(w + c);
            if (MODE == 0) *(f32x4*)(X + (size_t)row * DM + c) = v[i];
            f32x4 o = v[i] * rstd * wv;
            if (MODE == 2) { if (PROBE && row == 0 && i == 0 && lane == 0) o[0] += addA; *(f32x4*)(POUT + O_YP + (size_t)row * DM + c) = o; }
            else { u32x2 pk; pk.x = pk2(o[0], o[1]); pk.y = pk2(o[2], o[3]); *(u32x2*)(H + (size_t)row * DM + c) = pk; } }
    }
    if (ns > 0) {
        float* red = (float*)shm; const float* SL = (const float*)(PWS + WS_PROJ);
        for (int r = blockIdx.x; r < TS; r += gridDim.x) {
            const int row = TP + r, pmi = r >> 8, rr = r & 255, c = wv_ * 256 + lane * 4;
            f32x4 v = *(const f32x4*)(X + (size_t)row * DM + c);
            { f32x4 sl[16];
#pragma unroll
              for (int s = 0; s < 16; ++s) { sl[s] = (f32x4){0.f, 0.f, 0.f, 0.f}; if (s < ns) sl[s] = *(const f32x4*)(SL + ((size_t)(pmi * ns + s) * 256 + rr) * DM + c); }
#pragma unroll
              for (int s = 0; s < 16; s += 4) v += (sl[s] + sl[s + 1]) + (sl[s + 2] + sl[s + 3]); }
            float ss = wave_sum(v[0] * v[0] + v[1] * v[1] + v[2] * v[2] + v[3] * v[3]);
            if (lane == 0) red[wv_] = ss;
            __syncthreads();
            ss = red[0] + red[1] + red[2] + red[3] + red[4] + red[5] + red[6] + red[7];
            const float rstd = rsqrtf(ss * (1.0f / DM) + EPS);
            *(f32x4*)(X + (size_t)row * DM + c) = v;
            const f32x4 o = v * rstd * *(const f32x4*)(w + c);
            if (MODE == 2) *(f32x4*)(POUT + O_YP + (size_t)row * DM + c) = o;
            else { u32x2 pk; pk.x = pk2(o[0], o[1]); pk.y = pk2(o[2], o[3]); *(u32x2*)(H + (size_t)row * DM + c) = pk; }
            __syncthreads();
        }
    }
}

__device__ __forceinline__ bf16x8 ldfrag(const bf16_t* base, int ld, int row0, int k0, int lane) { return *(const bf16x8*)(base + (row0 + (lane & 15)) * ld + k0 + (lane >> 4) * 8); }
__device__ __forceinline__ f32x4 mma16(bf16x8 x, bf16x8 y, f32x4 c) { return __builtin_amdgcn_mfma_f32_16x16x32_bf16(x, y, c, 0, 0, 0); }

__device__ __forceinline__ float wave_scan_incl(float s) {
#define DPP_ADD_(ctrl, rmask) { const int t_ = __builtin_amdgcn_update_dpp(0, __float_as_int(s), ctrl, rmask, 0xf, true); s += __int_as_float(t_); }
    DPP_ADD_(0x111, 0xf) DPP_ADD_(0x112, 0xf) DPP_ADD_(0x114, 0xf) DPP_ADD_(0x118, 0xf) DPP_ADD_(0x142, 0xa) DPP_ADD_(0x143, 0xc)
#undef DPP_ADD_
    return s;
}
__device__ __forceinline__ void ssd_chain(const Params& p, int l, bool sample, int seq, int hd, unsigned char* shm) {
    KA_INIT; TID_INIT;
    const int lane = tid & 63, w = __builtin_amdgcn_readfirstlane(tid >> 6), r = lane & 15, q = lane >> 4;
    bf16_t* Cs = (bf16_t*)(shm + 0);
    bf16_t* Bs = (bf16_t*)(shm + 17408);
    bf16_t* BT = (bf16_t*)(shm + 34816);
    bf16_t* XT = (bf16_t*)(shm + 53248);
    bf16_t* Ms = (bf16_t*)(shm + 62464);
    bf16_t* Hs = (bf16_t*)(shm + 71680);
    float* dts = (float*)(shm + 89088);
    float* acss = dts + 64; float* scs = acss + 64; float* part = scs + 64;
    bf16_t* RAW = (bf16_t*)(shm + 90624);
    bf16_t* HALO = (bf16_t*)(shm + 132608);
    float* CWs = (float*)(shm + 136704);
    const bf16_t* proj = (const bf16_t*)(PWS + WS_PROJ); const float* DT = (const float*)(PWS + WS_DT);
    bf16_t* mix = (bf16_t*)(PWS + WS_MIX); float* ssq = (float*)(PWS + WS_SSQ);
    const int g = hd >> 2, nchunk = sample ? 1 : 32, nvalid = sample ? 16 : 64;
    const int rowbase = sample ? TP + seq * 16 : seq * 2048;
    const float Dh = PIN(I_D)[l * 32 + hd];
    const float a_neg = -__expf(PIN(I_ALOG)[l * 32 + hd]);
    const int ib = w >> 1, pb0 = 2 * (w & 1), pbS = w >> 1, nb0 = 4 * (w & 1);
#define SSD_CH(cv) ((cv) < 8 ? hd * 64 + (cv) * 8 : ((cv) < 24 ? 2048 + g * 128 + ((cv) - 8) * 8 : 3072 + g * 128 + ((cv) - 24) * 8))
    typedef const float __attribute__((address_space(4)))* cptr4_t;
    const cptr4_t cw4 = (cptr4_t)(PIN(I_CW) + (size_t)l * 4 * 4096); const cptr4_t cb4 = (cptr4_t)(PIN(I_CB) + (size_t)l * 4096);
    if (tid >= 384 && tid < 384 + 120) { const int e = tid - 384, hr = e / 40, cvv = e % 40; u32x4 hv = (u32x4){0u, 0u, 0u, 0u};
        if (sample) { const float* sp = PIN(I_SCONV) + ((size_t)(l * 32 + seq) * 3 + hr) * 4096 + SSD_CH(cvv); const f32x4 a = *(const f32x4*)sp, b = *(const f32x4*)(sp + 4);
            hv.x = pk2(a[0], a[1]); hv.y = pk2(a[2], a[3]); hv.z = pk2(b[0], b[1]); hv.w = pk2(b[2], b[3]); }
        *(u32x4*)(HALO + (3 + hr) * 328 + cvv * 8) = hv; }
    f32x4 hacc[4];
    {
        const size_t hoff = ((size_t)((l * 32 + seq) * 32 + hd) * 64 + 16 * pbS + r) * 128;
#pragma unroll
        for (int tt = 0; tt < 4; ++tt) {
            f32x4 h = (f32x4){0.f, 0.f, 0.f, 0.f};
            if (sample) h = *(const f32x4*)(PIN(I_SSSD) + hoff + 16 * (nb0 + tt) + 4 * q);
            hacc[tt] = h;
            u32x2 pk; pk.x = pk2(h[0], h[1]); pk.y = pk2(h[2], h[3]);
            *(u32x2*)(Hs + (16 * pbS + r) * 136 + 16 * (nb0 + tt) + 4 * q) = pk;
        }
    }
    u32x4 rawreg[5]; float dtreg = 0.f;
    int goff[5], loff[5];
#pragma unroll
    for (int it = 0; it < 5; ++it) { const int v_ = it * 512 + tid, prow = v_ / 40, pcv = v_ - prow * 40; goff[it] = prow * NPROJ + 2048 + SSD_CH(pcv); loff[it] = prow * 328 + pcv * 8; }
#pragma unroll
    for (int it = 0; it < 5; ++it) { rawreg[it] = (u32x4){0u, 0u, 0u, 0u};
        if (it * 512 + tid < nvalid * 40) rawreg[it] = *(const u32x4*)(proj + (size_t)rowbase * NPROJ + goff[it]); }
    if (w == 7 && lane < nvalid) dtreg = DT[(size_t)(rowbase + lane) * 32 + hd];
    for (int c = 0; c < nchunk; ++c) {
        const int R0 = rowbase + c * 64;
#pragma unroll
        for (int it = 0; it < 5; ++it) *(u32x4*)(RAW + loff[it]) = rawreg[it];
        if (tid >= 392) *(u32x4*)(HALO + ((c & 1) * 3 - 61) * 328 + loff[4]) = rawreg[4];
        if (w == 7) {
            const float dtv = dtreg; const float s = wave_scan_incl(dtv * a_neg);
            const float lastv = __int_as_float(__builtin_amdgcn_readlane(__float_as_int(s), 63));
            dts[lane] = dtv; acss[lane] = s; scs[lane] = dtv * __expf(lastv - s);
        }
        u32x2 gz[2];
        {
            const int i = 16 * ib + r;
#pragma unroll
            for (int tt = 0; tt < 2; ++tt) { gz[tt] = (u32x2){0u, 0u}; if (i < nvalid) gz[tt] = *(const u32x2*)(proj + (size_t)(R0 + i) * NPROJ + hd * 64 + 16 * (pb0 + tt) + 4 * q); }
        }
        if (c + 1 < nchunk) {
#pragma unroll
            for (int it = 0; it < 5; ++it) rawreg[it] = *(const u32x4*)(proj + (size_t)(R0 + 64) * NPROJ + goff[it]);
            if (w == 7) dtreg = DT[(size_t)(R0 + 64 + lane) * 32 + hd];
        }
        LBAR;
        {
            const int t = lane; const int haloff = 132608 + (((c + 1) & 1) * 3 + 3) * 656;
            u32x4 rws[5][4];
#pragma unroll
            for (int it = 0; it < 5; ++it)
#pragma unroll
                for (int k = 0; k < 4; ++k) { const int tt = t - 3 + k; const int off = (tt >= 0 ? 90624 : haloff) + tt * 656 + (5 * w + it) * 16; rws[it][k] = *(const u32x4*)(shm + off); }
#pragma unroll
            for (int it = 0; it < 5; ++it) {
                const int cv = 5 * w + it; const int ch = SSD_CH(cv);
                float v[8];
#pragma unroll
                for (int j = 0; j < 8; ++j) v[j] = cb4[ch + j];
#pragma unroll
                for (int k = 0; k < 4; ++k) { float rw[8]; unpack8(rws[it][k], rw);
#pragma unroll
                    for (int j = 0; j < 8; ++j) v[j] += cw4[k * 4096 + ch + j] * rw[j]; }
#pragma unroll
                for (int j = 0; j < 8; ++j) { const float sv = silu_f(v[j]); v[j] = t < nvalid ? sv : 0.f; }
                if (cv < 8) {
#pragma unroll
                    for (int j = 0; j < 8; ++j) XT[(cv * 8 + j) * 72 + t] = f2bf(v[j]);
                } else if (cv < 24) {
                    const int cc = (cv - 8) * 8; const u32x4 pk = pack8(v);
                    *(u32x4*)(Bs + t * 136 + cc) = pk;
#pragma unroll
                    for (int j = 0; j < 8; ++j) BT[(cc + j) * 72 + t] = (bf16_t)((j & 1) ? (pk[j >> 1] >> 16) : (pk[j >> 1] & 0xffffu));
                } else {
                    const int cc = (cv - 24) * 8;
                    *(u32x4*)(Cs + t * 136 + cc) = pack8(v);
                }
            }
        }
        LBAR;
        f32x4 yo[2] = {(f32x4){0.f, 0.f, 0.f, 0.f}, (f32x4){0.f, 0.f, 0.f, 0.f}};
        {
            const int i = 16 * ib + r;
            bf16x8 fC[4], fH[2][4], fB[2][4], fXT[2], fBT[4][2]; f32x4 aj[2], dj[2], sc[2][2];
#pragma unroll
            for (int ks = 0; ks < 4; ++ks) { fC[ks] = ldfrag(Cs, 136, 16 * ib, 32 * ks, lane);
#pragma unroll
                for (int tt = 0; tt < 2; ++tt) { fH[tt][ks] = ldfrag(Hs, 136, 16 * (pb0 + tt), 32 * ks, lane); fB[tt][ks] = ldfrag(Bs, 136, 16 * (pb0 + tt), 32 * ks, lane); } }
#pragma unroll
            for (int ks = 0; ks < 2; ++ks) { fXT[ks] = ldfrag(XT, 72, 16 * pbS, 32 * ks, lane); sc[ks][0] = *(const f32x4*)(scs + 32 * ks + 8 * q); sc[ks][1] = *(const f32x4*)(scs + 32 * ks + 8 * q + 4);
#pragma unroll
                for (int tt = 0; tt < 4; ++tt) fBT[tt][ks] = ldfrag(BT, 72, 16 * (nb0 + tt), 32 * ks, lane); }
#pragma unroll
            for (int tt = 0; tt < 2; ++tt) { aj[tt] = *(const f32x4*)(acss + 16 * (pb0 + tt) + 4 * q); dj[tt] = *(const f32x4*)(dts + 16 * (pb0 + tt) + 4 * q); }
            const float ai = acss[i]; const float cd = __expf(acss[63]);
            asm volatile("" ::: "memory");
            f32x4 gg[2] = {(f32x4){0.f, 0.f, 0.f, 0.f}, (f32x4){0.f, 0.f, 0.f, 0.f}};
#pragma unroll
            for (int ks = 0; ks < 4; ++ks)
#pragma unroll
                for (int tt = 0; tt < 2; ++tt) { yo[tt] = mma16(fH[tt][ks], fC[ks], yo[tt]); gg[tt] = mma16(fB[tt][ks], fC[ks], gg[tt]); }
#pragma unroll
            for (int tt = 0; tt < 4; ++tt) hacc[tt] *= cd;
#pragma unroll
            for (int ks = 0; ks < 2; ++ks) {
                const bf16x8 xr = fXT[ks];
                float xf[8]; u32x4 xu; xu.x = (unsigned)(unsigned short)xr[0] | ((unsigned)(unsigned short)xr[1] << 16); xu.y = (unsigned)(unsigned short)xr[2] | ((unsigned)(unsigned short)xr[3] << 16);
                xu.z = (unsigned)(unsigned short)xr[4] | ((unsigned)(unsigned short)xr[5] << 16); xu.w = (unsigned)(unsigned short)xr[6] | ((unsigned)(unsigned short)xr[7] << 16);
                unpack8(xu, xf);
#pragma unroll
                for (int e = 0; e < 4; ++e) { xf[e] *= sc[ks][0][e]; xf[4 + e] *= sc[ks][1][e]; }
                const u32x4 xs = pack8(xf); bf16x8 yf;
#pragma unroll
                for (int e = 0; e < 4; ++e) { yf[2 * e] = (short)(xs[e] & 0xffffu); yf[2 * e + 1] = (short)(xs[e] >> 16); }
#pragma unroll
                for (int tt = 0; tt < 4; ++tt) hacc[tt] = mma16(fBT[tt][ks], yf, hacc[tt]);
            }
#pragma unroll
            for (int tt = 0; tt < 2; ++tt) { const int jb = pb0 + tt; float mv[4];
#pragma unroll
                for (int jj = 0; jj < 4; ++jj) { const int j = 16 * jb + 4 * q + jj; mv[jj] = (j <= i) ? gg[tt][jj] * __expf(fminf(ai - aj[tt][jj], 0.f)) * dj[tt][jj] : 0.f; }
                u32x2 pk; pk.x = pk2(mv[0], mv[1]); pk.y = pk2(mv[2], mv[3]);
                *(u32x2*)(Ms + i * 72 + 16 * jb + 4 * q) = pk; }
        }
        LBAR;
        {
            f32x4 yd[2] = {(f32x4){0.f, 0.f, 0.f, 0.f}, (f32x4){0.f, 0.f, 0.f, 0.f}};
            const int i = 16 * ib + r;
            bf16x8 fM[2], fX2[2][2]; bf16_t xe[2][4];
#pragma unroll
            for (int ks = 0; ks < 2; ++ks) { fM[ks] = ldfrag(Ms, 72, 16 * ib, 32 * ks, lane);
#pragma unroll
                for (int tt = 0; tt < 2; ++tt) fX2[tt][ks] = ldfrag(XT, 72, 16 * (pb0 + tt), 32 * ks, lane); }
#pragma unroll
            for (int tt = 0; tt < 2; ++tt)
#pragma unroll
                for (int jj = 0; jj < 4; ++jj) xe[tt][jj] = XT[(16 * (pb0 + tt) + 4 * q + jj) * 72 + i];
            const float ea = __expf(acss[i]);
            asm volatile("" ::: "memory");
#pragma unroll
            for (int ks = 0; ks < 2; ++ks)
#pragma unroll
                for (int tt = 0; tt < 2; ++tt) yd[tt] = mma16(fX2[tt][ks], fM[ks], yd[tt]);
            const bool valid = i < nvalid; const size_t row = (size_t)(R0 + i);
            float ss = 0.f;
#pragma unroll
            for (int tt = 0; tt < 2; ++tt) { const int pc = 16 * (pb0 + tt) + 4 * q;
                const float gate[4] = {__uint_as_float(gz[tt].x << 16), __uint_as_float(gz[tt].x & 0xffff0000u), __uint_as_float(gz[tt].y << 16), __uint_as_float(gz[tt].y & 0xffff0000u)};
                float y[4];
#pragma unroll
                for (int jj = 0; jj < 4; ++jj) { const float xv = bf2f(xe[tt][jj]); y[jj] = (yd[tt][jj] + ea * yo[tt][jj] + Dh * xv) * gate[jj]; ss += y[jj] * y[jj]; }
                if (valid) { u32x2 pk; pk.x = pk2(y[0], y[1]); pk.y = pk2(y[2], y[3]); *(u32x2*)(mix + row * DMIX + hd * 64 + pc) = pk; } }
            ss += __shfl_xor(ss, 16); ss += __shfl_xor(ss, 32);
            if (q == 0) part[i * 2 + (w & 1)] = ss;
#pragma unroll
            for (int tt = 0; tt < 4; ++tt) { u32x2 pk; pk.x = pk2(hacc[tt][0], hacc[tt][1]); pk.y = pk2(hacc[tt][2], hacc[tt][3]); *(u32x2*)(Hs + (16 * pbS + r) * 136 + 16 * (nb0 + tt) + 4 * q) = pk; }
        }
        LBAR;
        if (tid < nvalid) ssq[(size_t)(R0 + tid) * 32 + hd] = part[2 * tid] + part[2 * tid + 1];
    }
    if (tid < 120) { const int hr = tid / 40, cvv = tid % 40;
        if (cvv < 8 || (hd & 3) == 0) { float f[8]; unpack8(*(const u32x4*)(RAW + (nvalid - 3 + hr) * 328 + cvv * 8), f);
            float* op = POUT + (sample ? O_SCONV + ((size_t)(l * 32 + seq) * 3 + hr) * 4096 : O_PCONV + ((size_t)(l * 4 + seq) * 3 + hr) * 4096) + SSD_CH(cvv);
            *(f32x4*)op = (f32x4){f[0], f[1], f[2], f[3]}; *(f32x4*)(op + 4) = (f32x4){f[4], f[5], f[6], f[7]}; } }
    {
        float* op = POUT + (sample ? O_SSSD + ((size_t)((l * 32 + seq) * 32 + hd) * 64) * 128 : O_PSSD + ((size_t)((l * 4 + seq) * 32 + hd) * 64) * 128);
#pragma unroll
        for (int tt = 0; tt < 4; ++tt) *(f32x4*)(op + (size_t)(16 * pbS + r) * 128 + 16 * (nb0 + tt) + 4 * q) = hacc[tt];
    }
    LBAR;
#undef SSD_CH
}

__device__ __forceinline__ void gmlp_item(const Params& p, int l, bool sample, int idx, unsigned char* shm) {
    KA_INIT; TID_INIT;
    const int lane = tid & 63, w = tid >> 6, r = lane & 15, q = lane >> 4;
    bf16_t* Ws = (bf16_t*)shm;
    bf16_t* VT = (bf16_t*)(shm + 34816);
    float* rs = (float*)(shm + 104448);
    float* pp = rs + 128;
    const bf16_t* proj = (const bf16_t*)(PWS + WS_PROJ); bf16_t* mix = (bf16_t*)(PWS + WS_MIX);
    const int g = idx & 7, blk = idx >> 3, R0 = sample ? TP + blk * 128 : blk * 128;
    const float* wv = PIN(I_GNW) + (size_t)l * 2048 + g * 256;
#pragma unroll
    for (int hh = 0; hh < 2; ++hh) { const int j = hh * 64 + lane; float ss = 0.f;
#pragma unroll
        for (int cc = 0; cc < 4; ++cc) { const int cv = 4 * w + cc; const u32x4 raw = *(const u32x4*)(proj + (size_t)(R0 + j) * NPROJ + 8192 + g * 256 + 8 * cv);
            float f[8]; unpack8(raw, f);
#pragma unroll
            for (int e = 0; e < 8; ++e) { ss += f[e] * f[e]; VT[(8 * cv + e) * 136 + j] = (bf16_t)((e & 1) ? (raw[e >> 1] >> 16) : (raw[e >> 1] & 0xffffu)); } }
        pp[j * 8 + w] = ss; }
    LBAR;
    if (tid < 128) { float s = 0.f;
#pragma unroll
        for (int k = 0; k < 8; ++k) s += pp[tid * 8 + k];
        rs[tid] = rsqrtf(s * (1.0f / 256.f) + EPS); }
    LBAR;
    {
        const int i = tid >> 2, jq = (tid & 3) * 32;
        const float* wsrc = PIN(I_GWS) + (size_t)(l * 8 + g) * 128 * 128;
#pragma unroll
        for (int jv = 0; jv < 8; ++jv) { const int j = jq + 4 * jv; f32x4 w4 = (f32x4){0.f, 0.f, 0.f, 0.f};
            if (!sample) { if ((j >> 6) <= (i >> 6)) w4 = *(const f32x4*)(wsrc + i * 128 + j); }
            else { if ((j >> 4) == (i >> 4)) w4 = *(const f32x4*)(wsrc + (i & 15) * 128 + (j & 15)); }
            u32x2 pk; pk.x = pk2(w4[0] * rs[j], w4[1] * rs[j + 1]); pk.y = pk2(w4[2] * rs[j + 2], w4[3] * rs[j + 3]);
            *(u32x2*)(Ws + i * 136 + j) = pk; }
        if (sample) {
#pragma unroll 1
            for (int k = 0; k < 8; ++k) { const int cvv = tid & 31, j = (tid >> 5) + 16 * k; const u32x4 raw = *(const u32x4*)(proj + (size_t)(R0 + j) * NPROJ + 8192 + g * 256 + 8 * cvv);
                float f[8]; unpack8(raw, f); const float rj = rs[j]; const int s = blk * 8 + (j >> 4), t = j & 15;
                float* op = POUT + O_SV + ((size_t)((l * 32 + s) * 16 + t)) * 2048 + g * 256 + 8 * cvv;
                const f32x4 w0 = *(const f32x4*)(wv + 8 * cvv), w1 = *(const f32x4*)(wv + 8 * cvv + 4);
                *(f32x4*)op = (f32x4){f[0] * rj * w0[0], f[1] * rj * w0[1], f[2] * rj * w0[2], f[3] * rj * w0[3]};
                *(f32x4*)(op + 4) = (f32x4){f[4] * rj * w1[0], f[5] * rj * w1[1], f[6] * rj * w1[2], f[7] * rj * w1[3]}; }
        }
    }
    LBAR;
    {
        const int ib = w, i = 16 * ib + r; const size_t row = (size_t)(R0 + i);
        const int nks = (!sample && ib < 4) ? 2 : 4;
        bf16x8 yf[4];
#pragma unroll
        for (int ks = 0; ks < 4; ++ks) yf[ks] = ldfrag(Ws, 136, 16 * ib, 32 * ks, lane);
        const float bias = PIN(I_GBS)[(size_t)(l * 8 + g) * 128 + (sample ? (i & 15) : i)];
#pragma unroll 2
        for (int db = 0; db < 16; ++db) { f32x4 acc = (f32x4){0.f, 0.f, 0.f, 0.f};
#pragma unroll
            for (int ks = 0; ks < 4; ++ks) if (ks < nks) acc = mma16(ldfrag(VT, 136, 16 * db, 32 * ks, lane), yf[ks], acc);
            const int d = 16 * db + 4 * q; const f32x4 w4 = *(const f32x4*)(wv + d);
            const u32x2 uz = *(const u32x2*)(proj + row * NPROJ + 6144 + g * 256 + d);
            const float uu[4] = {__uint_as_float(uz.x << 16), __uint_as_float(uz.x & 0xffff0000u), __uint_as_float(uz.y << 16), __uint_as_float(uz.y & 0xffff0000u)};
            float y[4];
#pragma unroll
            for (int jj = 0; jj < 4; ++jj) y[jj] = (acc[jj] * w4[jj] + bias) * uu[jj];
            u32x2 pk; pk.x = pk2(y[0], y[1]); pk.y = pk2(y[2], y[3]);
            *(u32x2*)(mix + row * DMIX + 2048 + g * 256 + d) = pk; }
    }
    LBAR;
}

__device__ __forceinline__ void phase_sn(const Params& p, int l) {
    KA_INIT; TID_INIT;
    bf16_t* mix = (bf16_t*)(PWS + WS_MIX); const float* ssq = (const float*)(PWS + WS_SSQ); const float* nw = PIN(I_SNW) + (size_t)l * 2048;
    const int nth = gridDim.x * 512;
    for (int idx0 = blockIdx.x * 512 + tid; idx0 < T * 256; idx0 += 4 * nth) {
        u32x4 raw[4]; f32x4 s4[4], w0[4], w1[4];
#pragma unroll
        for (int u = 0; u < 4; ++u) { const int idx = idx0 + u * nth; if (idx < T * 256) { const int row = idx >> 8, col = (idx & 255) * 8, g = col >> 8;
            s4[u] = *(const f32x4*)(ssq + (size_t)row * 32 + 4 * g); raw[u] = *(const u32x4*)(mix + (size_t)row * DMIX + col); w0[u] = *(const f32x4*)(nw + col); w1[u] = *(const f32x4*)(nw + col + 4); } }
#pragma unroll
        for (int u = 0; u < 4; ++u) { const int idx = idx0 + u * nth; if (idx < T * 256) { const int row = idx >> 8, col = (idx & 255) * 8;
            const float rstd = rsqrtf((s4[u][0] + s4[u][1] + s4[u][2] + s4[u][3]) * (1.0f / 256.f) + EPS);
            float f[8]; unpack8(raw[u], f);
#pragma unroll
            for (int j = 0; j < 4; ++j) { f[j] *= rstd * w0[u][j]; f[4 + j] *= rstd * w1[u][j]; }
            *(u32x4*)(mix + (size_t)row * DMIX + col) = pack8(f); } }
    }
}

__device__ __forceinline__ void phase_e2(const Params& p, int l) {
    KA_INIT; TID_INIT;
    const bf16_t* up = (const bf16_t*)(PWS + WS_PROJ); bf16_t* act = (bf16_t*)(PWS + WS_MIX);
    const float* fw = PIN(I_FCW) + (size_t)l * 3 * DUP; const float* fb = PIN(I_FCB) + (size_t)l * DUP;
    const int nth = gridDim.x * 512;
    for (int idx = blockIdx.x * 512 + tid; idx < 1088 * 704; idx += nth) {
        const int f8 = idx % 704, rb = idx / 704, r0 = rb * 8, ch = f8 * 8;
        const bool sample = r0 >= TP; const int s = (r0 - TP) >> 4;
        const bool seqstart = sample ? ((r0 & 15) == 0) : ((r0 & 2047) == 0);
        const bool seqend = sample ? ((r0 & 15) == 8) : ((r0 & 2047) == 2040);
        u32x4 rg[10], rl[10];
#pragma unroll
        for (int k = 0; k < 10; ++k) { rg[k] = (u32x4){0u, 0u, 0u, 0u}; rl[k] = (u32x4){0u, 0u, 0u, 0u};
            if (k >= 2 || !seqstart) { rg[k] = *(const u32x4*)(up + (size_t)(r0 - 2 + k) * DUP + ch); rl[k] = *(const u32x4*)(up + (size_t)(r0 - 2 + k) * DUP + DFF + ch); } }
        float wg[3][8], wl[3][8], bg[8], bl[8];
#pragma unroll
        for (int k = 0; k < 3; ++k) { const f32x4 a0 = *(const f32x4*)(fw + k * DUP + ch), a1 = *(const f32x4*)(fw + k * DUP + ch + 4), c0 = *(const f32x4*)(fw + k * DUP + DFF + ch), c1 = *(const f32x4*)(fw + k * DUP + DFF + ch + 4);
#pragma unroll
            for (int j = 0; j < 4; ++j) { wg[k][j] = a0[j]; wg[k][4 + j] = a1[j]; wl[k][j] = c0[j]; wl[k][4 + j] = c1[j]; } }
        { const f32x4 a0 = *(const f32x4*)(fb + ch), a1 = *(const f32x4*)(fb + ch + 4), c0 = *(const f32x4*)(fb + DFF + ch), c1 = *(const f32x4*)(fb + DFF + ch + 4);
#pragma unroll
            for (int j = 0; j < 4; ++j) { bg[j] = a0[j]; bg[4 + j] = a1[j]; bl[j] = c0[j]; bl[4 + j] = c1[j]; } }
        float pg[2][8], pl[2][8];
#pragma unroll
        for (int k = 0; k < 2; ++k) { unpack8(rg[k], pg[k]); unpack8(rl[k], pl[k]);
            if (seqstart && sample) { const float* sp = PIN(I_SFFN) + ((size_t)(l * 32 + s) * 2 + k) * DUP + ch;
#pragma unroll
                for (int j = 0; j < 8; ++j) { pg[k][j] = sp[j]; pl[k][j] = sp[DFF + j]; } } }
#pragma unroll
        for (int rr = 0; rr < 8; ++rr) {
            float cg_[8], cl[8], o[8];
            unpack8(rg[rr + 2], cg_); unpack8(rl[rr + 2], cl);
#pragma unroll
            for (int j = 0; j < 8; ++j) {
                const float a = bg[j] + wg[0][j] * pg[0][j] + wg[1][j] * pg[1][j] + wg[2][j] * cg_[j];
                const float b = bl[j] + wl[0][j] * pl[0][j] + wl[1][j] * pl[1][j] + wl[2][j] * cl[j];
                o[j] = silu_f(a) * b;
                pg[0][j] = pg[1][j]; pg[1][j] = cg_[j]; pl[0][j] = pl[1][j]; pl[1][j] = cl[j];
            }
            *(u32x4*)(act + (size_t)(r0 + rr) * DFF + ch) = pack8(o);
            if (seqend && rr >= 6) {
                float* op = POUT + (sample ? O_SFFN + ((size_t)(l * 32 + s) * 2 + (rr - 6)) * DUP : O_PFFN + ((size_t)(l * 4 + (r0 >> 11)) * 2 + (rr - 6)) * DUP) + ch;
                *(f32x4*)op = (f32x4){cg_[0], cg_[1], cg_[2], cg_[3]}; *(f32x4*)(op + 4) = (f32x4){cg_[4], cg_[5], cg_[6], cg_[7]};
                *(f32x4*)(op + DFF) = (f32x4){cl[0], cl[1], cl[2], cl[3]}; *(f32x4*)(op + DFF + 4) = (f32x4){cl[4], cl[5], cl[6], cl[7]};
            }
        }
    }
}

__device__ __forceinline__ void run_g1(LAS unsigned char* lds, const bf16_t* A, const bf16_t* Bt, bf16_t* P, float* DT, const float* dtb) {
    pg8::StaticOrder S; S.init(T, NINP, gridDim.x, blockIdx.x); S.nkt = DM / 64; pg8::Gemm g{A, Bt, T, NINP, DM}; EpiG1 E{P, DT, dtb}; pg8::gemm_phase(lds, g, S, E); }
__device__ __forceinline__ void run_gx(LAS unsigned char* lds, const bf16_t* A, const bf16_t* Bt, float* X, float* SL, int K, int ns) {
    pg8::HybridOrder S; S.init(K, ns, gridDim.x, blockIdx.x); pg8::Gemm g{A, Bt, T, DM, K}; EpiX E{X, SL}; pg8::gemm_phase(lds, g, S, E); }
__device__ __forceinline__ void run_g3(LAS unsigned char* lds, const bf16_t* A, const bf16_t* Bt, bf16_t* U) {
    pg8::StaticOrder S; S.init(T, DUP, gridDim.x, blockIdx.x); S.nkt = DM / 64; pg8::Gemm g{A, Bt, T, DUP, DM}; EpiUp E{U}; pg8::gemm_phase(lds, g, S, E); }
#ifndef EN_PREP
#define EN_PREP 1
#endif
#ifndef EN_GEMM
#define EN_GEMM 15
#endif
#ifndef EN_SSD
#define EN_SSD 1
#endif
#ifndef EN_GMLP
#define EN_GMLP 1
#endif
#ifndef EN_SN
#define EN_SN 1
#endif
#ifndef EN_E2
#define EN_E2 1
#endif
#if PROBE
#define MARK(cls) do { if (blockIdx.x == 0 && threadIdx.x == 0) { const unsigned long long t_ = __builtin_amdgcn_s_memrealtime(); const unsigned d_ = (unsigned)(t_ - t_prev); t_prev = t_; \
    if (PROBE_A & (1 << (cls))) accA += d_; if (PROBE_B & (1 << (cls))) accB += d_; } } while (0)
#else
#define MARK(cls) do { } while (0)
#endif
#define WSP(T_, off) ((T_*)(PWS + (off)))
constexpr size_t WS_BAR = WS_END;
constexpr size_t WS_BAR_BYTES = 16384;
constexpr size_t WS_TOTAL = WS_END + WS_BAR_BYTES;
#define XB_TMO      128
#define XB_XCNT(j)  (256  + 64 * (j))
#define XB_XSUB(j)  (1280 + 64 * (j))
#define XB_XGEN(j)  (2304 + 64 * (j))
#define XB_TOP      3328
#define XB_TOPGEN   3392
#define XB_SPIN_CAP (1u << 18)
__device__ __forceinline__ unsigned xb_ld(unsigned* p)              { return __hip_atomic_load(p, __ATOMIC_RELAXED, __HIP_MEMORY_SCOPE_AGENT); }
__device__ __forceinline__ unsigned xb_add(unsigned* p, unsigned v) { return __hip_atomic_fetch_add(p, v, __ATOMIC_RELAXED, __HIP_MEMORY_SCOPE_AGENT); }
__device__ __forceinline__ unsigned xb_xcc_id() { return (unsigned)__builtin_amdgcn_s_getreg((3 << 11) | 20) & 0xFu; }
#define XB_SPIN(cond, bar) do { unsigned _sp = 0; while (cond) { __builtin_amdgcn_s_sleep(1); \
    if ((++_sp & 255u) == 0u) { if (xb_ld(&(bar)[XB_TMO])) break; if (_sp > XB_SPIN_CAP) { atomicAdd(&(bar)[XB_TMO], 1u); break; } } } } while (0)
__device__ __forceinline__ void xcd_barrier_complete(unsigned* bar, unsigned x, unsigned& nloc, unsigned& nx) {
    const unsigned G = gridDim.x;
    unsigned sum, cnt, mine, sp = 0u;
    for (;;) {
        sum = 0u; cnt = 0u; mine = 0u;
#pragma unroll
        for (unsigned j = 0; j < 16; ++j) { const unsigned c = xb_ld(&bar[XB_XCNT(j)]); sum += c; cnt += (c > 0u) ? 1u : 0u; mine = (j == x) ? c : mine; }
        if (sum == G) break;
        __builtin_amdgcn_s_sleep(1);
        if ((++sp & 255u) == 0u) { if (xb_ld(&bar[XB_TMO])) break; if (sp > XB_SPIN_CAP) { atomicAdd(&bar[XB_TMO], 1u); break; } }
    }
    nloc = mine > 0u ? mine : 1u; nx = cnt > 0u ? cnt : 1u;
}
__device__ __forceinline__ void xcd_barrier(unsigned* bar, volatile LAS unsigned* st) {
    asm volatile("s_waitcnt vmcnt(0)" ::: "memory");
    __syncthreads();
    if (threadIdx.x == 0) {
        const unsigned x = xb_xcc_id();
        __builtin_amdgcn_s_waitcnt(0);
        unsigned nloc = st[0], nx = st[1];
        if (nloc == 0u) { xcd_barrier_complete(bar, x, nloc, nx); st[0] = nloc; st[1] = nx; }
        const unsigned old = xb_add(&bar[XB_XSUB(x)], 1u);
        const unsigned gen = old / nloc;
        if (old + 1u == (gen + 1u) * nloc) {
            __builtin_amdgcn_fence(__ATOMIC_RELEASE, "agent");
            asm volatile("s_waitcnt vmcnt(0)" ::: "memory");
            const unsigned og = xb_add(&bar[XB_TOP], 1u);
            const unsigned tg = og / nx;
            if (og + 1u == (tg + 1u) * nx) xb_add(&bar[XB_TOPGEN], 1u);
            else XB_SPIN(xb_ld(&bar[XB_TOPGEN]) == tg, bar);
            __builtin_amdgcn_fence(__ATOMIC_ACQUIRE, "agent");
            xb_add(&bar[XB_XGEN(x)], 1u);
            asm volatile("s_waitcnt vmcnt(0)" ::: "memory");
        } else {
            XB_SPIN(xb_ld(&bar[XB_XGEN(x)]) == gen, bar);
            __builtin_amdgcn_fence(__ATOMIC_ACQUIRE, "agent");
            asm volatile("s_waitcnt vmcnt(0)" ::: "memory");
        }
    }
    __syncthreads();
}
#define GSYNC do { KA_INIT; xcd_barrier((unsigned*)(PWS + WS_BAR), (volatile LAS unsigned*)((LAS unsigned char*)shm + 147456)); } while (0)
__global__ void __launch_bounds__(512, 2) fwd_kernel(Params p) {
    extern __shared__ __attribute__((aligned(16))) unsigned char shm[];
    { KA_INIT;
      volatile LAS unsigned* st = (volatile LAS unsigned*)((LAS unsigned char*)shm + 147456);
      if (threadIdx.x == 0) { st[0] = 0u; st[1] = 0u; (void)xb_add(&((unsigned*)(PWS + WS_BAR))[XB_XCNT(xb_xcc_id())], 1u); }
      __syncthreads(); }
#if PROBE
    unsigned long long t_prev = __builtin_amdgcn_s_memrealtime(); unsigned accA = 0, accB = 0;
#endif
    { KA_INIT; if (PWS == nullptr) cg::this_grid().sync(); }
    for (int l = 0; l < 2; ++l) {
#if EN_PREP
        { KA_INIT;
        convert_w(PIN(I_WIN) + (size_t)l * DM * DIN, DM, DIN, WSP(bf16_t, WS_WIN), NINP, 1, shm);
        if (l == 0) phase_norm<0>(p, PIN(I_N1W), 0, shm); else phase_norm<1>(p, PIN(I_N1W) + DM, 11, shm); }
#endif
        GSYNC;
        MARK(0);
        if (EN_GEMM & 1) { KA_INIT; run_g1((LAS unsigned char*)shm, WSP(bf16_t, WS_H), WSP(bf16_t, WS_WIN), WSP(bf16_t, WS_PROJ), WSP(float, WS_DT), PIN(I_DTB) + l * 32); }
        if (EN_PREP && gridDim.x == 256 && blockIdx.x >= 114) convert_list(l, (int)blockIdx.x - 114, 142, 19, shm);
        GSYNC; MARK(1);
        {
            const int step = blockIdx.x < 128 ? (1 << 20) : (int)gridDim.x - 128;
            if (EN_SSD) for (int it = blockIdx.x; it < 1152; it += step) { const bool smp = it >= 128; ssd_chain(p, l, smp, smp ? (it - 128) >> 5 : it >> 5, it & 31, shm); }
            if (EN_GMLP) if (blockIdx.x >= 128) for (int it = blockIdx.x - 128; it < 544; it += step) { const bool smp = it >= 512; gmlp_item(p, l, smp, smp ? it - 512 : it, shm); }
        }
        GSYNC; MARK(2);
        if (EN_PREP) convert_list(l, (gridDim.x == 256 ? 2698 : 0) + (int)blockIdx.x, (int)gridDim.x, 1 << 20, shm);
        if (EN_SN) phase_sn(p, l);
        GSYNC; MARK(3);
        if (EN_GEMM & 2) { KA_INIT; run_gx((LAS unsigned char*)shm, WSP(bf16_t, WS_MIX), WSP(bf16_t, WS_WOUT), WSP(float, WS_X), WSP(float, WS_PROJ), DMIX, 16); }
        GSYNC; MARK(4);
        { KA_INIT; phase_norm<1>(p, PIN(I_N2W) + (size_t)l * DM, 16, shm); }
        GSYNC; MARK(5);
        if (EN_GEMM & 4) { KA_INIT; run_g3((LAS unsigned char*)shm, WSP(bf16_t, WS_H), WSP(bf16_t, WS_WUP), WSP(bf16_t, WS_PROJ)); }
        GSYNC; MARK(6);
        if (EN_E2) phase_e2(p, l);
        GSYNC; MARK(7);
        if (EN_GEMM & 8) { KA_INIT; run_gx((LAS unsigned char*)shm, WSP(bf16_t, WS_MIX), WSP(bf16_t, WS_WDN), WSP(float, WS_X), WSP(float, WS_PROJ), DFF, 11); }
        GSYNC; MARK(8);
    }
#if PROBE
    float addA = 0.f;
    if (blockIdx.x == 0 && threadIdx.x == 0) { KA_INIT; addA = 10.f + (float)accA * (0.01f / 150.f); float* q_ = POUT + O_PCONV; *q_ = *q_ + 4.f + (float)accB * (0.01f / 1000.f); }
    { KA_INIT; phase_norm<2>(p, PIN(I_FNW), 11, shm, addA); }
#else
    { KA_INIT; phase_norm<2>(p, PIN(I_FNW), 11, shm); }
#endif
}

extern "C" void kernel_launch(void* const* d_in, const int* in_sizes, int n_in, void* d_out, int out_size, void* d_ws, size_t ws_size, hipStream_t stream) {
    static int grid = 0;
    if (grid == 0) {
        if (n_in != 23 || ws_size < WS_TOTAL) { fprintf(stderr, "kernel_launch: n_in %d ws %zu (need %zu)\n", n_in, ws_size, (size_t)WS_TOTAL); grid = -1; return; }
        int dev = 0, cus = 0, per_cu = 0;
        hipGetDevice(&dev); hipDeviceGetAttribute(&cus, hipDeviceAttributeMultiprocessorCount, dev);
        hipFuncSetAttribute((const void*)fwd_kernel, hipFuncAttributeMaxDynamicSharedMemorySize, LDS_BYTES);
        hipOccupancyMaxActiveBlocksPerMultiprocessor(&per_cu, (const void*)fwd_kernel, 512, LDS_BYTES);
        (void)hipGetLastError();
        if (per_cu < 1) per_cu = 1;
        grid = cus;
        if (grid < 129) { fprintf(stderr, "kernel_launch: needs > 128 CUs\n"); grid = -1; return; }
    }
    if (grid < 0) return;
    (void)hipMemsetAsync((unsigned char*)d_ws + WS_BAR, 0, WS_BAR_BYTES, stream);
    Params p{};
    for (int i = 0; i < 23; ++i) p.in[i] = (const float*)d_in[i];
    p.out = (float*)d_out; p.ws = (unsigned char*)d_ws;
    void* args[] = {&p};
    hipError_t e = hipLaunchCooperativeKernel((const void*)fwd_kernel, dim3(grid), dim3(512), args, LDS_BYTES, stream);
    if (e != hipSuccess) fprintf(stderr, "cooperative launch failed: %s (grid %d)\n", hipGetErrorString(e), grid);
}
```

```cpp
#include <hip/hip_runtime.h>
#include <hip/hip_cooperative_groups.h>
#include <cstdio>
namespace cg = cooperative_groups;

#define LAS __attribute__((address_space(3)))
typedef unsigned short bf16_t;
typedef short bf16x8 __attribute__((ext_vector_type(8)));
typedef float f32x4 __attribute__((ext_vector_type(4)));
typedef unsigned u32x4 __attribute__((ext_vector_type(4)));
typedef unsigned u32x2 __attribute__((ext_vector_type(2)));

#ifndef PROBE_A
#define PROBE_A 0
#endif
#ifndef PROBE_B
#define PROBE_B 0
#endif
#define PROBE (PROBE_A | PROBE_B)
constexpr int TP = 8192, TS = 512, T = 8704;
constexpr int DM = 2048, NPROJ = 10240, NINP = 10496, DIN = 10272;
constexpr int DMIX = 4096, DFF = 5632, DUP = 11264;
constexpr float EPS = 1e-6f;
constexpr size_t WS_WIN = 0;
constexpr size_t WS_WOUT = WS_WIN + (size_t)NINP * DM * 2;
constexpr size_t WS_WUP = WS_WOUT + (size_t)DM * DMIX * 2;
constexpr size_t WS_WDN = WS_WUP + (size_t)DUP * DM * 2;
constexpr size_t WS_X = WS_WDN + (size_t)DM * DFF * 2;
constexpr size_t WS_H = WS_X + (size_t)T * DM * 4;
constexpr size_t WS_PROJ = WS_H + (size_t)T * DM * 2;
constexpr size_t WS_MIX = WS_PROJ + (size_t)T * DUP * 2;
constexpr size_t WS_DT = WS_MIX + (size_t)T * DFF * 2;
constexpr size_t WS_SSQ = WS_DT + (size_t)T * 32 * 4;
constexpr size_t WS_BC = WS_SSQ + (size_t)T * 32 * 4;
constexpr size_t WS_END = WS_BC + (size_t)T * 2048 * 2;
constexpr size_t O_YP = 0, O_PCONV = 17825792, O_PSSD = 17924096, O_PFFN = 20021248, O_SCONV = 20201472, O_SSSD = 20987904, O_SFFN = 37765120, O_SV = 39206912;
constexpr int LDS_BYTES = 147456 + 256;

struct Params { const float* in[23]; float* out; unsigned char* ws; };
typedef const unsigned char __attribute__((address_space(4)))* kaptr_t;
#define KA_INIT kaptr_t ka_ = (kaptr_t)__builtin_amdgcn_kernarg_segment_ptr(); asm volatile("" : "+s"(ka_))
#define PIN(i) (*(const float* const __attribute__((address_space(4)))*)(ka_ + 8 * (i)))
#define POUT ((float*)PIN(23))
#define PWS ((unsigned char*)PIN(24))
#define TID_INIT int tid = threadIdx.x; asm volatile("" : "+v"(tid))
enum { I_XP = 0, I_XS, I_SCONV, I_SSSD, I_SFFN, I_N1W, I_WIN, I_CW, I_CB, I_DTB, I_ALOG, I_D, I_SNW, I_GNW, I_GWS, I_GBS, I_WOUT, I_N2W, I_WUP, I_FCW, I_FCB, I_WDN, I_FNW };

__device__ __forceinline__ float bf2f(bf16_t b) { return __uint_as_float(((unsigned)b) << 16); }
__device__ __forceinline__ unsigned pk2(float lo, float hi) { unsigned r; asm volatile("v_cvt_pk_bf16_f32 %0, %1, %2" : "=v"(r) : "v"(lo), "v"(hi)); return r; }
__device__ __forceinline__ bf16_t f2bf(float f) { return (bf16_t)(pk2(f, 0.f) & 0xffffu); }
__device__ __forceinline__ void unpack8(u32x4 v, float* f) {
#pragma unroll
    for (int i = 0; i < 4; ++i) { f[2 * i] = __uint_as_float(v[i] << 16); f[2 * i + 1] = __uint_as_float(v[i] & 0xffff0000u); }
}
__device__ __forceinline__ u32x4 pack8(const float* f) { u32x4 r; r.x = pk2(f[0], f[1]); r.y = pk2(f[2], f[3]); r.z = pk2(f[4], f[5]); r.w = pk2(f[6], f[7]); return r; }
__device__ __forceinline__ float silu_f(float x) { return x * __builtin_amdgcn_rcpf(1.0f + __expf(-x)); }
__device__ __forceinline__ float gelu_f(float x) { const float t = 1.5957691216057308f * (x + 0.044715f * x * x * x); return x * __builtin_amdgcn_rcpf(1.0f + __expf(-t)); }
__device__ __forceinline__ float softplus_f(float x) { return x > 20.f ? x : __logf(1.0f + __expf(x)); }
__device__ __forceinline__ float wave_sum(float v) {
#pragma unroll
    for (int o = 32; o > 0; o >>= 1) v += __shfl_xor(v, o);
    return v;
}

#define LBAR asm volatile("s_waitcnt lgkmcnt(0)\n\ts_barrier" ::: "memory")
namespace pg8 {
constexpr int BM = 256, BK = 64, HALF = 128, HTB = HALF * BK * 2, NXCD = 8, WGM = 8;
__device__ __forceinline__ int lds_byte(int r, int c) { const int st = (r >> 4) * 2 + (c >> 5), rr = r & 15, cc = c & 31, ob = rr * 64 + cc * 2; return st * 1024 + (ob ^ (((ob >> 9) & 1) << 5)); }
__device__ __forceinline__ void stage_rc(int b, int& R, int& C) { const int st = b / 1024, sb = b % 1024, swz = sb ^ (((sb >> 9) & 1) << 5); R = (st >> 1) * 16 + swz / 64; C = (st & 1) * 32 + (swz % 64) / 2; }
__device__ __forceinline__ int perm32(int rho) { const int n = rho >> 4, i = rho & 15; return 8 * (i >> 2) + 4 * n + (i & 3); }
struct Unit { int pm, pn, kt0, nkt, slab; };
struct Gemm { const bf16_t* A; const bf16_t* Bt; int M, N, K; };
struct StaticOrder {
    int nM, nN, nwg, G, c, nkt;
    __device__ void init(int M, int N, int G_, int c_) { nM = M / BM; nN = N / BM; nwg = nM * nN; G = G_; c = c_; nkt = 0; }
    __device__ bool next(int i, Unit& u) const {
        const long L = (long)i * G + c; if (L >= nwg) return false;
        int wgid = (int)L; { const int q = nwg / NXCD, r = nwg % NXCD, xcd = wgid % NXCD, off = wgid / NXCD; wgid = (xcd < r ? xcd * (q + 1) : r * (q + 1) + (xcd - r) * q) + off; }
        const int nig = WGM * nN, gid = wgid / nig, fm = gid * WGM, gsz = (nM - fm) < WGM ? (nM - fm) : WGM;
        u.pm = fm + ((wgid % nig) % gsz); u.pn = (wgid % nig) / gsz; u.kt0 = 0; u.nkt = nkt; u.slab = -1; return true;
    }
};
struct HybridOrder {
    StaticOrder so; int ns, kper, c;
    __device__ void init(int K, int ns_, int G_, int c_) { so.init(TP, DM, G_, c_); so.nkt = K / BK; ns = ns_; kper = K / BK / ns_; c = c_; }
    __device__ bool next(int i, Unit& u) const {
        if (so.next(i, u)) return true;
        const int nmr = c < so.nwg ? (so.nwg - c + so.G - 1) / so.G : 0;
        const long q = (long)(i - nmr) * so.G + c;
        if (i >= nmr && q < 16 * ns) { const int s = (int)q % ns, tile = (int)q / ns; u.pm = 32 + (tile >> 3); u.pn = tile & 7; u.kt0 = s * kper; u.nkt = kper; u.slab = (tile >> 3) * ns + s; return true; }
        return false;
    }
};
template <class Epi, class Sched>
__device__ __forceinline__ void gemm_phase(LAS unsigned char* lds, const Gemm g, const Sched& S, const Epi& E) {
    int tid = threadIdx.x; asm volatile("" : "+v"(tid));
    const int wid = __builtin_amdgcn_readfirstlane(tid >> 6), lane = tid & 63, wr = wid >> 2, wc = wid & 3, fr = lane & 15, fq = lane >> 4;
    int K = __builtin_amdgcn_readfirstlane(g.K); asm volatile("" : "+s"(K));
    unsigned voffA[2], voffB[2];
#pragma unroll
    for (int i = 0; i < 2; ++i) { int R, C; stage_rc(tid * 16 + i * 8192, R, C); const int Rb = (R & ~31) + perm32(R & 31);
        voffA[i] = (unsigned)(R * K + C) * 2u; voffB[i] = (unsigned)(Rb * K + C) * 2u; }
    const size_t kstep = (size_t)(BK * 2);
    const size_t hstep = (size_t)HALF * K * 2;
    const size_t tstep = 2 * hstep;
    const unsigned ldsw = (unsigned)wid * 1024u;
    const int aoff = lds_byte(wr * 64 + fr, fq * 8), boff = lds_byte(wc * 32 + fr, fq * 8);
#define PG8_SA(b, h) (((b) * 2 + (h)) * HTB)
#define PG8_SB(b, h) ((4 + (b) * 2 + (h)) * HTB)
#define PG8_STAGE(bufoff, gbase, voff) do { _Pragma("unroll") for (int _i = 0; _i < 2; ++_i) \
        __builtin_amdgcn_global_load_lds((const unsigned*)((const char*)(gbase) + (voff)[_i]), (LAS unsigned*)(lds + (bufoff) + ldsw + _i * 8192), 16, 0, 0); } while (0)
#define PG8_LDA(dst, b, h) do { _Pragma("unroll") for (int m = 0; m < 4; ++m) _Pragma("unroll") for (int k = 0; k < 2; ++k) dst[m][k] = *(const LAS bf16x8*)(lds + PG8_SA(b, h) + aoff + m * 2048 + k * 1024); } while (0)
#define PG8_LDB(dst, b, h) do { _Pragma("unroll") for (int n = 0; n < 2; ++n) _Pragma("unroll") for (int k = 0; k < 2; ++k) dst[n][k] = *(const LAS bf16x8*)(lds + PG8_SB(b, h) + boff + n * 2048 + k * 1024); } while (0)
#define PG8_MMA(ai, bj, At, Bt) do { __builtin_amdgcn_s_setprio(1); _Pragma("unroll") for (int m = 0; m < 4; ++m) _Pragma("unroll") for (int n = 0; n < 2; ++n) _Pragma("unroll") for (int k = 0; k < 2; ++k) \
        acc[ai][bj][m][n] = __builtin_amdgcn_mfma_f32_16x16x32_bf16(Bt[n][k], At[m][k], acc[ai][bj][m][n], 0, 0, 0); __builtin_amdgcn_s_setprio(0); } while (0)
#define PG8_WAIT_V(n) asm volatile("s_waitcnt vmcnt(" #n ")" ::: "memory")
#define PG8_WAIT_L(n) asm volatile("s_waitcnt lgkmcnt(" #n ")" ::: "memory")
#define PG8_BAR __builtin_amdgcn_s_barrier()
#define PG8_SCHED __builtin_amdgcn_sched_barrier(0)
    Unit cur, nxt; int ui = 0;
    if (!S.next(0, cur)) return;
    f32x4 acc[2][2][4][2];
#pragma unroll
    for (int a = 0; a < 2; ++a)
#pragma unroll
        for (int b = 0; b < 2; ++b)
#pragma unroll
            for (int m = 0; m < 4; ++m)
#pragma unroll
                for (int n = 0; n < 2; ++n) acc[a][b][m][n] = (f32x4){0.f, 0.f, 0.f, 0.f};
    bf16x8 At[4][2], B0[2][2], B1[2][2];
    const char* cA = (const char*)g.A + (size_t)cur.pm * tstep + (size_t)cur.kt0 * kstep; const char* cB = (const char*)g.Bt + (size_t)cur.pn * tstep + (size_t)cur.kt0 * kstep;
    PG8_STAGE(PG8_SB(0, 0), cB, voffB); PG8_STAGE(PG8_SA(0, 0), cA, voffA); PG8_STAGE(PG8_SB(0, 1), cB + hstep, voffB); PG8_STAGE(PG8_SA(0, 1), cA + hstep, voffA);
    if (wr == 1) PG8_BAR;
    PG8_WAIT_V(4); PG8_BAR;
    PG8_STAGE(PG8_SB(1, 0), cB + kstep, voffB); PG8_STAGE(PG8_SA(1, 0), cA + kstep, voffA); PG8_STAGE(PG8_SB(1, 1), cB + hstep + kstep, voffB);
    PG8_WAIT_V(6); PG8_BAR;
    for (;;) {
        const bool has_next = S.next(ui + 1, nxt);
        const char* nA = has_next ? (const char*)g.A + (size_t)nxt.pm * tstep + (size_t)nxt.kt0 * kstep : cA; const char* nB = has_next ? (const char*)g.Bt + (size_t)nxt.pn * tstep + (size_t)nxt.kt0 * kstep : cB;
        const int nt = cur.nkt;
        for (int t = 0; t < nt; t += 2) {
            const bool last = (t == nt - 2);
            const char* a1 = cA + (size_t)(t + 1) * kstep;
            const char* a2 = last ? nA : cA + (size_t)(t + 2) * kstep; const char* b2 = last ? nB : cB + (size_t)(t + 2) * kstep;
            const char* a3 = a2 + kstep; const char* b3 = b2 + kstep;
            PG8_LDB(B0, 0, 0); PG8_SCHED; PG8_LDA(At, 0, 0); PG8_STAGE(PG8_SA(1, 1), a1 + hstep, voffA);
            PG8_WAIT_L(8); PG8_BAR; PG8_WAIT_L(0); PG8_MMA(0, 0, At, B0); PG8_BAR; PG8_SCHED;
            PG8_LDB(B1, 0, 1); PG8_STAGE(PG8_SB(0, 0), b2, voffB);
            PG8_BAR; PG8_WAIT_L(0); PG8_MMA(0, 1, At, B1); PG8_BAR;
            PG8_LDA(At, 0, 1); PG8_STAGE(PG8_SA(0, 0), a2, voffA);
            PG8_BAR; PG8_WAIT_L(0); PG8_MMA(1, 0, At, B0); PG8_BAR; PG8_SCHED;
            PG8_STAGE(PG8_SB(0, 1), b2 + hstep, voffB);
            PG8_WAIT_V(6); PG8_BAR; PG8_MMA(1, 1, At, B1); PG8_BAR;
            PG8_LDB(B0, 1, 0); PG8_SCHED; PG8_LDA(At, 1, 0); PG8_STAGE(PG8_SA(0, 1), a2 + hstep, voffA);
            PG8_WAIT_L(8); PG8_BAR; PG8_WAIT_L(0); PG8_MMA(0, 0, At, B0); PG8_BAR; PG8_SCHED;
            PG8_LDB(B1, 1, 1); PG8_STAGE(PG8_SB(1, 0), b3, voffB);
            PG8_BAR; PG8_WAIT_L(0); PG8_MMA(0, 1, At, B1); PG8_BAR;
            PG8_LDA(At, 1, 1); PG8_STAGE(PG8_SA(1, 0), a3, voffA);
            PG8_BAR; PG8_WAIT_L(0); PG8_MMA(1, 0, At, B0); PG8_BAR; PG8_SCHED;
            PG8_STAGE(PG8_SB(1, 1), b3 + hstep, voffB);
            PG8_WAIT_V(6); PG8_BAR; PG8_MMA(1, 1, At, B1); PG8_BAR;
        }
        E(acc, cur, wr, wc, fr, fq);
        if (!has_next) break;
#pragma unroll
        for (int a = 0; a < 2; ++a)
#pragma unroll
            for (int b = 0; b < 2; ++b)
#pragma unroll
                for (int m = 0; m < 4; ++m)
#pragma unroll
                    for (int n = 0; n < 2; ++n) acc[a][b][m][n] = (f32x4){0.f, 0.f, 0.f, 0.f};
        cur = nxt; cA = nA; cB = nB; ++ui;
    }
    PG8_WAIT_V(0);
    if (wr == 0) PG8_BAR;
    PG8_BAR;
#undef PG8_SA
#undef PG8_SB
#undef PG8_STAGE
#undef PG8_LDA
#undef PG8_LDB
#undef PG8_MMA
#undef PG8_WAIT_V
#undef PG8_WAIT_L
#undef PG8_BAR
#undef PG8_SCHED
}
}
using pg8::Unit;

struct EpiG1 {
    bf16_t* P; float* DT; const float* dtb;
    __device__ __forceinline__ void operator()(const f32x4 (&acc)[2][2][4][2], const Unit& u, int wr, int wc, int fr, int fq) const {
        const int row0 = u.pm * 256 + wr * 64 + fr;
        if (u.pn < 40) {
            const int mode = u.pn < 8 ? 1 : (u.pn < 24 ? 0 : 2);
            const int col0 = u.pn * 256 + wc * 32 + 8 * fq;
#pragma unroll
            for (int ai = 0; ai < 2; ++ai)
#pragma unroll
                for (int m = 0; m < 4; ++m) { bf16_t* rowp = P + (size_t)(row0 + ai * 128 + m * 16) * NPROJ + col0;
#pragma unroll
                    for (int bj = 0; bj < 2; ++bj) { float v[8];
#pragma unroll
                        for (int j = 0; j < 4; ++j) { v[j] = acc[ai][bj][m][0][j]; v[4 + j] = acc[ai][bj][m][1][j]; }
                        if (mode == 1) {
#pragma unroll
                            for (int j = 0; j < 8; ++j) v[j] = silu_f(v[j]); }
                        else if (mode == 2) {
#pragma unroll
                            for (int j = 0; j < 8; ++j) v[j] = gelu_f(v[j]); }
                        *(u32x4*)(rowp + bj * 128) = pack8(v); } }
        } else if (wc == 0) {
#pragma unroll
            for (int ai = 0; ai < 2; ++ai)
#pragma unroll
                for (int m = 0; m < 4; ++m) { float* rowp = DT + (size_t)(row0 + ai * 128 + m * 16) * 32 + 8 * fq;
#pragma unroll
                    for (int n = 0; n < 2; ++n) { f32x4 o;
#pragma unroll
                        for (int j = 0; j < 4; ++j) o[j] = softplus_f(acc[ai][0][m][n][j] + dtb[8 * fq + 4 * n + j]);
                        *(f32x4*)(rowp + 4 * n) = o; } }
        }
    }
};
struct EpiX {
    float* X; float* SL;
    __device__ __forceinline__ void operator()(const f32x4 (&acc)[2][2][4][2], const Unit& u, int wr, int wc, int fr, int fq) const {
        const int col0 = u.pn * 256 + wc * 32 + 8 * fq;
        if (u.slab < 0) {
            const int row0 = u.pm * 256 + wr * 64 + fr;
#pragma unroll
            for (int ai = 0; ai < 2; ++ai)
#pragma unroll
                for (int m = 0; m < 4; ++m) { float* rowp = X + (size_t)(row0 + ai * 128 + m * 16) * DM + col0;
#pragma unroll
                    for (int bj = 0; bj < 2; ++bj) { f32x4* q = (f32x4*)(rowp + bj * 128); f32x4 a = q[0], b = q[1]; q[0] = a + acc[ai][bj][m][0]; q[1] = b + acc[ai][bj][m][1]; } }
        } else {
            float* base = SL + (size_t)u.slab * 256 * DM; const int row0 = wr * 64 + fr;
#pragma unroll
            for (int ai = 0; ai < 2; ++ai)
#pragma unroll
                for (int m = 0; m < 4; ++m) { float* rowp = base + (size_t)(row0 + ai * 128 + m * 16) * DM + col0;
#pragma unroll
                    for (int bj = 0; bj < 2; ++bj) { f32x4* q = (f32x4*)(rowp + bj * 128); q[0] = acc[ai][bj][m][0]; q[1] = acc[ai][bj][m][1]; } }
        }
    }
};
struct EpiUp {
    bf16_t* U;
    __device__ __forceinline__ void operator()(const f32x4 (&acc)[2][2][4][2], const Unit& u, int wr, int wc, int fr, int fq) const {
        const int row0 = u.pm * 256 + wr * 64 + fr, col0 = u.pn * 256 + wc * 32 + 8 * fq;
#pragma unroll
        for (int ai = 0; ai < 2; ++ai)
#pragma unroll
            for (int m = 0; m < 4; ++m) { bf16_t* rowp = U + (size_t)(row0 + ai * 128 + m * 16) * DUP + col0;
#pragma unroll
                for (int bj = 0; bj < 2; ++bj) { u32x4 w; w.x = pk2(acc[ai][bj][m][0][0], acc[ai][bj][m][0][1]); w.y = pk2(acc[ai][bj][m][0][2], acc[ai][bj][m][0][3]);
                    w.z = pk2(acc[ai][bj][m][1][0], acc[ai][bj][m][1][1]); w.w = pk2(acc[ai][bj][m][1][2], acc[ai][bj][m][1][3]); *(u32x4*)(rowp + bj * 128) = w; } }
    }
};

__device__ __forceinline__ int map_col(int n, int mode) {
    if (mode == 0) return n;
    if (n < 6144) return n; if (n < 10240) return n + 32; if (n < 10272) return n - 10240 + 6144; return -1;
}
__device__ __forceinline__ void convert_w(const float* __restrict__ src, int K, int Nsrc, bf16_t* __restrict__ dst, int Ndst, int mode, unsigned char* shm) {
    float* tile = (float*)shm;
    TID_INIT;
    const int ntn = Ndst / 256, ntk = K / 64, ntile = ntn * ntk;
    const int tkk = tid >> 4, tn4 = tid & 15, wn = tid >> 3, wk8 = tid & 7;
    f32x4 v[4][2];
    int t = blockIdx.x;
#define CW_LOAD(tt_) do { const int tn_ = (tt_) % ntn, tk_ = (tt_) / ntn; \
        _Pragma("unroll") for (int s_ = 0; s_ < 4; ++s_) { const int sc_ = map_col(tn_ * 256 + 64 * s_ + 4 * tn4, mode); \
            _Pragma("unroll") for (int i_ = 0; i_ < 2; ++i_) { v[s_][i_] = (f32x4){0.f, 0.f, 0.f, 0.f}; if (sc_ >= 0) v[s_][i_] = *(const f32x4*)(src + (size_t)(tk_ * 64 + tkk + 32 * i_) * Nsrc + sc_); } } } while (0)
    if (t < ntile) CW_LOAD(t);
    for (; t < ntile; t += gridDim.x) {
        const int tn = t % ntn, tk = t / ntn, n0 = tn * 256, k0 = tk * 64;
#pragma unroll
        for (int s_ = 0; s_ < 4; ++s_)
#pragma unroll
            for (int i = 0; i < 2; ++i)
#pragma unroll
                for (int j = 0; j < 4; ++j) tile[(tkk + 32 * i) * 257 + 64 * s_ + 4 * tn4 + j] = v[s_][i][j];
        LBAR;
        if (t + (int)gridDim.x < ntile) CW_LOAD(t + (int)gridDim.x);
#pragma unroll
        for (int s_ = 0; s_ < 4; ++s_) { float f[8];
#pragma unroll
            for (int j = 0; j < 8; ++j) f[j] = tile[(8 * wk8 + j) * 257 + 64 * s_ + wn];
            *(u32x4*)(dst + (size_t)(n0 + 64 * s_ + wn) * K + k0 + 8 * wk8) = pack8(f); }
        LBAR;
    }
#undef CW_LOAD
}

constexpr int CVT_REST_TILES = 2624;
struct CvtTile { const float* src; bf16_t* dst; int K, Nsrc, n0, k0; };
__device__ __forceinline__ CvtTile cvt_decode(int t, int l, kaptr_t ka_) {
    CvtTile c; int ntn, tt;
    if (t < 512) { ntn = 8; tt = t; c.src = PIN(I_WOUT) + (size_t)l * DMIX * DM; c.K = DMIX; c.Nsrc = DM; c.dst = (bf16_t*)(PWS + WS_WOUT); }
    else if (t < 1920) { ntn = 44; tt = t - 512; c.src = PIN(I_WUP) + (size_t)l * DM * DUP; c.K = DM; c.Nsrc = DUP; c.dst = (bf16_t*)(PWS + WS_WUP); }
    else { ntn = 8; tt = t - 1920; c.src = PIN(I_WDN) + (size_t)l * DFF * DM; c.K = DFF; c.Nsrc = DM; c.dst = (bf16_t*)(PWS + WS_WDN); }
    c.n0 = (tt % ntn) * 256; c.k0 = (tt / ntn) * 64; return c;
}
__device__ __forceinline__ void convert_list(int l, int t0, int stride, int niter, unsigned char* shm) {
    KA_INIT; TID_INIT;
    float* tile = (float*)shm;
    const int tkk = tid >> 4, tn4 = tid & 15, wn = tid >> 3, wk8 = tid & 7;
    f32x4 v[4][2];
    int t = t0; asm volatile("" : "+s"(t));
#define CL_LOAD(tt_) do { const CvtTile c_ = cvt_decode((tt_), l, ka_); \
        _Pragma("unroll") for (int s_ = 0; s_ < 4; ++s_) _Pragma("unroll") for (int i_ = 0; i_ < 2; ++i_) \
            v[s_][i_] = *(const f32x4*)(c_.src + (size_t)(c_.k0 + tkk + 32 * i_) * c_.Nsrc + c_.n0 + 64 * s_ + 4 * tn4); } while (0)
    if (niter > 0 && t < CVT_REST_TILES) CL_LOAD(t);
    for (int k = 0; k < niter && t < CVT_REST_TILES; ++k, t += stride) {
        const CvtTile c = cvt_decode(t, l, ka_);
#pragma unroll
        for (int s_ = 0; s_ < 4; ++s_)
#pragma unroll
            for (int i = 0; i < 2; ++i)
#pragma unroll
                for (int j = 0; j < 4; ++j) tile[(tkk + 32 * i) * 257 + 64 * s_ + 4 * tn4 + j] = v[s_][i][j];
        LBAR;
        if (k + 1 < niter && t + stride < CVT_REST_TILES) CL_LOAD(t + stride);
#pragma unroll
        for (int s_ = 0; s_ < 4; ++s_) { float f[8];
#pragma unroll
            for (int j = 0; j < 8; ++j) f[j] = tile[(8 * wk8 + j) * 257 + 64 * s_ + wn];
            *(u32x4*)(c.dst + (size_t)(c.n0 + 64 * s_ + wn) * c.K + c.k0 + 8 * wk8) = pack8(f); }
        LBAR;
    }
#undef CL_LOAD
}

template <int MODE>
__device__ __forceinline__ void phase_norm(const Params& p, const float* __restrict__ w, int ns, unsigned char* shm, float addA = 0.f) {
    KA_INIT; TID_INIT;
    const int lane = tid & 63, wv_ = tid >> 6, gw = blockIdx.x * 8 + wv_, nw = gridDim.x * 8;
    float* X = (float*)(PWS + WS_X); bf16_t* H = (bf16_t*)(PWS + WS_H);
    const int nrows = ns > 0 ? TP : T;
    for (int row = gw; row < nrows; row += nw) {
        const float* src = MODE == 0 ? (row < TP ? PIN(I_XP) + (size_t)row * DM : PIN(I_XS) + (size_t)(row - TP) * DM) : X + (size_t)row * DM;
        f32x4 v[8]; float ss = 0.f;
#pragma unroll
        for (int i = 0; i < 8; ++i) { v[i] = *(const f32x4*)(src + i * 256 + lane * 4); ss += v[i][0] * v[i][0] + v[i][1] * v[i][1] + v[i][2] * v[i][2] + v[i][3] * v[i][3]; }
        ss = wave_sum(ss);
        const float rstd = rsqrtf(ss * (1.0f / DM) + EPS);
#pragma unroll
        for (int i = 0; i < 8; ++i) { const int c = i * 256 + lane * 4; const f32x4 wv = *(const f32x4*)(w + c);
            if (MODE == 0) *(f32x4*)(X + (size_t)row * DM + c) = v[i];
            f32x4 o = v[i] * rstd * wv;
            if (MODE == 2) { if (PROBE && row == 0 && i == 0 && lane == 0) o[0] += addA; *(f32x4*)(POUT + O_YP + (size_t)row * DM + c) = o; }
            else { u32x2 pk; pk.x = pk2(o[0], o[1]); pk.y = pk2(o[2], o[3]); *(u32x2*)(H + (size_t)row * DM + c) = pk; } }
    }
    if (ns > 0) {
        float* red = (float*)shm; const float* SL = (const float*)(PWS + WS_PROJ);
        for (int r = blockIdx.x; r < TS; r += gridDim.x) {
            const int row = TP + r, pmi = r >> 8, rr = r & 255, c = wv_ * 256 + lane * 4;
            f32x4 v = *(const f32x4*)(X + (size_t)row * DM + c);
            { f32x4 sl[16];
#pragma unroll
              for (int s = 0; s < 16; ++s) { sl[s] = (f32x4){0.f, 0.f, 0.f, 0.f}; if (s < ns) sl[s] = *(const f32x4*)(SL + ((size_t)(pmi * ns + s) * 256 + rr) * DM + c); }
#pragma unroll
              for (int s = 0; s < 16; s += 4) v += (sl[s] + sl[s + 1]) + (sl[s + 2] + sl[s + 3]); }
            float ss = wave_sum(v[0] * v[0] + v[1] * v[1] + v[2] * v[2] + v[3] * v[3]);
            if (lane == 0) red[wv_] = ss;
            __syncthreads();
            ss = red[0] + red[1] + red[2] + red[3] + red[4] + red[5] + red[6] + red[7];
            const float rstd = rsqrtf(ss * (1.0f / DM) + EPS);
            *(f32x4*)(X + (size_t)row * DM + c) = v;
            const f32x4 o = v * rstd * *(const f32x4*)(w + c);
            if (MODE == 2) *(f32x4*)(POUT + O_YP + (size_t)row * DM + c) = o;
            else { u32x2 pk; pk.x = pk2(o[0], o[1]); pk.y = pk2(o[2], o[3]); *(u32x2*)(H + (size_t)row * DM + c) = pk; }
            __syncthreads();
        }
    }
}

__device__ __forceinline__ bf16x8 ldfrag(const bf16_t* base, int ld, int row0, int k0, int lane) { return *(const bf16x8*)(base + (row0 + (lane & 15)) * ld + k0 + (lane >> 4) * 8); }
__device__ __forceinline__ f32x4 mma16(bf16x8 x, bf16x8 y, f32x4 c) { return __builtin_amdgcn_mfma_f32_16x16x32_bf16(x, y, c, 0, 0, 0); }

__device__ __forceinline__ void phase_e1(const Params& p, int l, unsigned char* shm) {
    KA_INIT; TID_INIT;
    const int lane = tid & 63, w = __builtin_amdgcn_readfirstlane(tid >> 6);
    bf16_t* RAWE = (bf16_t*)(shm + 0);
    bf16_t* HST = (bf16_t*)(shm + 35840);
    bf16_t* OUT = (bf16_t*)(shm + 43008);
    const bf16_t* proj = (const bf16_t*)(PWS + WS_PROJ); bf16_t* bc = (bf16_t*)(PWS + WS_BC);
    typedef const float __attribute__((address_space(4)))* cptr4_t;
    const cptr4_t cw4 = (cptr4_t)(PIN(I_CW) + (size_t)l * 4 * 4096); const cptr4_t cb4 = (cptr4_t)(PIN(I_CB) + (size_t)l * 4096);
    for (int item = blockIdx.x; item < 1088; item += gridDim.x) {
        const int rb = item >> 3, g = item & 7, R0 = rb * 64; const bool sample = R0 >= TP; const bool havehalo = !sample && (rb & 31) != 0;
#define E1_CH(cvl) ((cvl) < 16 ? 2048 + g * 128 + (cvl) * 8 : 3072 + g * 128 + ((cvl) - 16) * 8)
#pragma unroll
        for (int i = 0; i < 5; ++i) { const int v_ = i * 512 + tid; if (v_ < 2144) { const int rowh = v_ >> 5, cvl = v_ & 31; u32x4 val = (u32x4){0u, 0u, 0u, 0u};
            if (rowh >= 3 || havehalo) val = *(const u32x4*)(proj + (size_t)(R0 - 3 + rowh) * NPROJ + 2048 + E1_CH(cvl));
            *(u32x4*)(RAWE + rowh * 264 + cvl * 8) = val; } }
        if (sample && tid < 384) { const int sl = tid / 96, rem = tid - sl * 96, hr = rem >> 5, cvl = rem & 31, sq = ((R0 - TP) >> 4) + sl;
            const float* sp = PIN(I_SCONV) + ((size_t)(l * 32 + sq) * 3 + hr) * 4096 + E1_CH(cvl); const f32x4 a = *(const f32x4*)sp, b = *(const f32x4*)(sp + 4);
            u32x4 hv; hv.x = pk2(a[0], a[1]); hv.y = pk2(a[2], a[3]); hv.z = pk2(b[0], b[1]); hv.w = pk2(b[2], b[3]);
            *(u32x4*)(HST + (sl * 3 + hr) * 264 + cvl * 8) = hv; }
        LBAR;
        {
            const int t = lane, tl = t & 15;
            u32x4 rws[4][4];
#pragma unroll
            for (int it = 0; it < 4; ++it)
#pragma unroll
                for (int k = 0; k < 4; ++k) { const int cvl = 4 * w + it; int off = ((t + k) * 264 + cvl * 8) * 2;
                    if (sample && tl - 3 + k < 0) off = 35840 + (((t >> 4) * 3 + tl + k) * 264 + cvl * 8) * 2;
                    rws[it][k] = *(const u32x4*)(shm + off); }
#pragma unroll
            for (int it = 0; it < 4; ++it) { const int cvl = 4 * w + it, ch = E1_CH(cvl);
                float v[8];
#pragma unroll
                for (int j = 0; j < 8; ++j) v[j] = cb4[ch + j];
#pragma unroll
                for (int k = 0; k < 4; ++k) { float rw[8]; unpack8(rws[it][k], rw);
#pragma unroll
                    for (int j = 0; j < 8; ++j) v[j] += cw4[k * 4096 + ch + j] * rw[j]; }
#pragma unroll
                for (int j = 0; j < 8; ++j) v[j] = silu_f(v[j]);
                *(u32x4*)(OUT + t * 264 + cvl * 8) = pack8(v); }
        }
        LBAR;
#pragma unroll
        for (int i = 0; i < 4; ++i) { const int v_ = i * 512 + tid, rowo = v_ >> 5, cvl = v_ & 31;
            *(u32x4*)(bc + (size_t)(R0 + rowo) * 2048 + (cvl < 16 ? g * 128 + cvl * 8 : 1024 + g * 128 + (cvl - 16) * 8)) = *(const u32x4*)(OUT + rowo * 264 + cvl * 8); }
        if (!sample) { if ((rb & 31) == 31 && tid < 96) { const int hr = tid >> 5, cvl = tid & 31; float f[8]; unpack8(*(const u32x4*)(RAWE + (64 + hr) * 264 + cvl * 8), f);
            float* op = POUT + O_PCONV + ((size_t)(l * 4 + (rb >> 5)) * 3 + hr) * 4096 + E1_CH(cvl);
            *(f32x4*)op = (f32x4){f[0], f[1], f[2], f[3]}; *(f32x4*)(op + 4) = (f32x4){f[4], f[5], f[6], f[7]}; } }
        else if (tid < 384) { const int sl = tid / 96, rem = tid - sl * 96, hr = rem >> 5, cvl = rem & 31, sq = ((R0 - TP) >> 4) + sl; float f[8]; unpack8(*(const u32x4*)(RAWE + (3 + 16 * sl + 13 + hr) * 264 + cvl * 8), f);
            float* op = POUT + O_SCONV + ((size_t)(l * 32 + sq) * 3 + hr) * 4096 + E1_CH(cvl);
            *(f32x4*)op = (f32x4){f[0], f[1], f[2], f[3]}; *(f32x4*)(op + 4) = (f32x4){f[4], f[5], f[6], f[7]}; }
        LBAR;
#undef E1_CH
    }
}

__device__ __forceinline__ float wave_scan_incl(float s) {
#define DPP_ADD_(ctrl, rmask) { const int t_ = __builtin_amdgcn_update_dpp(0, __float_as_int(s), ctrl, rmask, 0xf, true); s += __int_as_float(t_); }
    DPP_ADD_(0x111, 0xf) DPP_ADD_(0x112, 0xf) DPP_ADD_(0x114, 0xf) DPP_ADD_(0x118, 0xf) DPP_ADD_(0x142, 0xa) DPP_ADD_(0x143, 0xc)
#undef DPP_ADD_
    return s;
}
__device__ __forceinline__ void ssd_chain(const Params& p, int l, bool sample, int seq, int hd, unsigned char* shm) {
    KA_INIT; TID_INIT;
    const int lane = tid & 63, w = __builtin_amdgcn_readfirstlane(tid >> 6), r = lane & 15, q = lane >> 4;
    bf16_t* Cs = (bf16_t*)(shm + 0);
    bf16_t* Bs = (bf16_t*)(shm + 17408);
    bf16_t* BT = (bf16_t*)(shm + 34816);
    bf16_t* XT = (bf16_t*)(shm + 53248);
    bf16_t* Ms = (bf16_t*)(shm + 62464);
    bf16_t* Hs = (bf16_t*)(shm + 71680);
    float* dts = (float*)(shm + 89088);
    float* acss = dts + 64; float* scs = acss + 64; float* part = scs + 64;
    bf16_t* RAW = (bf16_t*)(shm + 90624);
    bf16_t* HALO = (bf16_t*)(shm + 132608);
    float* CWs = (float*)(shm + 136704);
    const bf16_t* proj = (const bf16_t*)(PWS + WS_PROJ); const float* DT = (const float*)(PWS + WS_DT);
    bf16_t* mix = (bf16_t*)(PWS + WS_MIX); float* ssq = (float*)(PWS + WS_SSQ);
    const int g = hd >> 2, nchunk = sample ? 1 : 32, nvalid = sample ? 16 : 64;
    const int rowbase = sample ? TP + seq * 16 : seq * 2048;
    const float Dh = PIN(I_D)[l * 32 + hd];
    const float a_neg = -__expf(PIN(I_ALOG)[l * 32 + hd]);
    const int ib = w >> 1, pb0 = 2 * (w & 1), pbS = w >> 1, nb0 = 4 * (w & 1);
#define SSD_CH(cv) ((cv) < 8 ? hd * 64 + (cv) * 8 : ((cv) < 24 ? 2048 + g * 128 + ((cv) - 8) * 8 : 3072 + g * 128 + ((cv) - 24) * 8))
    typedef const float __attribute__((address_space(4)))* cptr4_t;
    const cptr4_t cw4 = (cptr4_t)(PIN(I_CW) + (size_t)l * 4 * 4096); const cptr4_t cb4 = (cptr4_t)(PIN(I_CB) + (size_t)l * 4096);
    if (tid >= 384 && tid < 384 + 120) { const int e = tid - 384, hr = e / 40, cvv = e % 40; u32x4 hv = (u32x4){0u, 0u, 0u, 0u};
        if (sample) { const float* sp = PIN(I_SCONV) + ((size_t)(l * 32 + seq) * 3 + hr) * 4096 + SSD_CH(cvv); const f32x4 a = *(const f32x4*)sp, b = *(const f32x4*)(sp + 4);
            hv.x = pk2(a[0], a[1]); hv.y = pk2(a[2], a[3]); hv.z = pk2(b[0], b[1]); hv.w = pk2(b[2], b[3]); }
        *(u32x4*)(HALO + (3 + hr) * 328 + cvv * 8) = hv; }
    f32x4 hacc[4];
    {
        const size_t hoff = ((size_t)((l * 32 + seq) * 32 + hd) * 64 + 16 * pbS + r) * 128;
#pragma unroll
        for (int tt = 0; tt < 4; ++tt) {
            f32x4 h = (f32x4){0.f, 0.f, 0.f, 0.f};
            if (sample) h = *(const f32x4*)(PIN(I_SSSD) + hoff + 16 * (nb0 + tt) + 4 * q);
            hacc[tt] = h;
            u32x2 pk; pk.x = pk2(h[0], h[1]); pk.y = pk2(h[2], h[3]);
            *(u32x2*)(Hs + (16 * pbS + r) * 136 + 16 * (nb0 + tt) + 4 * q) = pk;
        }
    }
    u32x4 rawreg[5]; float dtreg = 0.f;
    const bf16_t* wsb = (const bf16_t*)PWS;
    int goff[5], gstr[5], loffb[5];
#pragma unroll
    for (int it = 0; it < 5; ++it) { const int v_ = it * 512 + tid, prow = v_ / 40, pcv = v_ - prow * 40;
        if (pcv < 8) { goff[it] = (int)(WS_PROJ / 2) + prow * NPROJ + 2048 + hd * 64 + pcv * 8; gstr[it] = NPROJ; loffb[it] = 90624 + prow * 656 + pcv * 16; }
        else if (pcv < 24) { goff[it] = (int)(WS_BC / 2) + prow * 2048 + g * 128 + (pcv - 8) * 8; gstr[it] = 2048; loffb[it] = 17408 + prow * 272 + (pcv - 8) * 16; }
        else { goff[it] = (int)(WS_BC / 2) + prow * 2048 + 1024 + g * 128 + (pcv - 24) * 8; gstr[it] = 2048; loffb[it] = prow * 272 + (pcv - 24) * 16; } }
    const bool xhalo = tid >= 392 && ((2048 + tid) % 40) < 8;
#pragma unroll
    for (int it = 0; it < 5; ++it) { rawreg[it] = (u32x4){0u, 0u, 0u, 0u};
        if (it * 512 + tid < nvalid * 40) rawreg[it] = *(const u32x4*)(wsb + (size_t)(goff[it] + rowbase * gstr[it])); }
    if (w == 7 && lane < nvalid) dtreg = DT[(size_t)(rowbase + lane) * 32 + hd];
    for (int c = 0; c < nchunk; ++c) {
        const int R0 = rowbase + c * 64;
#pragma unroll
        for (int it = 0; it < 5; ++it) *(u32x4*)(shm + loffb[it]) = rawreg[it];
        if (xhalo) *(u32x4*)(shm + 132608 + ((c & 1) * 3 - 61) * 656 + (loffb[4] - 90624)) = rawreg[4];
        if (w == 7) {
            const float dtv = dtreg; const float s = wave_scan_incl(dtv * a_neg);
            const float lastv = __int_as_float(__builtin_amdgcn_readlane(__float_as_int(s), 63));
            dts[lane] = dtv; acss[lane] = s; scs[lane] = dtv * __expf(lastv - s);
        }
        u32x2 gz[2];
        {
            const int i = 16 * ib + r;
#pragma unroll
            for (int tt = 0; tt < 2; ++tt) { gz[tt] = (u32x2){0u, 0u}; if (i < nvalid) gz[tt] = *(const u32x2*)(proj + (size_t)(R0 + i) * NPROJ + hd * 64 + 16 * (pb0 + tt) + 4 * q); }
        }
        if (c + 1 < nchunk) {
#pragma unroll
            for (int it = 0; it < 5; ++it) rawreg[it] = *(const u32x4*)(wsb + (size_t)(goff[it] + (R0 + 64) * gstr[it]));
            if (w == 7) dtreg = DT[(size_t)(R0 + 64 + lane) * 32 + hd];
        }
        LBAR;
        {
            const int t = lane; const int haloff = 132608 + (((c + 1) & 1) * 3 + 3) * 656;
            u32x4 rws[4], bpk[2];
#pragma unroll
            for (int k = 0; k < 4; ++k) { const int tt = t - 3 + k; const int off = (tt >= 0 ? 90624 : haloff) + tt * 656 + w * 16; rws[k] = *(const u32x4*)(shm + off); }
#pragma unroll
            for (int u = 0; u < 2; ++u) bpk[u] = *(const u32x4*)(Bs + t * 136 + (2 * w + u) * 8);
            const int ch = hd * 64 + w * 8;
            float v[8];
#pragma unroll
            for (int j = 0; j < 8; ++j) v[j] = cb4[ch + j];
#pragma unroll
            for (int k = 0; k < 4; ++k) { float rw[8]; unpack8(rws[k], rw);
#pragma unroll
                for (int j = 0; j < 8; ++j) v[j] += cw4[k * 4096 + ch + j] * rw[j]; }
#pragma unroll
            for (int j = 0; j < 8; ++j) { const float sv = silu_f(v[j]); v[j] = t < nvalid ? sv : 0.f; }
            { const u32x4 pk = pack8(v);
#pragma unroll
              for (int j = 0; j < 8; ++j) XT[(w * 8 + j) * 72 + t] = (bf16_t)((j & 1) ? (pk[j >> 1] >> 16) : (pk[j >> 1] & 0xffffu)); }
#pragma unroll
            for (int u = 0; u < 2; ++u)
#pragma unroll
                for (int j = 0; j < 8; ++j) BT[((2 * w + u) * 8 + j) * 72 + t] = (bf16_t)((j & 1) ? (bpk[u][j >> 1] >> 16) : (bpk[u][j >> 1] & 0xffffu));
        }
        LBAR;
        f32x4 yo[2] = {(f32x4){0.f, 0.f, 0.f, 0.f}, (f32x4){0.f, 0.f, 0.f, 0.f}};
        {
            const int i = 16 * ib + r;
            bf16x8 fC[4], fH[2][4], fB[2][4], fXT[2], fBT[4][2]; f32x4 aj[2], dj[2], sc[2][2];
#pragma unroll
            for (int ks = 0; ks < 4; ++ks) { fC[ks] = ldfrag(Cs, 136, 16 * ib, 32 * ks, lane);
#pragma unroll
                for (int tt = 0; tt < 2; ++tt) { fH[tt][ks] = ldfrag(Hs, 136, 16 * (pb0 + tt), 32 * ks, lane); fB[tt][ks] = ldfrag(Bs, 136, 16 * (pb0 + tt), 32 * ks, lane); } }
#pragma unroll
            for (int ks = 0; ks < 2; ++ks) { fXT[ks] = ldfrag(XT, 72, 16 * pbS, 32 * ks, lane); sc[ks][0] = *(const f32x4*)(scs + 32 * ks + 8 * q); sc[ks][1] = *(const f32x4*)(scs + 32 * ks + 8 * q + 4);
#pragma unroll
                for (int tt = 0; tt < 4; ++tt) fBT[tt][ks] = ldfrag(BT, 72, 16 * (nb0 + tt), 32 * ks, lane); }
#pragma unroll
            for (int tt = 0; tt < 2; ++tt) { aj[tt] = *(const f32x4*)(acss + 16 * (pb0 + tt) + 4 * q); dj[tt] = *(const f32x4*)(dts + 16 * (pb0 + tt) + 4 * q); }
            const float ai = acss[i]; const float cd = __expf(acss[63]);
            asm volatile("" ::: "memory");
            f32x4 gg[2] = {(f32x4){0.f, 0.f, 0.f, 0.f}, (f32x4){0.f, 0.f, 0.f, 0.f}};
#pragma unroll
            for (int ks = 0; ks < 4; ++ks)
#pragma unroll
                for (int tt = 0; tt < 2; ++tt) { yo[tt] = mma16(fH[tt][ks], fC[ks], yo[tt]); gg[tt] = mma16(fB[tt][ks], fC[ks], gg[tt]); }
#pragma unroll
            for (int tt = 0; tt < 4; ++tt) hacc[tt] *= cd;
#pragma unroll
            for (int ks = 0; ks < 2; ++ks) {
                const bf16x8 xr = fXT[ks];
                float xf[8]; u32x4 xu; xu.x = (unsigned)(unsigned short)xr[0] | ((unsigned)(unsigned short)xr[1] << 16); xu.y = (unsigned)(unsigned short)xr[2] | ((unsigned)(unsigned short)xr[3] << 16);
                xu.z = (unsigned)(unsigned short)xr[4] | ((unsigned)(unsigned short)xr[5] << 16); xu.w = (unsigned)(unsigned short)xr[6] | ((unsigned)(unsigned short)xr[7] << 16);
                unpack8(xu, xf);
#pragma unroll
                for (int e = 0; e < 4; ++e) { xf[e] *= sc[ks][0][e]; xf[4 + e] *= sc[ks][1][e]; }
                const u32x4 xs = pack8(xf); bf16x8 yf;
#pragma unroll
                for (int e = 0; e < 4; ++e) { yf[2 * e] = (short)(xs[e] & 0xffffu); yf[2 * e + 1] = (short)(xs[e] >> 16); }
#pragma unroll
                for (int tt = 0; tt < 4; ++tt) hacc[tt] = mma16(fBT[tt][ks], yf, hacc[tt]);
            }
#pragma unroll
            for (int tt = 0; tt < 2; ++tt) { const int jb = pb0 + tt; float mv[4];
#pragma unroll
                for (int jj = 0; jj < 4; ++jj) { const int j = 16 * jb + 4 * q + jj; mv[jj] = (j <= i) ? gg[tt][jj] * __expf(fminf(ai - aj[tt][jj], 0.f)) * dj[tt][jj] : 0.f; }
                u32x2 pk; pk.x = pk2(mv[0], mv[1]); pk.y = pk2(mv[2], mv[3]);
                *(u32x2*)(Ms + i * 72 + 16 * jb + 4 * q) = pk; }
        }
        LBAR;
        {
            f32x4 yd[2] = {(f32x4){0.f, 0.f, 0.f, 0.f}, (f32x4){0.f, 0.f, 0.f, 0.f}};
            const int i = 16 * ib + r;
            bf16x8 fM[2], fX2[2][2]; bf16_t xe[2][4];
#pragma unroll
            for (int ks = 0; ks < 2; ++ks) { fM[ks] = ldfrag(Ms, 72, 16 * ib, 32 * ks, lane);
#pragma unroll
                for (int tt = 0; tt < 2; ++tt) fX2[tt][ks] = ldfrag(XT, 72, 16 * (pb0 + tt), 32 * ks, lane); }
#pragma unroll
            for (int tt = 0; tt < 2; ++tt)
#pragma unroll
                for (int jj = 0; jj < 4; ++jj) xe[tt][jj] = XT[(16 * (pb0 + tt) + 4 * q + jj) * 72 + i];
            const float ea = __expf(acss[i]);
            asm volatile("" ::: "memory");
#pragma unroll
            for (int ks = 0; ks < 2; ++ks)
#pragma unroll
                for (int tt = 0; tt < 2; ++tt) yd[tt] = mma16(fX2[tt][ks], fM[ks], yd[tt]);
            const bool valid = i < nvalid; const size_t row = (size_t)(R0 + i);
            float ss = 0.f;
#pragma unroll
            for (int tt = 0; tt < 2; ++tt) { const int pc = 16 * (pb0 + tt) + 4 * q;
                const float gate[4] = {__uint_as_float(gz[tt].x << 16), __uint_as_float(gz[tt].x & 0xffff0000u), __uint_as_float(gz[tt].y << 16), __uint_as_float(gz[tt].y & 0xffff0000u)};
                float y[4];
#pragma unroll
                for (int jj = 0; jj < 4; ++jj) { const float xv = bf2f(xe[tt][jj]); y[jj] = (yd[tt][jj] + ea * yo[tt][jj] + Dh * xv) * gate[jj]; ss += y[jj] * y[jj]; }
                if (valid) { u32x2 pk; pk.x = pk2(y[0], y[1]); pk.y = pk2(y[2], y[3]); *(u32x2*)(mix + row * DMIX + hd * 64 + pc) = pk; } }
            ss += __shfl_xor(ss, 16); ss += __shfl_xor(ss, 32);
            if (q == 0) part[i * 2 + (w & 1)] = ss;
#pragma unroll
            for (int tt = 0; tt < 4; ++tt) { u32x2 pk; pk.x = pk2(hacc[tt][0], hacc[tt][1]); pk.y = pk2(hacc[tt][2], hacc[tt][3]); *(u32x2*)(Hs + (16 * pbS + r) * 136 + 16 * (nb0 + tt) + 4 * q) = pk; }
        }
        LBAR;
        if (tid < nvalid) ssq[(size_t)(R0 + tid) * 32 + hd] = part[2 * tid] + part[2 * tid + 1];
    }
    if (tid < 24) { const int hr = tid >> 3, cvv = tid & 7; float f[8]; unpack8(*(const u32x4*)(RAW + (nvalid - 3 + hr) * 328 + cvv * 8), f);
        float* op = POUT + (sample ? O_SCONV + ((size_t)(l * 32 + seq) * 3 + hr) * 4096 : O_PCONV + ((size_t)(l * 4 + seq) * 3 + hr) * 4096) + hd * 64 + cvv * 8;
        *(f32x4*)op = (f32x4){f[0], f[1], f[2], f[3]}; *(f32x4*)(op + 4) = (f32x4){f[4], f[5], f[6], f[7]}; }
    {
        float* op = POUT + (sample ? O_SSSD + ((size_t)((l * 32 + seq) * 32 + hd) * 64) * 128 : O_PSSD + ((size_t)((l * 4 + seq) * 32 + hd) * 64) * 128);
#pragma unroll
        for (int tt = 0; tt < 4; ++tt) *(f32x4*)(op + (size_t)(16 * pbS + r) * 128 + 16 * (nb0 + tt) + 4 * q) = hacc[tt];
    }
    LBAR;
#undef SSD_CH
}

__device__ __forceinline__ void gmlp_item(const Params& p, int l, bool sample, int idx, unsigned char* shm) {
    KA_INIT; TID_INIT;
    const int lane = tid & 63, w = tid >> 6, r = lane & 15, q = lane >> 4;
    bf16_t* Ws = (bf16_t*)shm;
    bf16_t* VT = (bf16_t*)(shm + 34816);
    float* rs = (float*)(shm + 104448);
    float* pp = rs + 128;
    const bf16_t* proj = (const bf16_t*)(PWS + WS_PROJ); bf16_t* mix = (bf16_t*)(PWS + WS_MIX);
    const int g = idx & 7, blk = idx >> 3, R0 = sample ? TP + blk * 128 : blk * 128;
    const float* wv = PIN(I_GNW) + (size_t)l * 2048 + g * 256;
#pragma unroll
    for (int hh = 0; hh < 2; ++hh) { const int j = hh * 64 + lane; float ss = 0.f;
#pragma unroll
        for (int cc = 0; cc < 4; ++cc) { const int cv = 4 * w + cc; const u32x4 raw = *(const u32x4*)(proj + (size_t)(R0 + j) * NPROJ + 8192 + g * 256 + 8 * cv);
            float f[8]; unpack8(raw, f);
#pragma unroll
            for (int e = 0; e < 8; ++e) { ss += f[e] * f[e]; VT[(8 * cv + e) * 136 + j] = (bf16_t)((e & 1) ? (raw[e >> 1] >> 16) : (raw[e >> 1] & 0xffffu)); } }
        pp[j * 8 + w] = ss; }
    LBAR;
    if (tid < 128) { float s = 0.f;
#pragma unroll
        for (int k = 0; k < 8; ++k) s += pp[tid * 8 + k];
        rs[tid] = rsqrtf(s * (1.0f / 256.f) + EPS); }
    LBAR;
    {
        const int i = tid >> 2, jq = (tid & 3) * 32;
        const float* wsrc = PIN(I_GWS) + (size_t)(l * 8 + g) * 128 * 128;
#pragma unroll
        for (int jv = 0; jv < 8; ++jv) { const int j = jq + 4 * jv; f32x4 w4 = (f32x4){0.f, 0.f, 0.f, 0.f};
            if (!sample) { if ((j >> 6) <= (i >> 6)) w4 = *(const f32x4*)(wsrc + i * 128 + j); }
            else { if ((j >> 4) == (i >> 4)) w4 = *(const f32x4*)(wsrc + (i & 15) * 128 + (j & 15)); }
            u32x2 pk; pk.x = pk2(w4[0] * rs[j], w4[1] * rs[j + 1]); pk.y = pk2(w4[2] * rs[j + 2], w4[3] * rs[j + 3]);
            *(u32x2*)(Ws + i * 136 + j) = pk; }
        if (sample) {
#pragma unroll 1
            for (int k = 0; k < 8; ++k) { const int cvv = tid & 31, j = (tid >> 5) + 16 * k; const u32x4 raw = *(const u32x4*)(proj + (size_t)(R0 + j) * NPROJ + 8192 + g * 256 + 8 * cvv);
                float f[8]; unpack8(raw, f); const float rj = rs[j]; const int s = blk * 8 + (j >> 4), t = j & 15;
                float* op = POUT + O_SV + ((size_t)((l * 32 + s) * 16 + t)) * 2048 + g * 256 + 8 * cvv;
                const f32x4 w0 = *(const f32x4*)(wv + 8 * cvv), w1 = *(const f32x4*)(wv + 8 * cvv + 4);
                *(f32x4*)op = (f32x4){f[0] * rj * w0[0], f[1] * rj * w0[1], f[2] * rj * w0[2], f[3] * rj * w0[3]};
                *(f32x4*)(op + 4) = (f32x4){f[4] * rj * w1[0], f[5] * rj * w1[1], f[6] * rj * w1[2], f[7] * rj * w1[3]}; }
        }
    }
    LBAR;
    {
        const int ib = w, i = 16 * ib + r; const size_t row = (size_t)(R0 + i);
        const int nks = (!sample && ib < 4) ? 2 : 4;
        bf16x8 yf[4];
#pragma unroll
        for (int ks = 0; ks < 4; ++ks) yf[ks] = ldfrag(Ws, 136, 16 * ib, 32 * ks, lane);
        const float bias = PIN(I_GBS)[(size_t)(l * 8 + g) * 128 + (sample ? (i & 15) : i)];
#pragma unroll 2
        for (int db = 0; db < 16; ++db) { f32x4 acc = (f32x4){0.f, 0.f, 0.f, 0.f};
#pragma unroll
            for (int ks = 0; ks < 4; ++ks) if (ks < nks) acc = mma16(ldfrag(VT, 136, 16 * db, 32 * ks, lane), yf[ks], acc);
            const int d = 16 * db + 4 * q; const f32x4 w4 = *(const f32x4*)(wv + d);
            const u32x2 uz = *(const u32x2*)(proj + row * NPROJ + 6144 + g * 256 + d);
            const float uu[4] = {__uint_as_float(uz.x << 16), __uint_as_float(uz.x & 0xffff0000u), __uint_as_float(uz.y << 16), __uint_as_float(uz.y & 0xffff0000u)};
            float y[4];
#pragma unroll
            for (int jj = 0; jj < 4; ++jj) y[jj] = (acc[jj] * w4[jj] + bias) * uu[jj];
            u32x2 pk; pk.x = pk2(y[0], y[1]); pk.y = pk2(y[2], y[3]);
            *(u32x2*)(mix + row * DMIX + 2048 + g * 256 + d) = pk; }
    }
    LBAR;
}

__device__ __forceinline__ void phase_sn(const Params& p, int l) {
    KA_INIT; TID_INIT;
    bf16_t* mix = (bf16_t*)(PWS + WS_MIX); const float* ssq = (const float*)(PWS + WS_SSQ); const float* nw = PIN(I_SNW) + (size_t)l * 2048;
    const int nth = gridDim.x * 512;
    for (int idx0 = blockIdx.x * 512 + tid; idx0 < T * 256; idx0 += 4 * nth) {
        u32x4 raw[4]; f32x4 s4[4], w0[4], w1[4];
#pragma unroll
        for (int u = 0; u < 4; ++u) { const int idx = idx0 + u * nth; if (idx < T * 256) { const int row = idx >> 8, col = (idx & 255) * 8, g = col >> 8;
            s4[u] = *(const f32x4*)(ssq + (size_t)row * 32 + 4 * g); raw[u] = *(const u32x4*)(mix + (size_t)row * DMIX + col); w0[u] = *(const f32x4*)(nw + col); w1[u] = *(const f32x4*)(nw + col + 4); } }
#pragma unroll
        for (int u = 0; u < 4; ++u) { const int idx = idx0 + u * nth; if (idx < T * 256) { const int row = idx >> 8, col = (idx & 255) * 8;
            const float rstd = rsqrtf((s4[u][0] + s4[u][1] + s4[u][2] + s4[u][3]) * (1.0f / 256.f) + EPS);
            float f[8]; unpack8(raw[u], f);
#pragma unroll
            for (int j = 0; j < 4; ++j) { f[j] *= rstd * w0[u][j]; f[4 + j] *= rstd * w1[u][j]; }
            *(u32x4*)(mix + (size_t)row * DMIX + col) = pack8(f); } }
    }
}

__device__ __forceinline__ void phase_e2(const Params& p, int l) {
    KA_INIT; TID_INIT;
    const bf16_t* up = (const bf16_t*)(PWS + WS_PROJ); bf16_t* act = (bf16_t*)(PWS + WS_MIX);
    const float* fw = PIN(I_FCW) + (size_t)l * 3 * DUP; const float* fb = PIN(I_FCB) + (size_t)l * DUP;
    const int nth = gridDim.x * 512;
    for (int idx = blockIdx.x * 512 + tid; idx < 1088 * 704; idx += nth) {
        const int f8 = idx % 704, rb = idx / 704, r0 = rb * 8, ch = f8 * 8;
        const bool sample = r0 >= TP; const int s = (r0 - TP) >> 4;
        const bool seqstart = sample ? ((r0 & 15) == 0) : ((r0 & 2047) == 0);
        const bool seqend = sample ? ((r0 & 15) == 8) : ((r0 & 2047) == 2040);
        u32x4 rg[10], rl[10];
#pragma unroll
        for (int k = 0; k < 10; ++k) { rg[k] = (u32x4){0u, 0u, 0u, 0u}; rl[k] = (u32x4){0u, 0u, 0u, 0u};
            if (k >= 2 || !seqstart) { rg[k] = *(const u32x4*)(up + (size_t)(r0 - 2 + k) * DUP + ch); rl[k] = *(const u32x4*)(up + (size_t)(r0 - 2 + k) * DUP + DFF + ch); } }
        float wg[3][8], wl[3][8], bg[8], bl[8];
#pragma unroll
        for (int k = 0; k < 3; ++k) { const f32x4 a0 = *(const f32x4*)(fw + k * DUP + ch), a1 = *(const f32x4*)(fw + k * DUP + ch + 4), c0 = *(const f32x4*)(fw + k * DUP + DFF + ch), c1 = *(const f32x4*)(fw + k * DUP + DFF + ch + 4);
#pragma unroll
            for (int j = 0; j < 4; ++j) { wg[k][j] = a0[j]; wg[k][4 + j] = a1[j]; wl[k][j] = c0[j]; wl[k][4 + j] = c1[j]; } }
        { const f32x4 a0 = *(const f32x4*)(fb + ch), a1 = *(const f32x4*)(fb + ch + 4), c0 = *(const f32x4*)(fb + DFF + ch), c1 = *(const f32x4*)(fb + DFF + ch + 4);
#pragma unroll
            for (int j = 0; j < 4; ++j) { bg[j] = a0[j]; bg[4 + j] = a1[j]; bl[j] = c0[j]; bl[4 + j] = c1[j]; } }
        float pg[2][8], pl[2][8];
#pragma unroll
        for (int k = 0; k < 2; ++k) { unpack8(rg[k], pg[k]); unpack8(rl[k], pl[k]);
            if (seqstart && sample) { const float* sp = PIN(I_SFFN) + ((size_t)(l * 32 + s) * 2 + k) * DUP + ch;
#pragma unroll
                for (int j = 0; j < 8; ++j) { pg[k][j] = sp[j]; pl[k][j] = sp[DFF + j]; } } }
#pragma unroll
        for (int rr = 0; rr < 8; ++rr) {
            float cg_[8], cl[8], o[8];
            unpack8(rg[rr + 2], cg_); unpack8(rl[rr + 2], cl);
#pragma unroll
            for (int j = 0; j < 8; ++j) {
                const float a = bg[j] + wg[0][j] * pg[0][j] + wg[1][j] * pg[1][j] + wg[2][j] * cg_[j];
                const float b = bl[j] + wl[0][j] * pl[0][j] + wl[1][j] * pl[1][j] + wl[2][j] * cl[j];
                o[j] = silu_f(a) * b;
                pg[0][j] = pg[1][j]; pg[1][j] = cg_[j]; pl[0][j] = pl[1][j]; pl[1][j] = cl[j];
            }
            *(u32x4*)(act + (size_t)(r0 + rr) * DFF + ch) = pack8(o);
            if (seqend && rr >= 6) {
                float* op = POUT + (sample ? O_SFFN + ((size_t)(l * 32 + s) * 2 + (rr - 6)) * DUP : O_PFFN + ((size_t)(l * 4 + (r0 >> 11)) * 2 + (rr - 6)) * DUP) + ch;
                *(f32x4*)op = (f32x4){cg_[0], cg_[1], cg_[2], cg_[3]}; *(f32x4*)(op + 4) = (f32x4){cg_[4], cg_[5], cg_[6], cg_[7]};
                *(f32x4*)(op + DFF) = (f32x4){cl[0], cl[1], cl[2], cl[3]}; *(f32x4*)(op + DFF + 4) = (f32x4){cl[4], cl[5], cl[6], cl[7]};
            }
        }
    }
}

__device__ __forceinline__ void run_g1(LAS unsigned char* lds, const bf16_t* A, const bf16_t* Bt, bf16_t* P, float* DT, const float* dtb) {
    pg8::StaticOrder S; S.init(T, NINP, gridDim.x, blockIdx.x); S.nkt = DM / 64; pg8::Gemm g{A, Bt, T, NINP, DM}; EpiG1 E{P, DT, dtb}; pg8::gemm_phase(lds, g, S, E); }
__device__ __forceinline__ void run_gx(LAS unsigned char* lds, const bf16_t* A, const bf16_t* Bt, float* X, float* SL, int K, int ns) {
    pg8::HybridOrder S; S.init(K, ns, gridDim.x, blockIdx.x); pg8::Gemm g{A, Bt, T, DM, K}; EpiX E{X, SL}; pg8::gemm_phase(lds, g, S, E); }
__device__ __forceinline__ void run_g3(LAS unsigned char* lds, const bf16_t* A, const bf16_t* Bt, bf16_t* U) {
    pg8::StaticOrder S; S.init(T, DUP, gridDim.x, blockIdx.x); S.nkt = DM / 64; pg8::Gemm g{A, Bt, T, DUP, DM}; EpiUp E{U}; pg8::gemm_phase(lds, g, S, E); }
#ifndef EN_PREP
#define EN_PREP 1
#endif
#ifndef EN_GEMM
#define EN_GEMM 15
#endif
#ifndef EN_SSD
#define EN_SSD 1
#endif
#ifndef EN_GMLP
#define EN_GMLP 1
#endif
#ifndef EN_SN
#define EN_SN 1
#endif
#ifndef EN_E2
#define EN_E2 1
#endif
#if PROBE
#define MARK(cls) do { if (blockIdx.x == 0 && threadIdx.x == 0) { const unsigned long long t_ = __builtin_amdgcn_s_memrealtime(); const unsigned d_ = (unsigned)(t_ - t_prev); t_prev = t_; \
    if (PROBE_A & (1 << (cls))) accA += d_; if (PROBE_B & (1 << (cls))) accB += d_; } } while (0)
#else
#define MARK(cls) do { } while (0)
#endif
#define WSP(T_, off) ((T_*)(PWS + (off)))
constexpr size_t WS_BAR = WS_END;
constexpr size_t WS_BAR_BYTES = 16384;
constexpr size_t WS_TOTAL = WS_END + WS_BAR_BYTES;
#define XB_TMO      128
#define XB_XCNT(j)  (256  + 64 * (j))
#define XB_XSUB(j)  (1280 + 64 * (j))
#define XB_XGEN(j)  (2304 + 64 * (j))
#define XB_TOP      3328
#define XB_TOPGEN   3392
#define XB_SPIN_CAP (1u << 18)
__device__ __forceinline__ unsigned xb_ld(unsigned* p)              { return __hip_atomic_load(p, __ATOMIC_RELAXED, __HIP_MEMORY_SCOPE_AGENT); }
__device__ __forceinline__ unsigned xb_add(unsigned* p, unsigned v) { return __hip_atomic_fetch_add(p, v, __ATOMIC_RELAXED, __HIP_MEMORY_SCOPE_AGENT); }
__device__ __forceinline__ unsigned xb_xcc_id() { return (unsigned)__builtin_amdgcn_s_getreg((3 << 11) | 20) & 0xFu; }
#define XB_SPIN(cond, bar) do { unsigned _sp = 0; while (cond) { __builtin_amdgcn_s_sleep(1); \
    if ((++_sp & 255u) == 0u) { if (xb_ld(&(bar)[XB_TMO])) break; if (_sp > XB_SPIN_CAP) { atomicAdd(&(bar)[XB_TMO], 1u); break; } } } } while (0)
__device__ __forceinline__ void xcd_barrier_complete(unsigned* bar, unsigned x, unsigned& nloc, unsigned& nx) {
    const unsigned G = gridDim.x;
    unsigned sum, cnt, mine, sp = 0u;
    for (;;) {
        sum = 0u; cnt = 0u; mine = 0u;
#pragma unroll
        for (unsigned j = 0; j < 16; ++j) { const unsigned c = xb_ld(&bar[XB_XCNT(j)]); sum += c; cnt += (c > 0u) ? 1u : 0u; mine = (j == x) ? c : mine; }
        if (sum == G) break;
        __builtin_amdgcn_s_sleep(1);
        if ((++sp & 255u) == 0u) { if (xb_ld(&bar[XB_TMO])) break; if (sp > XB_SPIN_CAP) { atomicAdd(&bar[XB_TMO], 1u); break; } }
    }
    nloc = mine > 0u ? mine : 1u; nx = cnt > 0u ? cnt : 1u;
}
__device__ __forceinline__ void xcd_barrier(unsigned* bar, volatile LAS unsigned* st) {
    asm volatile("s_waitcnt vmcnt(0)" ::: "memory");
    __syncthreads();
    if (threadIdx.x == 0) {
        const unsigned x = xb_xcc_id();
        __builtin_amdgcn_s_waitcnt(0);
        unsigned nloc = st[0], nx = st[1];
        if (nloc == 0u) { xcd_barrier_complete(bar, x, nloc, nx); st[0] = nloc; st[1] = nx; }
        const unsigned old = xb_add(&bar[XB_XSUB(x)], 1u);
        const unsigned gen = old / nloc;
        if (old + 1u == (gen + 1u) * nloc) {
            __builtin_amdgcn_fence(__ATOMIC_RELEASE, "agent");
            asm volatile("s_waitcnt vmcnt(0)" ::: "memory");
            const unsigned og = xb_add(&bar[XB_TOP], 1u);
            const unsigned tg = og / nx;
            if (og + 1u == (tg + 1u) * nx) xb_add(&bar[XB_TOPGEN], 1u);
            else XB_SPIN(xb_ld(&bar[XB_TOPGEN]) == tg, bar);
            __builtin_amdgcn_fence(__ATOMIC_ACQUIRE, "agent");
            xb_add(&bar[XB_XGEN(x)], 1u);
            asm volatile("s_waitcnt vmcnt(0)" ::: "memory");
        } else {
            XB_SPIN(xb_ld(&bar[XB_XGEN(x)]) == gen, bar);
            __builtin_amdgcn_fence(__ATOMIC_ACQUIRE, "agent");
            asm volatile("s_waitcnt vmcnt(0)" ::: "memory");
        }
    }
    __syncthreads();
}
#define GSYNC do { KA_INIT; xcd_barrier((unsigned*)(PWS + WS_BAR), (volatile LAS unsigned*)((LAS unsigned char*)shm + 147456)); } while (0)
__global__ void __launch_bounds__(512, 2) fwd_kernel(Params p) {
    extern __shared__ __attribute__((aligned(16))) unsigned char shm[];
    { KA_INIT;
      volatile LAS unsigned* st = (volatile LAS unsigned*)((LAS unsigned char*)shm + 147456);
      if (threadIdx.x == 0) { st[0] = 0u; st[1] = 0u; (void)xb_add(&((unsigned*)(PWS + WS_BAR))[XB_XCNT(xb_xcc_id())], 1u); }
      __syncthreads(); }
#if PROBE
    unsigned long long t_prev = __builtin_amdgcn_s_memrealtime(); unsigned accA = 0, accB = 0;
#endif
    { KA_INIT; if (PWS == nullptr) cg::this_grid().sync(); }
    for (int l = 0; l < 2; ++l) {
#if EN_PREP
        { KA_INIT;
        convert_w(PIN(I_WIN) + (size_t)l * DM * DIN, DM, DIN, WSP(bf16_t, WS_WIN), NINP, 1, shm);
        if (l == 0) phase_norm<0>(p, PIN(I_N1W), 0, shm); else phase_norm<1>(p, PIN(I_N1W) + DM, 11, shm); }
#endif
        GSYNC;
        MARK(0);
        if (EN_GEMM & 1) { KA_INIT; run_g1((LAS unsigned char*)shm, WSP(bf16_t, WS_H), WSP(bf16_t, WS_WIN), WSP(bf16_t, WS_PROJ), WSP(float, WS_DT), PIN(I_DTB) + l * 32); }
        if (EN_PREP && gridDim.x == 256 && blockIdx.x >= 114) convert_list(l, (int)blockIdx.x - 114, 142, 19, shm);
        GSYNC; MARK(1);
        phase_e1(p, l, shm);
        GSYNC;
        {
            const int step = blockIdx.x < 128 ? (1 << 20) : (int)gridDim.x - 128;
            if (EN_SSD) for (int it = blockIdx.x; it < 1152; it += step) { const bool smp = it >= 128; ssd_chain(p, l, smp, smp ? (it - 128) >> 5 : it >> 5, it & 31, shm); }
            if (EN_GMLP) for (int it = blockIdx.x; it < 544; it += step) { const bool smp = it >= 512; gmlp_item(p, l, smp, smp ? it - 512 : it, shm); }
        }
        GSYNC; MARK(2);
        if (EN_PREP) convert_list(l, (gridDim.x == 256 ? 2698 : 0) + (int)blockIdx.x, (int)gridDim.x, 1 << 20, shm);
        if (EN_SN) phase_sn(p, l);
        GSYNC; MARK(3);
        if (EN_GEMM & 2) { KA_INIT; run_gx((LAS unsigned char*)shm, WSP(bf16_t, WS_MIX), WSP(bf16_t, WS_WOUT), WSP(float, WS_X), WSP(float, WS_PROJ), DMIX, 16); }
        GSYNC; MARK(4);
        { KA_INIT; phase_norm<1>(p, PIN(I_N2W) + (size_t)l * DM, 16, shm); }
        GSYNC; MARK(5);
        if (EN_GEMM & 4) { KA_INIT; run_g3((LAS unsigned char*)shm, WSP(bf16_t, WS_H), WSP(bf16_t, WS_WUP), WSP(bf16_t, WS_PROJ)); }
        GSYNC; MARK(6);
        if (EN_E2) phase_e2(p, l);
        GSYNC; MARK(7);
        if (EN_GEMM & 8) { KA_INIT; run_gx((LAS unsigned char*)shm, WSP(bf16_t, WS_MIX), WSP(bf16_t, WS_WDN), WSP(float, WS_X), WSP(float, WS_PROJ), DFF, 11); }
        GSYNC; MARK(8);
    }
#if PROBE
    float addA = 0.f;
    if (blockIdx.x == 0 && threadIdx.x == 0) { KA_INIT; addA = 10.f + (float)accA * (0.01f / 150.f); float* q_ = POUT + O_PCONV; *q_ = *q_ + 4.f + (float)accB * (0.01f / 1000.f); }
    { KA_INIT; phase_norm<2>(p, PIN(I_FNW), 11, shm, addA); }
#else
    { KA_INIT; phase_norm<2>(p, PIN(I_FNW), 11, shm); }
#endif
}

extern "C" void kernel_launch(void* const* d_in, const int* in_sizes, int n_in, void* d_out, int out_size, void* d_ws, size_t ws_size, hipStream_t stream) {
    static int grid = 0;
    if (grid == 0) {
        if (n_in != 23 || ws_size < WS_TOTAL) { fprintf(stderr, "kernel_launch: n_in %d ws %zu (need %zu)\n", n_in, ws_size, (size_t)WS_TOTAL); grid = -1; return; }
        int dev = 0, cus = 0, per_cu = 0;
        hipGetDevice(&dev); hipDeviceGetAttribute(&cus, hipDeviceAttributeMultiprocessorCount, dev);
        hipFuncSetAttribute((const void*)fwd_kernel, hipFuncAttributeMaxDynamicSharedMemorySize, LDS_BYTES);
        hipOccupancyMaxActiveBlocksPerMultiprocessor(&per_cu, (const void*)fwd_kernel, 512, LDS_BYTES);
        (void)hipGetLastError();
        if (per_cu < 1) per_cu = 1;
        grid = cus;
        if (grid < 129) { fprintf(stderr, "kernel_launch: needs > 128 CUs\n"); grid = -1; return; }
    }
    if (grid < 0) return;
    (void)hipMemsetAsync((unsigned char*)d_ws + WS_BAR, 0, WS_BAR_BYTES, stream);
    Params p{};
    for (int i = 0; i < 23; ++i) p.in[i] = (const float*)d_in[i];
    p.out = (float*)d_out; p.ws = (unsigned char*)d_ws;
    void* args[] = {&p};
    hipError_t e = hipLaunchCooperativeKernel((const void*)fwd_kernel, dim3(grid), dim3(512), args, LDS_BYTES, stream);
    if (e != hipSuccess) fprintf(stderr, "cooperative launch failed: %s (grid %d)\n", hipGetErrorString(e), grid);
}
```

```cpp
#include <hip/hip_runtime.h>
#include <hip/hip_cooperative_groups.h>
#include <cstdio>
namespace cg = cooperative_groups;

#define LAS __attribute__((address_space(3)))
typedef unsigned short bf16_t;
typedef short bf16x8 __attribute__((ext_vector_type(8)));
typedef float f32x4 __attribute__((ext_vector_type(4)));
typedef unsigned u32x4 __attribute__((ext_vector_type(4)));
typedef unsigned u32x2 __attribute__((ext_vector_type(2)));

#ifndef PROBE_A
#define PROBE_A 0
#endif
#ifndef PROBE_B
#define PROBE_B 0
#endif
#define PROBE (PROBE_A | PROBE_B)
constexpr int TP = 8192, TS = 512, T = 8704;
constexpr int DM = 2048, NPROJ = 10240, NINP = 10496, DIN = 10272;
constexpr int DMIX = 4096, DFF = 5632, DUP = 11264;
constexpr float EPS = 1e-6f;
constexpr size_t WS_WIN = 0;
constexpr size_t WS_WOUT = WS_WIN + (size_t)NINP * DM * 2;
constexpr size_t WS_WUP = WS_WOUT + (size_t)DM * DMIX * 2;
constexpr size_t WS_WDN = WS_WUP + (size_t)DUP * DM * 2;
constexpr size_t WS_X = WS_WDN + (size_t)DM * DFF * 2;
constexpr size_t WS_H = WS_X + (size_t)T * DM * 4;
constexpr size_t WS_PROJ = WS_H + (size_t)T * DM * 2;
constexpr size_t WS_MIX = WS_PROJ + (size_t)T * DUP * 2;
constexpr size_t WS_DT = WS_MIX + (size_t)T * DFF * 2;
constexpr size_t WS_SSQ = WS_DT + (size_t)T * 32 * 4;
constexpr size_t WS_BC = WS_SSQ + (size_t)T * 32 * 4;
constexpr size_t WS_END = WS_BC + (size_t)T * 2048 * 2;
constexpr size_t O_YP = 0, O_PCONV = 17825792, O_PSSD = 17924096, O_PFFN = 20021248, O_SCONV = 20201472, O_SSSD = 20987904, O_SFFN = 37765120, O_SV = 39206912;
constexpr int LDS_BYTES = 147456 + 256;

struct Params { const float* in[23]; float* out; unsigned char* ws; };
typedef const unsigned char __attribute__((address_space(4)))* kaptr_t;
#define KA_INIT kaptr_t ka_ = (kaptr_t)__builtin_amdgcn_kernarg_segment_ptr(); asm volatile("" : "+s"(ka_))
#define PIN(i) (*(const float* const __attribute__((address_space(4)))*)(ka_ + 8 * (i)))
#define POUT ((float*)PIN(23))
#define PWS ((unsigned char*)PIN(24))
#define TID_INIT int tid = threadIdx.x; asm volatile("" : "+v"(tid))
enum { I_XP = 0, I_XS, I_SCONV, I_SSSD, I_SFFN, I_N1W, I_WIN, I_CW, I_CB, I_DTB, I_ALOG, I_D, I_SNW, I_GNW, I_GWS, I_GBS, I_WOUT, I_N2W, I_WUP, I_FCW, I_FCB, I_WDN, I_FNW };

__device__ __forceinline__ float bf2f(bf16_t b) { return __uint_as_float(((unsigned)b) << 16); }
__device__ __forceinline__ unsigned pk2(float lo, float hi) { unsigned r; asm volatile("v_cvt_pk_bf16_f32 %0, %1, %2" : "=v"(r) : "v"(lo), "v"(hi)); return r; }
__device__ __forceinline__ bf16_t f2bf(float f) { return (bf16_t)(pk2(f, 0.f) & 0xffffu); }
__device__ __forceinline__ void unpack8(u32x4 v, float* f) {
#pragma unroll
    for (int i = 0; i < 4; ++i) { f[2 * i] = __uint_as_float(v[i] << 16); f[2 * i + 1] = __uint_as_float(v[i] & 0xffff0000u); }
}
__device__ __forceinline__ u32x4 pack8(const float* f) { u32x4 r; r.x = pk2(f[0], f[1]); r.y = pk2(f[2], f[3]); r.z = pk2(f[4], f[5]); r.w = pk2(f[6], f[7]); return r; }
__device__ __forceinline__ float silu_f(float x) { return x * __builtin_amdgcn_rcpf(1.0f + __expf(-x)); }
__device__ __forceinline__ float gelu_f(float x) { const float t = 1.5957691216057308f * (x + 0.044715f * x * x * x); return x * __builtin_amdgcn_rcpf(1.0f + __expf(-t)); }
__device__ __forceinline__ float softplus_f(float x) { return x > 20.f ? x : __logf(1.0f + __expf(x)); }
__device__ __forceinline__ float wave_sum(float v) {
#pragma unroll
    for (int o = 32; o > 0; o >>= 1) v += __shfl_xor(v, o);
    return v;
}

#define LBAR asm volatile("s_waitcnt lgkmcnt(0)\n\ts_barrier" ::: "memory")
namespace pg8 {
constexpr int BM = 256, BK = 64, HALF = 128, HTB = HALF * BK * 2, NXCD = 8, WGM = 8;
__device__ __forceinline__ int lds_byte(int r, int c) { const int st = (r >> 4) * 2 + (c >> 5), rr = r & 15, cc = c & 31, ob = rr * 64 + cc * 2; return st * 1024 + (ob ^ (((ob >> 9) & 1) << 5)); }
__device__ __forceinline__ void stage_rc(int b, int& R, int& C) { const int st = b / 1024, sb = b % 1024, swz = sb ^ (((sb >> 9) & 1) << 5); R = (st >> 1) * 16 + swz / 64; C = (st & 1) * 32 + (swz % 64) / 2; }
__device__ __forceinline__ int perm32(int rho) { const int n = rho >> 4, i = rho & 15; return 8 * (i >> 2) + 4 * n + (i & 3); }
struct Unit { int pm, pn, kt0, nkt, slab; };
struct Gemm { const bf16_t* A; const bf16_t* Bt; int M, N, K; };
struct StaticOrder {
    int nM, nN, nwg, G, c, nkt;
    __device__ void init(int M, int N, int G_, int c_) { nM = M / BM; nN = N / BM; nwg = nM * nN; G = G_; c = c_; nkt = 0; }
    __device__ bool next(int i, Unit& u) const {
        const long L = (long)i * G + c; if (L >= nwg) return false;
        int wgid = (int)L; { const int q = nwg / NXCD, r = nwg % NXCD, xcd = wgid % NXCD, off = wgid / NXCD; wgid = (xcd < r ? xcd * (q + 1) : r * (q + 1) + (xcd - r) * q) + off; }
        const int nig = WGM * nN, gid = wgid / nig, fm = gid * WGM, gsz = (nM - fm) < WGM ? (nM - fm) : WGM;
        u.pm = fm + ((wgid % nig) % gsz); u.pn = (wgid % nig) / gsz; u.kt0 = 0; u.nkt = nkt; u.slab = -1; return true;
    }
};
struct HybridOrder {
    StaticOrder so; int ns, kper, c;
    __device__ void init(int K, int ns_, int G_, int c_) { so.init(TP, DM, G_, c_); so.nkt = K / BK; ns = ns_; kper = K / BK / ns_; c = c_; }
    __device__ bool next(int i, Unit& u) const {
        if (so.next(i, u)) return true;
        const int nmr = c < so.nwg ? (so.nwg - c + so.G - 1) / so.G : 0;
        const long q = (long)(i - nmr) * so.G + c;
        if (i >= nmr && q < 16 * ns) { const int s = (int)q % ns, tile = (int)q / ns; u.pm = 32 + (tile >> 3); u.pn = tile & 7; u.kt0 = s * kper; u.nkt = kper; u.slab = (tile >> 3) * ns + s; return true; }
        return false;
    }
};
template <class Epi, class Sched>
__device__ __forceinline__ void gemm_phase(LAS unsigned char* lds, const Gemm g, const Sched& S, const Epi& E) {
    int tid = threadIdx.x; asm volatile("" : "+v"(tid));
    const int wid = __builtin_amdgcn_readfirstlane(tid >> 6), lane = tid & 63, wr = wid >> 2, wc = wid & 3, fr = lane & 15, fq = lane >> 4;
    int K = __builtin_amdgcn_readfirstlane(g.K); asm volatile("" : "+s"(K));
    unsigned voffA[2], voffB[2];
#pragma unroll
    for (int i = 0; i < 2; ++i) { int R, C; stage_rc(tid * 16 + i * 8192, R, C); const int Rb = (R & ~31) + perm32(R & 31);
        voffA[i] = (unsigned)(R * K + C) * 2u; voffB[i] = (unsigned)(Rb * K + C) * 2u; }
    const size_t kstep = (size_t)(BK * 2);
    const size_t hstep = (size_t)HALF * K * 2;
    const size_t tstep = 2 * hstep;
    const unsigned ldsw = (unsigned)wid * 1024u;
    const int aoff = lds_byte(wr * 64 + fr, fq * 8), boff = lds_byte(wc * 32 + fr, fq * 8);
#define PG8_SA(b, h) (((b) * 2 + (h)) * HTB)
#define PG8_SB(b, h) ((4 + (b) * 2 + (h)) * HTB)
#define PG8_STAGE(bufoff, gbase, voff) do { _Pragma("unroll") for (int _i = 0; _i < 2; ++_i) \
        __builtin_amdgcn_global_load_lds((const unsigned*)((const char*)(gbase) + (voff)[_i]), (LAS unsigned*)(lds + (bufoff) + ldsw + _i * 8192), 16, 0, 0); } while (0)
#define PG8_LDA(dst, b, h) do { _Pragma("unroll") for (int m = 0; m < 4; ++m) _Pragma("unroll") for (int k = 0; k < 2; ++k) dst[m][k] = *(const LAS bf16x8*)(lds + PG8_SA(b, h) + aoff + m * 2048 + k * 1024); } while (0)
#define PG8_LDB(dst, b, h) do { _Pragma("unroll") for (int n = 0; n < 2; ++n) _Pragma("unroll") for (int k = 0; k < 2; ++k) dst[n][k] = *(const LAS bf16x8*)(lds + PG8_SB(b, h) + boff + n * 2048 + k * 1024); } while (0)
#define PG8_MMA(ai, bj, At, Bt) do { __builtin_amdgcn_s_setprio(1); _Pragma("unroll") for (int m = 0; m < 4; ++m) _Pragma("unroll") for (int n = 0; n < 2; ++n) _Pragma("unroll") for (int k = 0; k < 2; ++k) \
        acc[ai][bj][m][n] = __builtin_amdgcn_mfma_f32_16x16x32_bf16(Bt[n][k], At[m][k], acc[ai][bj][m][n], 0, 0, 0); __builtin_amdgcn_s_setprio(0); } while (0)
#define PG8_WAIT_V(n) asm volatile("s_waitcnt vmcnt(" #n ")" ::: "memory")
#define PG8_WAIT_L(n) asm volatile("s_waitcnt lgkmcnt(" #n ")" ::: "memory")
#define PG8_BAR __builtin_amdgcn_s_barrier()
#define PG8_SCHED __builtin_amdgcn_sched_barrier(0)
    Unit cur, nxt; int ui = 0;
    if (!S.next(0, cur)) return;
    f32x4 acc[2][2][4][2];
#pragma unroll
    for (int a = 0; a < 2; ++a)
#pragma unroll
        for (int b = 0; b < 2; ++b)
#pragma unroll
            for (int m = 0; m < 4; ++m)
#pragma unroll
                for (int n = 0; n < 2; ++n) acc[a][b][m][n] = (f32x4){0.f, 0.f, 0.f, 0.f};
    bf16x8 At[4][2], B0[2][2], B1[2][2];
    const char* cA = (const char*)g.A + (size_t)cur.pm * tstep + (size_t)cur.kt0 * kstep; const char* cB = (const char*)g.Bt + (size_t)cur.pn * tstep + (size_t)cur.kt0 * kstep;
    PG8_STAGE(PG8_SB(0, 0), cB, voffB); PG8_STAGE(PG8_SA(0, 0), cA, voffA); PG8_STAGE(PG8_SB(0, 1), cB + hstep, voffB); PG8_STAGE(PG8_SA(0, 1), cA + hstep, voffA);
    if (wr == 1) PG8_BAR;
    PG8_WAIT_V(4); PG8_BAR;
    PG8_STAGE(PG8_SB(1, 0), cB + kstep, voffB); PG8_STAGE(PG8_SA(1, 0), cA + kstep, voffA); PG8_STAGE(PG8_SB(1, 1), cB + hstep + kstep, voffB);
    PG8_WAIT_V(6); PG8_BAR;
    for (;;) {
        const bool has_next = S.next(ui + 1, nxt);
        const char* nA = has_next ? (const char*)g.A + (size_t)nxt.pm * tstep + (size_t)nxt.kt0 * kstep : cA; const char* nB = has_next ? (const char*)g.Bt + (size_t)nxt.pn * tstep + (size_t)nxt.kt0 * kstep : cB;
        const int nt = cur.nkt;
        for (int t = 0; t < nt; t += 2) {
            const bool last = (t == nt - 2);
            const char* a1 = cA + (size_t)(t + 1) * kstep;
            const char* a2 = last ? nA : cA + (size_t)(t + 2) * kstep; const char* b2 = last ? nB : cB + (size_t)(t + 2) * kstep;
            const char* a3 = a2 + kstep; const char* b3 = b2 + kstep;
            PG8_LDB(B0, 0, 0); PG8_SCHED; PG8_LDA(At, 0, 0); PG8_STAGE(PG8_SA(1, 1), a1 + hstep, voffA);
            PG8_WAIT_L(8); PG8_BAR; PG8_WAIT_L(0); PG8_MMA(0, 0, At, B0); PG8_BAR; PG8_SCHED;
            PG8_LDB(B1, 0, 1); PG8_STAGE(PG8_SB(0, 0), b2, voffB);
            PG8_BAR; PG8_WAIT_L(0); PG8_MMA(0, 1, At, B1); PG8_BAR;
            PG8_LDA(At, 0, 1); PG8_STAGE(PG8_SA(0, 0), a2, voffA);
            PG8_BAR; PG8_WAIT_L(0); PG8_MMA(1, 0, At, B0); PG8_BAR; PG8_SCHED;
            PG8_STAGE(PG8_SB(0, 1), b2 + hstep, voffB);
            PG8_WAIT_V(6); PG8_BAR; PG8_MMA(1, 1, At, B1); PG8_BAR;
            PG8_LDB(B0, 1, 0); PG8_SCHED; PG8_LDA(At, 1, 0); PG8_STAGE(PG8_SA(0, 1), a2 + hstep, voffA);
            PG8_WAIT_L(8); PG8_BAR; PG8_WAIT_L(0); PG8_MMA(0, 0, At, B0); PG8_BAR; PG8_SCHED;
            PG8_LDB(B1, 1, 1); PG8_STAGE(PG8_SB(1, 0), b3, voffB);
            PG8_BAR; PG8_WAIT_L(0); PG8_MMA(0, 1, At, B1); PG8_BAR;
            PG8_LDA(At, 1, 1); PG8_STAGE(PG8_SA(1, 0), a3, voffA);
            PG8_BAR; PG8_WAIT_L(0); PG8_MMA(1, 0, At, B0); PG8_BAR; PG8_SCHED;
            PG8_STAGE(PG8_SB(1, 1), b3 + hstep, voffB);
            PG8_WAIT_V(6); PG8_BAR; PG8_MMA(1, 1, At, B1); PG8_BAR;
        }
        E(acc, cur, wr, wc, fr, fq);
        if (!has_next) break;
#pragma unroll
        for (int a = 0; a < 2; ++a)
#pragma unroll
            for (int b = 0; b < 2; ++b)
#pragma unroll
                for (int m = 0; m < 4; ++m)
#pragma unroll
                    for (int n = 0; n < 2; ++n) acc[a][b][m][n] = (f32x4){0.f, 0.f, 0.f, 0.f};
        cur = nxt; cA = nA; cB = nB; ++ui;
    }
    PG8_WAIT_V(0);
    if (wr == 0) PG8_BAR;
    PG8_BAR;
#undef PG8_SA
#undef PG8_SB
#undef PG8_STAGE
#undef PG8_LDA
#undef PG8_LDB
#undef PG8_MMA
#undef PG8_WAIT_V
#undef PG8_WAIT_L
#undef PG8_BAR
#undef PG8_SCHED
}
}
using pg8::Unit;

struct EpiG1 {
    bf16_t* P; float* DT; const float* dtb;
    __device__ __forceinline__ void operator()(const f32x4 (&acc)[2][2][4][2], const Unit& u, int wr, int wc, int fr, int fq) const {
        const int row0 = u.pm * 256 + wr * 64 + fr;
        if (u.pn < 40) {
            const int mode = u.pn < 8 ? 1 : (u.pn < 24 ? 0 : 2);
            const int col0 = u.pn * 256 + wc * 32 + 8 * fq;
#pragma unroll
            for (int ai = 0; ai < 2; ++ai)
#pragma unroll
                for (int m = 0; m < 4; ++m) { bf16_t* rowp = P + (size_t)(row0 + ai * 128 + m * 16) * NPROJ + col0;
#pragma unroll
                    for (int bj = 0; bj < 2; ++bj) { float v[8];
#pragma unroll
                        for (int j = 0; j < 4; ++j) { v[j] = acc[ai][bj][m][0][j]; v[4 + j] = acc[ai][bj][m][1][j]; }
                        if (mode == 1) {
#pragma unroll
                            for (int j = 0; j < 8; ++j) v[j] = silu_f(v[j]); }
                        else if (mode == 2) {
#pragma unroll
                            for (int j = 0; j < 8; ++j) v[j] = gelu_f(v[j]); }
                        *(u32x4*)(rowp + bj * 128) = pack8(v); } }
        } else if (wc == 0) {
#pragma unroll
            for (int ai = 0; ai < 2; ++ai)
#pragma unroll
                for (int m = 0; m < 4; ++m) { float* rowp = DT + (size_t)(row0 + ai * 128 + m * 16) * 32 + 8 * fq;
#pragma unroll
                    for (int n = 0; n < 2; ++n) { f32x4 o;
#pragma unroll
                        for (int j = 0; j < 4; ++j) o[j] = softplus_f(acc[ai][0][m][n][j] + dtb[8 * fq + 4 * n + j]);
                        *(f32x4*)(rowp + 4 * n) = o; } }
        }
    }
};
struct EpiX {
    float* X; float* SL;
    __device__ __forceinline__ void operator()(const f32x4 (&acc)[2][2][4][2], const Unit& u, int wr, int wc, int fr, int fq) const {
        const int col0 = u.pn * 256 + wc * 32 + 8 * fq;
        if (u.slab < 0) {
            const int row0 = u.pm * 256 + wr * 64 + fr;
#pragma unroll
            for (int ai = 0; ai < 2; ++ai)
#pragma unroll
                for (int m = 0; m < 4; ++m) { float* rowp = X + (size_t)(row0 + ai * 128 + m * 16) * DM + col0;
#pragma unroll
                    for (int bj = 0; bj < 2; ++bj) { f32x4* q = (f32x4*)(rowp + bj * 128); f32x4 a = q[0], b = q[1]; q[0] = a + acc[ai][bj][m][0]; q[1] = b + acc[ai][bj][m][1]; } }
        } else {
            float* base = SL + (size_t)u.slab * 256 * DM; const int row0 = wr * 64 + fr;
#pragma unroll
            for (int ai = 0; ai < 2; ++ai)
#pragma unroll
                for (int m = 0; m < 4; ++m) { float* rowp = base + (size_t)(row0 + ai * 128 + m * 16) * DM + col0;
#pragma unroll
                    for (int bj = 0; bj < 2; ++bj) { f32x4* q = (f32x4*)(rowp + bj * 128); q[0] = acc[ai][bj][m][0]; q[1] = acc[ai][bj][m][1]; } }
        }
    }
};
struct EpiUp {
    bf16_t* U;
    __device__ __forceinline__ void operator()(const f32x4 (&acc)[2][2][4][2], const Unit& u, int wr, int wc, int fr, int fq) const {
        const int row0 = u.pm * 256 + wr * 64 + fr, col0 = u.pn * 256 + wc * 32 + 8 * fq;
#pragma unroll
        for (int ai = 0; ai < 2; ++ai)
#pragma unroll
            for (int m = 0; m < 4; ++m) { bf16_t* rowp = U + (size_t)(row0 + ai * 128 + m * 16) * DUP + col0;
#pragma unroll
                for (int bj = 0; bj < 2; ++bj) { u32x4 w; w.x = pk2(acc[ai][bj][m][0][0], acc[ai][bj][m][0][1]); w.y = pk2(acc[ai][bj][m][0][2], acc[ai][bj][m][0][3]);
                    w.z = pk2(acc[ai][bj][m][1][0], acc[ai][bj][m][1][1]); w.w = pk2(acc[ai][bj][m][1][2], acc[ai][bj][m][1][3]); *(u32x4*)(rowp + bj * 128) = w; } }
    }
};

__device__ __forceinline__ int map_col(int n, int mode) {
    if (mode == 0) return n;
    if (n < 6144) return n; if (n < 10240) return n + 32; if (n < 10272) return n - 10240 + 6144; return -1;
}
__device__ __forceinline__ void convert_w(const float* __restrict__ src, int K, int Nsrc, bf16_t* __restrict__ dst, int Ndst, int mode, unsigned char* shm) {
    float* tile = (float*)shm;
    TID_INIT;
    const int ntn = Ndst / 256, ntk = K / 64, ntile = ntn * ntk;
    const int tkk = tid >> 4, tn4 = tid & 15, wn = tid >> 3, wk8 = tid & 7;
    f32x4 v[4][2];
    int t = blockIdx.x;
#define CW_LOAD(tt_) do { const int tn_ = (tt_) % ntn, tk_ = (tt_) / ntn; \
        _Pragma("unroll") for (int s_ = 0; s_ < 4; ++s_) { const int sc_ = map_col(tn_ * 256 + 64 * s_ + 4 * tn4, mode); \
            _Pragma("unroll") for (int i_ = 0; i_ < 2; ++i_) { v[s_][i_] = (f32x4){0.f, 0.f, 0.f, 0.f}; if (sc_ >= 0) v[s_][i_] = *(const f32x4*)(src + (size_t)(tk_ * 64 + tkk + 32 * i_) * Nsrc + sc_); } } } while (0)
    if (t < ntile) CW_LOAD(t);
    for (; t < ntile; t += gridDim.x) {
        const int tn = t % ntn, tk = t / ntn, n0 = tn * 256, k0 = tk * 64;
#pragma unroll
        for (int s_ = 0; s_ < 4; ++s_)
#pragma unroll
            for (int i = 0; i < 2; ++i)
#pragma unroll
                for (int j = 0; j < 4; ++j) tile[(tkk + 32 * i) * 257 + 64 * s_ + 4 * tn4 + j] = v[s_][i][j];
        LBAR;
        if (t + (int)gridDim.x < ntile) CW_LOAD(t + (int)gridDim.x);
#pragma unroll
        for (int s_ = 0; s_ < 4; ++s_) { float f[8];
#pragma unroll
            for (int j = 0; j < 8; ++j) f[j] = tile[(8 * wk8 + j) * 257 + 64 * s_ + wn];
            *(u32x4*)(dst + (size_t)(n0 + 64 * s_ + wn) * K + k0 + 8 * wk8) = pack8(f); }
        LBAR;
    }
#undef CW_LOAD
}

constexpr int CVT_REST_TILES = 2624;
struct CvtTile { const float* src; bf16_t* dst; int K, Nsrc, n0, k0; };
__device__ __forceinline__ CvtTile cvt_decode(int t, int l, kaptr_t ka_) {
    CvtTile c; int ntn, tt;
    if (t < 512) { ntn = 8; tt = t; c.src = PIN(I_WOUT) + (size_t)l * DMIX * DM; c.K = DMIX; c.Nsrc = DM; c.dst = (bf16_t*)(PWS + WS_WOUT); }
    else if (t < 1920) { ntn = 44; tt = t - 512; c.src = PIN(I_WUP) + (size_t)l * DM * DUP; c.K = DM; c.Nsrc = DUP; c.dst = (bf16_t*)(PWS + WS_WUP); }
    else { ntn = 8; tt = t - 1920; c.src = PIN(I_WDN) + (size_t)l * DFF * DM; c.K = DFF; c.Nsrc = DM; c.dst = (bf16_t*)(PWS + WS_WDN); }
    c.n0 = (tt % ntn) * 256; c.k0 = (tt / ntn) * 64; return c;
}
__device__ __forceinline__ void convert_list(int l, int t0, int stride, int niter, unsigned char* shm) {
    KA_INIT; TID_INIT;
    float* tile = (float*)shm;
    const int tkk = tid >> 4, tn4 = tid & 15, wn = tid >> 3, wk8 = tid & 7;
    f32x4 v[4][2];
    int t = t0; asm volatile("" : "+s"(t));
#define CL_LOAD(tt_) do { const CvtTile c_ = cvt_decode((tt_), l, ka_); \
        _Pragma("unroll") for (int s_ = 0; s_ < 4; ++s_) _Pragma("unroll") for (int i_ = 0; i_ < 2; ++i_) \
            v[s_][i_] = *(const f32x4*)(c_.src + (size_t)(c_.k0 + tkk + 32 * i_) * c_.Nsrc + c_.n0 + 64 * s_ + 4 * tn4); } while (0)
    if (niter > 0 && t < CVT_REST_TILES) CL_LOAD(t);
    for (int k = 0; k < niter && t < CVT_REST_TILES; ++k, t += stride) {
        const CvtTile c = cvt_decode(t, l, ka_);
#pragma unroll
        for (int s_ = 0; s_ < 4; ++s_)
#pragma unroll
            for (int i = 0; i < 2; ++i)
#pragma unroll
                for (int j = 0; j < 4; ++j) tile[(tkk + 32 * i) * 257 + 64 * s_ + 4 * tn4 + j] = v[s_][i][j];
        LBAR;
        if (k + 1 < niter && t + stride < CVT_REST_TILES) CL_LOAD(t + stride);
#pragma unroll
        for (int s_ = 0; s_ < 4; ++s_) { float f[8];
#pragma unroll
            for (int j = 0; j < 8; ++j) f[j] = tile[(8 * wk8 + j) * 257 + 64 * s_ + wn];
            *(u32x4*)(c.dst + (size_t)(c.n0 + 64 * s_ + wn) * c.K + c.k0 + 8 * wk8) = pack8(f); }
        LBAR;
    }
#undef CL_LOAD
}

template <int MODE>
__device__ __forceinline__ void phase_norm(const Params& p, const float* __restrict__ w, int ns, unsigned char* shm, float addA = 0.f) {
    KA_INIT; TID_INIT;
    const int lane = tid & 63, wv_ = tid >> 6, gw = blockIdx.x * 8 + wv_, nw = gridDim.x * 8;
    float* X = (float*)(PWS + WS_X); bf16_t* H = (bf16_t*)(PWS + WS_H);
    const int nrows = ns > 0 ? TP : T;
    for (int row = gw; row < nrows; row += nw) {
        const float* src = MODE == 0 ? (row < TP ? PIN(I_XP) + (size_t)row * DM : PIN(I_XS) + (size_t)(row - TP) * DM) : X + (size_t)row * DM;
        f32x4 v[8]; float ss = 0.f;
#pragma unroll
        for (int i = 0; i < 8; ++i) { v[i] = *(const f32x4*)(src + i * 256 + lane * 4); ss += v[i][0] * v[i][0] + v[i][1] * v[i][1] + v[i][2] * v[i][2] + v[i][3] * v[i][3]; }
        ss = wave_sum(ss);
        const float rstd = rsqrtf(ss * (1.0f / DM) + EPS);
#pragma unroll
        for (int i = 0; i < 8; ++i) { const int c = i * 256 + lane * 4; const f32x4 wv = *(const f32x4*)(w + c);
            if (MODE == 0) *(f32x4*)(X + (size_t)row * DM + c) = v[i];
            f32x4 o = v[i] * rstd * wv;
            if (MODE == 2) { if (PROBE && row == 0 && i == 0 && lane == 0) o[0] += addA; *(f32x4*)(POUT + O_YP + (size_t)row * DM + c) = o; }
            else { u32x2 pk; pk.x = pk2(o[0], o[1]); pk.y = pk2(o[2], o[3]); *(u32x2*)(H + (size_t)row * DM + c) = pk; } }
    }
    if (ns > 0) {
        float* red = (float*)shm; const float* SL = (const float*)(PWS + WS_PROJ);
        for (int r = blockIdx.x; r < TS; r += gridDim.x) {
            const int row = TP + r, pmi = r >> 8, rr = r & 255, c = wv_ * 256 + lane * 4;
            f32x4 v = *(const f32x4*)(X + (size_t)row * DM + c);
            { f32x4 sl[16];
#pragma unroll
              for (int s = 0; s < 16; ++s) { sl[s] = (f32x4){0.f, 0.f, 0.f, 0.f}; if (s < ns) sl[s] = *(const f32x4*)(SL + ((size_t)(pmi * ns + s) * 256 + rr) * DM + c); }
#pragma unroll
              for (int s = 0; s < 16; s += 4) v += (sl[s] + sl[s + 1]) + (sl[s + 2] + sl[s + 3]); }
            float ss = wave_sum(v[0] * v[0] + v[1] * v[1] + v[2] * v[2] + v[3] * v[3]);
            if (lane == 0) red[wv_] = ss;
            __syncthreads();
            ss = red[0] + red[1] + red[2] + red[3] + red[4] + red[5] + red[6] + red[7];
            const float rstd = rsqrtf(ss * (1.0f / DM) + EPS);
            *(f32x4*)(X + (size_t)row * DM + c) = v;
            const f32x4 o = v * rstd * *(const f32x4*)(w + c);
            if (MODE == 2) *(f32x4*)(POUT + O_YP + (size_t)row * DM + c) = o;
            else { u32x2 pk; pk.x = pk2(o[0], o[1]); pk.y = pk2(o[2], o[3]); *(u32x2*)(H + (size_t)row * DM + c) = pk; }
            __syncthreads();
        }
    }
}

__device__ __forceinline__ bf16x8 ldfrag(const bf16_t* base, int ld, int row0, int k0, int lane) { return *(const bf16x8*)(base + (row0 + (lane & 15)) * ld + k0 + (lane >> 4) * 8); }
__device__ __forceinline__ f32x4 mma16(bf16x8 x, bf16x8 y, f32x4 c) { return __builtin_amdgcn_mfma_f32_16x16x32_bf16(x, y, c, 0, 0, 0); }

__device__ __forceinline__ void phase_e1(const Params& p, int l, unsigned char* shm) {
    KA_INIT; TID_INIT;
    const int lane = tid & 63, w = __builtin_amdgcn_readfirstlane(tid >> 6);
    bf16_t* RAWE = (bf16_t*)(shm + 0);
    bf16_t* HST = (bf16_t*)(shm + 18432);
    bf16_t* OUT = (bf16_t*)(shm + 22528);
    const bf16_t* proj = (const bf16_t*)(PWS + WS_PROJ); bf16_t* bc = (bf16_t*)(PWS + WS_BC);
    typedef const float __attribute__((address_space(4)))* cptr4_t;
    const cptr4_t cw4 = (cptr4_t)(PIN(I_CW) + (size_t)l * 4 * 4096); const cptr4_t cb4 = (cptr4_t)(PIN(I_CB) + (size_t)l * 4096);
    u32x4 pre[3];
#define E1_LOAD(item_) do { const int rb_ = (item_) >> 4, chb_ = 2048 + ((item_) & 1) * 1024 + (((item_) >> 1) & 7) * 128, R0_ = rb_ * 64; const bool hh_ = R0_ < TP && (rb_ & 31) != 0; \
        _Pragma("unroll") for (int i_ = 0; i_ < 3; ++i_) { const int v_ = i_ * 512 + tid, rowh_ = v_ >> 4, c16_ = v_ & 15; pre[i_] = (u32x4){0u, 0u, 0u, 0u}; \
            if (v_ < 1072 && (rowh_ >= 3 || hh_)) pre[i_] = *(const u32x4*)(proj + (size_t)(R0_ - 3 + rowh_) * NPROJ + 2048 + chb_ + c16_ * 8); } } while (0)
    int item = blockIdx.x; asm volatile("" : "+s"(item));
    if (item < 2176) E1_LOAD(item);
    for (; item < 2176; item += gridDim.x) {
        const int rb = item >> 4, g = (item >> 1) & 7, half = item & 1, chb = 2048 + half * 1024 + g * 128, R0 = rb * 64; const bool sample = R0 >= TP;
#pragma unroll
        for (int i = 0; i < 3; ++i) { const int v_ = i * 512 + tid; if (v_ < 1072) *(u32x4*)(RAWE + (v_ >> 4) * 136 + (v_ & 15) * 8) = pre[i]; }
        if (sample && tid < 192) { const int sl = tid / 48, rem = tid - sl * 48, hr = rem >> 4, c16 = rem & 15, sq = ((R0 - TP) >> 4) + sl;
            const float* sp = PIN(I_SCONV) + ((size_t)(l * 32 + sq) * 3 + hr) * 4096 + chb + c16 * 8; const f32x4 a = *(const f32x4*)sp, b = *(const f32x4*)(sp + 4);
            u32x4 hv; hv.x = pk2(a[0], a[1]); hv.y = pk2(a[2], a[3]); hv.z = pk2(b[0], b[1]); hv.w = pk2(b[2], b[3]);
            *(u32x4*)(HST + (sl * 3 + hr) * 136 + c16 * 8) = hv; }
        LBAR;
        if (item + (int)gridDim.x < 2176) E1_LOAD(item + (int)gridDim.x);
        {
            const int t = lane, tl = t & 15;
            u32x4 rws[2][4];
#pragma unroll
            for (int it = 0; it < 2; ++it)
#pragma unroll
                for (int k = 0; k < 4; ++k) { const int c16 = 2 * w + it; int off = ((t + k) * 136 + c16 * 8) * 2;
                    if (sample && tl - 3 + k < 0) off = 18432 + (((t >> 4) * 3 + tl + k) * 136 + c16 * 8) * 2;
                    rws[it][k] = *(const u32x4*)(shm + off); }
#pragma unroll
            for (int it = 0; it < 2; ++it) { const int c16 = 2 * w + it, ch = chb + c16 * 8;
                float v[8];
#pragma unroll
                for (int j = 0; j < 8; ++j) v[j] = cb4[ch + j];
#pragma unroll
                for (int k = 0; k < 4; ++k) { float rw[8]; unpack8(rws[it][k], rw);
#pragma unroll
                    for (int j = 0; j < 8; ++j) v[j] += cw4[k * 4096 + ch + j] * rw[j]; }
#pragma unroll
                for (int j = 0; j < 8; ++j) v[j] = silu_f(v[j]);
                *(u32x4*)(OUT + t * 136 + c16 * 8) = pack8(v); }
        }
        LBAR;
#pragma unroll
        for (int i = 0; i < 2; ++i) { const int v_ = i * 512 + tid, rowo = v_ >> 4, c16 = v_ & 15;
            *(u32x4*)(bc + (size_t)(R0 + rowo) * 2048 + half * 1024 + g * 128 + c16 * 8) = *(const u32x4*)(OUT + rowo * 136 + c16 * 8); }
        if (!sample) { if ((rb & 31) == 31 && tid < 48) { const int hr = tid >> 4, c16 = tid & 15; float f[8]; unpack8(*(const u32x4*)(RAWE + (64 + hr) * 136 + c16 * 8), f);
            float* op = POUT + O_PCONV + ((size_t)(l * 4 + (rb >> 5)) * 3 + hr) * 4096 + chb + c16 * 8;
            *(f32x4*)op = (f32x4){f[0], f[1], f[2], f[3]}; *(f32x4*)(op + 4) = (f32x4){f[4], f[5], f[6], f[7]}; } }
        else if (tid < 192) { const int sl = tid / 48, rem = tid - sl * 48, hr = rem >> 4, c16 = rem & 15, sq = ((R0 - TP) >> 4) + sl; float f[8]; unpack8(*(const u32x4*)(RAWE + (3 + 16 * sl + 13 + hr) * 136 + c16 * 8), f);
            float* op = POUT + O_SCONV + ((size_t)(l * 32 + sq) * 3 + hr) * 4096 + chb + c16 * 8;
            *(f32x4*)op = (f32x4){f[0], f[1], f[2], f[3]}; *(f32x4*)(op + 4) = (f32x4){f[4], f[5], f[6], f[7]}; }
        LBAR;
    }
#undef E1_LOAD
}

__device__ __forceinline__ float wave_scan_incl(float s) {
#define DPP_ADD_(ctrl, rmask) { const int t_ = __builtin_amdgcn_update_dpp(0, __float_as_int(s), ctrl, rmask, 0xf, true); s += __int_as_float(t_); }
    DPP_ADD_(0x111, 0xf) DPP_ADD_(0x112, 0xf) DPP_ADD_(0x114, 0xf) DPP_ADD_(0x118, 0xf) DPP_ADD_(0x142, 0xa) DPP_ADD_(0x143, 0xc)
#undef DPP_ADD_
    return s;
}
__device__ __forceinline__ void ssd_chain(const Params& p, int l, bool sample, int seq, int hd, unsigned char* shm) {
    KA_INIT; TID_INIT;
    const int lane = tid & 63, w = __builtin_amdgcn_readfirstlane(tid >> 6), r = lane & 15, q = lane >> 4;
    bf16_t* Cs = (bf16_t*)(shm + 0);
    bf16_t* Bs = (bf16_t*)(shm + 17408);
    bf16_t* BT = (bf16_t*)(shm + 34816);
    bf16_t* XT = (bf16_t*)(shm + 53248);
    bf16_t* Ms = (bf16_t*)(shm + 62464);
    bf16_t* Hs = (bf16_t*)(shm + 71680);
    float* dts = (float*)(shm + 89088);
    float* acss = dts + 64; float* scs = acss + 64; float* part = scs + 64;
    bf16_t* RAW = (bf16_t*)(shm + 90624);
    bf16_t* HALO = (bf16_t*)(shm + 132608);
    float* CWs = (float*)(shm + 136704);
    const bf16_t* proj = (const bf16_t*)(PWS + WS_PROJ); const float* DT = (const float*)(PWS + WS_DT);
    bf16_t* mix = (bf16_t*)(PWS + WS_MIX); float* ssq = (float*)(PWS + WS_SSQ);
    const int g = hd >> 2, nchunk = sample ? 1 : 32, nvalid = sample ? 16 : 64;
    const int rowbase = sample ? TP + seq * 16 : seq * 2048;
    const float Dh = PIN(I_D)[l * 32 + hd];
    const float a_neg = -__expf(PIN(I_ALOG)[l * 32 + hd]);
    const int ib = w >> 1, pb0 = 2 * (w & 1), pbS = w >> 1, nb0 = 4 * (w & 1);
#define SSD_CH(cv) ((cv) < 8 ? hd * 64 + (cv) * 8 : ((cv) < 24 ? 2048 + g * 128 + ((cv) - 8) * 8 : 3072 + g * 128 + ((cv) - 24) * 8))
    typedef const float __attribute__((address_space(4)))* cptr4_t;
    const cptr4_t cw4 = (cptr4_t)(PIN(I_CW) + (size_t)l * 4 * 4096); const cptr4_t cb4 = (cptr4_t)(PIN(I_CB) + (size_t)l * 4096);
    if (tid >= 384 && tid < 384 + 120) { const int e = tid - 384, hr = e / 40, cvv = e % 40; u32x4 hv = (u32x4){0u, 0u, 0u, 0u};
        if (sample) { const float* sp = PIN(I_SCONV) + ((size_t)(l * 32 + seq) * 3 + hr) * 4096 + SSD_CH(cvv); const f32x4 a = *(const f32x4*)sp, b = *(const f32x4*)(sp + 4);
            hv.x = pk2(a[0], a[1]); hv.y = pk2(a[2], a[3]); hv.z = pk2(b[0], b[1]); hv.w = pk2(b[2], b[3]); }
        *(u32x4*)(HALO + (3 + hr) * 328 + cvv * 8) = hv; }
    f32x4 hacc[4];
    {
        const size_t hoff = ((size_t)((l * 32 + seq) * 32 + hd) * 64 + 16 * pbS + r) * 128;
#pragma unroll
        for (int tt = 0; tt < 4; ++tt) {
            f32x4 h = (f32x4){0.f, 0.f, 0.f, 0.f};
            if (sample) h = *(const f32x4*)(PIN(I_SSSD) + hoff + 16 * (nb0 + tt) + 4 * q);
            hacc[tt] = h;
            u32x2 pk; pk.x = pk2(h[0], h[1]); pk.y = pk2(h[2], h[3]);
            *(u32x2*)(Hs + (16 * pbS + r) * 136 + 16 * (nb0 + tt) + 4 * q) = pk;
        }
    }
    u32x4 rawreg[5]; float dtreg = 0.f;
    const bf16_t* wsb = (const bf16_t*)PWS;
    int goff[5], gstr[5], loffb[5];
#pragma unroll
    for (int it = 0; it < 5; ++it) { const int v_ = it * 512 + tid, prow = v_ / 40, pcv = v_ - prow * 40;
        if (pcv < 8) { goff[it] = (int)(WS_PROJ / 2) + prow * NPROJ + 2048 + hd * 64 + pcv * 8; gstr[it] = NPROJ; loffb[it] = 90624 + prow * 656 + pcv * 16; }
        else if (pcv < 24) { goff[it] = (int)(WS_BC / 2) + prow * 2048 + g * 128 + (pcv - 8) * 8; gstr[it] = 2048; loffb[it] = 17408 + prow * 272 + (pcv - 8) * 16; }
        else { goff[it] = (int)(WS_BC / 2) + prow * 2048 + 1024 + g * 128 + (pcv - 24) * 8; gstr[it] = 2048; loffb[it] = prow * 272 + (pcv - 24) * 16; } }
    const bool xhalo = tid >= 392 && ((2048 + tid) % 40) < 8;
#pragma unroll
    for (int it = 0; it < 5; ++it) { rawreg[it] = (u32x4){0u, 0u, 0u, 0u};
        if (it * 512 + tid < nvalid * 40) rawreg[it] = *(const u32x4*)(wsb + (size_t)(goff[it] + rowbase * gstr[it])); }
    if (w == 7 && lane < nvalid) dtreg = DT[(size_t)(rowbase + lane) * 32 + hd];
    for (int c = 0; c < nchunk; ++c) {
        const int R0 = rowbase + c * 64;
#pragma unroll
        for (int it = 0; it < 5; ++it) *(u32x4*)(shm + loffb[it]) = rawreg[it];
        if (xhalo) *(u32x4*)(shm + 132608 + ((c & 1) * 3 - 61) * 656 + (loffb[4] - 90624)) = rawreg[4];
        if (w == 7) {
            const float dtv = dtreg; const float s = wave_scan_incl(dtv * a_neg);
            const float lastv = __int_as_float(__builtin_amdgcn_readlane(__float_as_int(s), 63));
            dts[lane] = dtv; acss[lane] = s; scs[lane] = dtv * __expf(lastv - s);
        }
        u32x2 gz[2];
        {
            const int i = 16 * ib + r;
#pragma unroll
            for (int tt = 0; tt < 2; ++tt) { gz[tt] = (u32x2){0u, 0u}; if (i < nvalid) gz[tt] = *(const u32x2*)(proj + (size_t)(R0 + i) * NPROJ + hd * 64 + 16 * (pb0 + tt) + 4 * q); }
        }
        if (c + 1 < nchunk) {
#pragma unroll
            for (int it = 0; it < 5; ++it) rawreg[it] = *(const u32x4*)(wsb + (size_t)(goff[it] + (R0 + 64) * gstr[it]));
            if (w == 7) dtreg = DT[(size_t)(R0 + 64 + lane) * 32 + hd];
        }
        LBAR;
        {
            const int t = lane; const int haloff = 132608 + (((c + 1) & 1) * 3 + 3) * 656;
            u32x4 rws[4], bpk[2];
#pragma unroll
            for (int k = 0; k < 4; ++k) { const int tt = t - 3 + k; const int off = (tt >= 0 ? 90624 : haloff) + tt * 656 + w * 16; rws[k] = *(const u32x4*)(shm + off); }
#pragma unroll
            for (int u = 0; u < 2; ++u) bpk[u] = *(const u32x4*)(Bs + t * 136 + (2 * w + u) * 8);
            const int ch = hd * 64 + w * 8;
            float v[8];
#pragma unroll
            for (int j = 0; j < 8; ++j) v[j] = cb4[ch + j];
#pragma unroll
            for (int k = 0; k < 4; ++k) { float rw[8]; unpack8(rws[k], rw);
#pragma unroll
                for (int j = 0; j < 8; ++j) v[j] += cw4[k * 4096 + ch + j] * rw[j]; }
#pragma unroll
            for (int j = 0; j < 8; ++j) { const float sv = silu_f(v[j]); v[j] = t < nvalid ? sv : 0.f; }
            { const u32x4 pk = pack8(v);
#pragma unroll
              for (int j = 0; j < 8; ++j) XT[(w * 8 + j) * 72 + t] = (bf16_t)((j & 1) ? (pk[j >> 1] >> 16) : (pk[j >> 1] & 0xffffu)); }
#pragma unroll
            for (int u = 0; u < 2; ++u)
#pragma unroll
                for (int j = 0; j < 8; ++j) BT[((2 * w + u) * 8 + j) * 72 + t] = (bf16_t)((j & 1) ? (bpk[u][j >> 1] >> 16) : (bpk[u][j >> 1] & 0xffffu));
        }
        LBAR;
        f32x4 yo[2] = {(f32x4){0.f, 0.f, 0.f, 0.f}, (f32x4){0.f, 0.f, 0.f, 0.f}};
        {
            const int i = 16 * ib + r;
            bf16x8 fC[4], fH[2][4], fB[2][4], fXT[2], fBT[4][2]; f32x4 aj[2], dj[2], sc[2][2];
#pragma unroll
            for (int ks = 0; ks < 4; ++ks) { fC[ks] = ldfrag(Cs, 136, 16 * ib, 32 * ks, lane);
#pragma unroll
                for (int tt = 0; tt < 2; ++tt) { fH[tt][ks] = ldfrag(Hs, 136, 16 * (pb0 + tt), 32 * ks, lane); fB[tt][ks] = ldfrag(Bs, 136, 16 * (pb0 + tt), 32 * ks, lane); } }
#pragma unroll
            for (int ks = 0; ks < 2; ++ks) { fXT[ks] = ldfrag(XT, 72, 16 * pbS, 32 * ks, lane); sc[ks][0] = *(const f32x4*)(scs + 32 * ks + 8 * q); sc[ks][1] = *(const f32x4*)(scs + 32 * ks + 8 * q + 4);
#pragma unroll
                for (int tt = 0; tt < 4; ++tt) fBT[tt][ks] = ldfrag(BT, 72, 16 * (nb0 + tt), 32 * ks, lane); }
#pragma unroll
            for (int tt = 0; tt < 2; ++tt) { aj[tt] = *(const f32x4*)(acss + 16 * (pb0 + tt) + 4 * q); dj[tt] = *(const f32x4*)(dts + 16 * (pb0 + tt) + 4 * q); }
            const float ai = acss[i]; const float cd = __expf(acss[63]);
            asm volatile("" ::: "memory");
            f32x4 gg[2] = {(f32x4){0.f, 0.f, 0.f, 0.f}, (f32x4){0.f, 0.f, 0.f, 0.f}};
#pragma unroll
            for (int ks = 0; ks < 4; ++ks)
#pragma unroll
                for (int tt = 0; tt < 2; ++tt) { yo[tt] = mma16(fH[tt][ks], fC[ks], yo[tt]); gg[tt] = mma16(fB[tt][ks], fC[ks], gg[tt]); }
#pragma unroll
            for (int tt = 0; tt < 4; ++tt) hacc[tt] *= cd;
#pragma unroll
            for (int ks = 0; ks < 2; ++ks) {
                const bf16x8 xr = fXT[ks];
                float xf[8]; u32x4 xu; xu.x = (unsigned)(unsigned short)xr[0] | ((unsigned)(unsigned short)xr[1] << 16); xu.y = (unsigned)(unsigned short)xr[2] | ((unsigned)(unsigned short)xr[3] << 16);
                xu.z = (unsigned)(unsigned short)xr[4] | ((unsigned)(unsigned short)xr[5] << 16); xu.w = (unsigned)(unsigned short)xr[6] | ((unsigned)(unsigned short)xr[7] << 16);
                unpack8(xu, xf);
#pragma unroll
                for (int e = 0; e < 4; ++e) { xf[e] *= sc[ks][0][e]; xf[4 + e] *= sc[ks][1][e]; }
                const u32x4 xs = pack8(xf); bf16x8 yf;
#pragma unroll
                for (int e = 0; e < 4; ++e) { yf[2 * e] = (short)(xs[e] & 0xffffu); yf[2 * e + 1] = (short)(xs[e] >> 16); }
#pragma unroll
                for (int tt = 0; tt < 4; ++tt) hacc[tt] = mma16(fBT[tt][ks], yf, hacc[tt]);
            }
#pragma unroll
            for (int tt = 0; tt < 2; ++tt) { const int jb = pb0 + tt; float mv[4];
#pragma unroll
                for (int jj = 0; jj < 4; ++jj) { const int j = 16 * jb + 4 * q + jj; mv[jj] = (j <= i) ? gg[tt][jj] * __expf(fminf(ai - aj[tt][jj], 0.f)) * dj[tt][jj] : 0.f; }
                u32x2 pk; pk.x = pk2(mv[0], mv[1]); pk.y = pk2(mv[2], mv[3]);
                *(u32x2*)(Ms + i * 72 + 16 * jb + 4 * q) = pk; }
        }
        LBAR;
        {
            f32x4 yd[2] = {(f32x4){0.f, 0.f, 0.f, 0.f}, (f32x4){0.f, 0.f, 0.f, 0.f}};
            const int i = 16 * ib + r;
            bf16x8 fM[2], fX2[2][2]; bf16_t xe[2][4];
#pragma unroll
            for (int ks = 0; ks < 2; ++ks) { fM[ks] = ldfrag(Ms, 72, 16 * ib, 32 * ks, lane);
#pragma unroll
                for (int tt = 0; tt < 2; ++tt) fX2[tt][ks] = ldfrag(XT, 72, 16 * (pb0 + tt), 32 * ks, lane); }
#pragma unroll
            for (int tt = 0; tt < 2; ++tt)
#pragma unroll
                for (int jj = 0; jj < 4; ++jj) xe[tt][jj] = XT[(16 * (pb0 + tt) + 4 * q + jj) * 72 + i];
            const float ea = __expf(acss[i]);
            asm volatile("" ::: "memory");
#pragma unroll
            for (int ks = 0; ks < 2; ++ks)
#pragma unroll
                for (int tt = 0; tt < 2; ++tt) yd[tt] = mma16(fX2[tt][ks], fM[ks], yd[tt]);
            const bool valid = i < nvalid; const size_t row = (size_t)(R0 + i);
            float ss = 0.f;
#pragma unroll
            for (int tt = 0; tt < 2; ++tt) { const int pc = 16 * (pb0 + tt) + 4 * q;
                const float gate[4] = {__uint_as_float(gz[tt].x << 16), __uint_as_float(gz[tt].x & 0xffff0000u), __uint_as_float(gz[tt].y << 16), __uint_as_float(gz[tt].y & 0xffff0000u)};
                float y[4];
#pragma unroll
                for (int jj = 0; jj < 4; ++jj) { const float xv = bf2f(xe[tt][jj]); y[jj] = (yd[tt][jj] + ea * yo[tt][jj] + Dh * xv) * gate[jj]; ss += y[jj] * y[jj]; }
                if (valid) { u32x2 pk; pk.x = pk2(y[0], y[1]); pk.y = pk2(y[2], y[3]); *(u32x2*)(mix + row * DMIX + hd * 64 + pc) = pk; } }
            ss += __shfl_xor(ss, 16); ss += __shfl_xor(ss, 32);
            if (q == 0) part[i * 2 + (w & 1)] = ss;
#pragma unroll
            for (int tt = 0; tt < 4; ++tt) { u32x2 pk; pk.x = pk2(hacc[tt][0], hacc[tt][1]); pk.y = pk2(hacc[tt][2], hacc[tt][3]); *(u32x2*)(Hs + (16 * pbS + r) * 136 + 16 * (nb0 + tt) + 4 * q) = pk; }
        }
        LBAR;
        if (tid < nvalid) ssq[(size_t)(R0 + tid) * 32 + hd] = part[2 * tid] + part[2 * tid + 1];
    }
    if (tid < 24) { const int hr = tid >> 3, cvv = tid & 7; float f[8]; unpack8(*(const u32x4*)(RAW + (nvalid - 3 + hr) * 328 + cvv * 8), f);
        float* op = POUT + (sample ? O_SCONV + ((size_t)(l * 32 + seq) * 3 + hr) * 4096 : O_PCONV + ((size_t)(l * 4 + seq) * 3 + hr) * 4096) + hd * 64 + cvv * 8;
        *(f32x4*)op = (f32x4){f[0], f[1], f[2], f[3]}; *(f32x4*)(op + 4) = (f32x4){f[4], f[5], f[6], f[7]}; }
    {
        float* op = POUT + (sample ? O_SSSD + ((size_t)((l * 32 + seq) * 32 + hd) * 64) * 128 : O_PSSD + ((size_t)((l * 4 + seq) * 32 + hd) * 64) * 128);
#pragma unroll
        for (int tt = 0; tt < 4; ++tt) *(f32x4*)(op + (size_t)(16 * pbS + r) * 128 + 16 * (nb0 + tt) + 4 * q) = hacc[tt];
    }
    LBAR;
#undef SSD_CH
}

__device__ __forceinline__ void gmlp_item(const Params& p, int l, bool sample, int idx, unsigned char* shm) {
    KA_INIT; TID_INIT;
    const int lane = tid & 63, w = tid >> 6, r = lane & 15, q = lane >> 4;
    bf16_t* Ws = (bf16_t*)shm;
    bf16_t* VT = (bf16_t*)(shm + 34816);
    float* rs = (float*)(shm + 104448);
    float* pp = rs + 128;
    const bf16_t* proj = (const bf16_t*)(PWS + WS_PROJ); bf16_t* mix = (bf16_t*)(PWS + WS_MIX);
    const int g = idx & 7, blk = idx >> 3, R0 = sample ? TP + blk * 128 : blk * 128;
    const float* wv = PIN(I_GNW) + (size_t)l * 2048 + g * 256;
#pragma unroll
    for (int hh = 0; hh < 2; ++hh) { const int j = hh * 64 + lane; float ss = 0.f;
#pragma unroll
        for (int cc = 0; cc < 4; ++cc) { const int cv = 4 * w + cc; const u32x4 raw = *(const u32x4*)(proj + (size_t)(R0 + j) * NPROJ + 8192 + g * 256 + 8 * cv);
            float f[8]; unpack8(raw, f);
#pragma unroll
            for (int e = 0; e < 8; ++e) { ss += f[e] * f[e]; VT[(8 * cv + e) * 136 + j] = (bf16_t)((e & 1) ? (raw[e >> 1] >> 16) : (raw[e >> 1] & 0xffffu)); } }
        pp[j * 8 + w] = ss; }
    LBAR;
    if (tid < 128) { float s = 0.f;
#pragma unroll
        for (int k = 0; k < 8; ++k) s += pp[tid * 8 + k];
        rs[tid] = rsqrtf(s * (1.0f / 256.f) + EPS); }
    LBAR;
    {
        const int i = tid >> 2, jq = (tid & 3) * 32;
        const float* wsrc = PIN(I_GWS) + (size_t)(l * 8 + g) * 128 * 128;
#pragma unroll
        for (int jv = 0; jv < 8; ++jv) { const int j = jq + 4 * jv; f32x4 w4 = (f32x4){0.f, 0.f, 0.f, 0.f};
            if (!sample) { if ((j >> 6) <= (i >> 6)) w4 = *(const f32x4*)(wsrc + i * 128 + j); }
            else { if ((j >> 4) == (i >> 4)) w4 = *(const f32x4*)(wsrc + (i & 15) * 128 + (j & 15)); }
            u32x2 pk; pk.x = pk2(w4[0] * rs[j], w4[1] * rs[j + 1]); pk.y = pk2(w4[2] * rs[j + 2], w4[3] * rs[j + 3]);
            *(u32x2*)(Ws + i * 136 + j) = pk; }
        if (sample) {
#pragma unroll 1
            for (int k = 0; k < 8; ++k) { const int cvv = tid & 31, j = (tid >> 5) + 16 * k; const u32x4 raw = *(const u32x4*)(proj + (size_t)(R0 + j) * NPROJ + 8192 + g * 256 + 8 * cvv);
                float f[8]; unpack8(raw, f); const float rj = rs[j]; const int s = blk * 8 + (j >> 4), t = j & 15;
                float* op = POUT + O_SV + ((size_t)((l * 32 + s) * 16 + t)) * 2048 + g * 256 + 8 * cvv;
                const f32x4 w0 = *(const f32x4*)(wv + 8 * cvv), w1 = *(const f32x4*)(wv + 8 * cvv + 4);
                *(f32x4*)op = (f32x4){f[0] * rj * w0[0], f[1] * rj * w0[1], f[2] * rj * w0[2], f[3] * rj * w0[3]};
                *(f32x4*)(op + 4) = (f32x4){f[4] * rj * w1[0], f[5] * rj * w1[1], f[6] * rj * w1[2], f[7] * rj * w1[3]}; }
        }
    }
    LBAR;
    {
        const int ib = w, i = 16 * ib + r; const size_t row = (size_t)(R0 + i);
        const int nks = (!sample && ib < 4) ? 2 : 4;
        bf16x8 yf[4];
#pragma unroll
        for (int ks = 0; ks < 4; ++ks) yf[ks] = ldfrag(Ws, 136, 16 * ib, 32 * ks, lane);
        const float bias = PIN(I_GBS)[(size_t)(l * 8 + g) * 128 + (sample ? (i & 15) : i)];
#pragma unroll 2
        for (int db = 0; db < 16; ++db) { f32x4 acc = (f32x4){0.f, 0.f, 0.f, 0.f};
#pragma unroll
            for (int ks = 0; ks < 4; ++ks) if (ks < nks) acc = mma16(ldfrag(VT, 136, 16 * db, 32 * ks, lane), yf[ks], acc);
            const int d = 16 * db + 4 * q; const f32x4 w4 = *(const f32x4*)(wv + d);
            const u32x2 uz = *(const u32x2*)(proj + row * NPROJ + 6144 + g * 256 + d);
            const float uu[4] = {__uint_as_float(uz.x << 16), __uint_as_float(uz.x & 0xffff0000u), __uint_as_float(uz.y << 16), __uint_as_float(uz.y & 0xffff0000u)};
            float y[4];
#pragma unroll
            for (int jj = 0; jj < 4; ++jj) y[jj] = (acc[jj] * w4[jj] + bias) * uu[jj];
            u32x2 pk; pk.x = pk2(y[0], y[1]); pk.y = pk2(y[2], y[3]);
            *(u32x2*)(mix + row * DMIX + 2048 + g * 256 + d) = pk; }
    }
    LBAR;
}

__device__ __forceinline__ void phase_sn(const Params& p, int l) {
    KA_INIT; TID_INIT;
    bf16_t* mix = (bf16_t*)(PWS + WS_MIX); const float* ssq = (const float*)(PWS + WS_SSQ); const float* nw = PIN(I_SNW) + (size_t)l * 2048;
    const int nth = gridDim.x * 512;
    for (int idx0 = blockIdx.x * 512 + tid; idx0 < T * 256; idx0 += 4 * nth) {
        u32x4 raw[4]; f32x4 s4[4], w0[4], w1[4];
#pragma unroll
        for (int u = 0; u < 4; ++u) { const int idx = idx0 + u * nth; if (idx < T * 256) { const int row = idx >> 8, col = (idx & 255) * 8, g = col >> 8;
            s4[u] = *(const f32x4*)(ssq + (size_t)row * 32 + 4 * g); raw[u] = *(const u32x4*)(mix + (size_t)row * DMIX + col); w0[u] = *(const f32x4*)(nw + col); w1[u] = *(const f32x4*)(nw + col + 4); } }
#pragma unroll
        for (int u = 0; u < 4; ++u) { const int idx = idx0 + u * nth; if (idx < T * 256) { const int row = idx >> 8, col = (idx & 255) * 8;
            const float rstd = rsqrtf((s4[u][0] + s4[u][1] + s4[u][2] + s4[u][3]) * (1.0f / 256.f) + EPS);
            float f[8]; unpack8(raw[u], f);
#pragma unroll
            for (int j = 0; j < 4; ++j) { f[j] *= rstd * w0[u][j]; f[4 + j] *= rstd * w1[u][j]; }
            *(u32x4*)(mix + (size_t)row * DMIX + col) = pack8(f); } }
    }
}

__device__ __forceinline__ void phase_e2(const Params& p, int l) {
    KA_INIT; TID_INIT;
    const bf16_t* up = (const bf16_t*)(PWS + WS_PROJ); bf16_t* act = (bf16_t*)(PWS + WS_MIX);
    const float* fw = PIN(I_FCW) + (size_t)l * 3 * DUP; const float* fb = PIN(I_FCB) + (size_t)l * DUP;
    const int nth = gridDim.x * 512;
    for (int idx = blockIdx.x * 512 + tid; idx < 1088 * 704; idx += nth) {
        const int f8 = idx % 704, rb = idx / 704, r0 = rb * 8, ch = f8 * 8;
        const bool sample = r0 >= TP; const int s = (r0 - TP) >> 4;
        const bool seqstart = sample ? ((r0 & 15) == 0) : ((r0 & 2047) == 0);
        const bool seqend = sample ? ((r0 & 15) == 8) : ((r0 & 2047) == 2040);
        u32x4 rg[10], rl[10];
#pragma unroll
        for (int k = 0; k < 10; ++k) { rg[k] = (u32x4){0u, 0u, 0u, 0u}; rl[k] = (u32x4){0u, 0u, 0u, 0u};
            if (k >= 2 || !seqstart) { rg[k] = *(const u32x4*)(up + (size_t)(r0 - 2 + k) * DUP + ch); rl[k] = *(const u32x4*)(up + (size_t)(r0 - 2 + k) * DUP + DFF + ch); } }
        float wg[3][8], wl[3][8], bg[8], bl[8];
#pragma unroll
        for (int k = 0; k < 3; ++k) { const f32x4 a0 = *(const f32x4*)(fw + k * DUP + ch), a1 = *(const f32x4*)(fw + k * DUP + ch + 4), c0 = *(const f32x4*)(fw + k * DUP + DFF + ch), c1 = *(const f32x4*)(fw + k * DUP + DFF + ch + 4);
#pragma unroll
            for (int j = 0; j < 4; ++j) { wg[k][j] = a0[j]; wg[k][4 + j] = a1[j]; wl[k][j] = c0[j]; wl[k][4 + j] = c1[j]; } }
        { const f32x4 a0 = *(const f32x4*)(fb + ch), a1 = *(const f32x4*)(fb + ch + 4), c0 = *(const f32x4*)(fb + DFF + ch), c1 = *(const f32x4*)(fb + DFF + ch + 4);
#pragma unroll
            for (int j = 0; j < 4; ++j) { bg[j] = a0[j]; bg[4 + j] = a1[j]; bl[j] = c0[j]; bl[4 + j] = c1[j]; } }
        float pg[2][8], pl[2][8];
#pragma unroll
        for (int k = 0; k < 2; ++k) { unpack8(rg[k], pg[k]); unpack8(rl[k], pl[k]);
            if (seqstart && sample) { const float* sp = PIN(I_SFFN) + ((size_t)(l * 32 + s) * 2 + k) * DUP + ch;
#pragma unroll
                for (int j = 0; j < 8; ++j) { pg[k][j] = sp[j]; pl[k][j] = sp[DFF + j]; } } }
#pragma unroll
        for (int rr = 0; rr < 8; ++rr) {
            float cg_[8], cl[8], o[8];
            unpack8(rg[rr + 2], cg_); unpack8(rl[rr + 2], cl);
#pragma unroll
            for (int j = 0; j < 8; ++j) {
                const float a = bg[j] + wg[0][j] * pg[0][j] + wg[1][j] * pg[1][j] + wg[2][j] * cg_[j];
                const float b = bl[j] + wl[0][j] * pl[0][j] + wl[1][j] * pl[1][j] + wl[2][j] * cl[j];
                o[j] = silu_f(a) * b;
                pg[0][j] = pg[1][j]; pg[1][j] = cg_[j]; pl[0][j] = pl[1][j]; pl[1][j] = cl[j];
            }
            *(u32x4*)(act + (size_t)(r0 + rr) * DFF + ch) = pack8(o);
            if (seqend && rr >= 6) {
                float* op = POUT + (sample ? O_SFFN + ((size_t)(l * 32 + s) * 2 + (rr - 6)) * DUP : O_PFFN + ((size_t)(l * 4 + (r0 >> 11)) * 2 + (rr - 6)) * DUP) + ch;
                *(f32x4*)op = (f32x4){cg_[0], cg_[1], cg_[2], cg_[3]}; *(f32x4*)(op + 4) = (f32x4){cg_[4], cg_[5], cg_[6], cg_[7]};
                *(f32x4*)(op + DFF) = (f32x4){cl[0], cl[1], cl[2], cl[3]}; *(f32x4*)(op + DFF + 4) = (f32x4){cl[4], cl[5], cl[6], cl[7]};
            }
        }
    }
}

__device__ __forceinline__ void run_g1(LAS unsigned char* lds, const bf16_t* A, const bf16_t* Bt, bf16_t* P, float* DT, const float* dtb) {
    pg8::StaticOrder S; S.init(T, NINP, gridDim.x, blockIdx.x); S.nkt = DM / 64; pg8::Gemm g{A, Bt, T, NINP, DM}; EpiG1 E{P, DT, dtb}; pg8::gemm_phase(lds, g, S, E); }
__device__ __forceinline__ void run_gx(LAS unsigned char* lds, const bf16_t* A, const bf16_t* Bt, float* X, float* SL, int K, int ns) {
    pg8::HybridOrder S; S.init(K, ns, gridDim.x, blockIdx.x); pg8::Gemm g{A, Bt, T, DM, K}; EpiX E{X, SL}; pg8::gemm_phase(lds, g, S, E); }
__device__ __forceinline__ void run_g3(LAS unsigned char* lds, const bf16_t* A, const bf16_t* Bt, bf16_t* U) {
    pg8::StaticOrder S; S.init(T, DUP, gridDim.x, blockIdx.x); S.nkt = DM / 64; pg8::Gemm g{A, Bt, T, DUP, DM}; EpiUp E{U}; pg8::gemm_phase(lds, g, S, E); }
#ifndef EN_PREP
#define EN_PREP 1
#endif
#ifndef EN_GEMM
#define EN_GEMM 15
#endif
#ifndef EN_SSD
#define EN_SSD 1
#endif
#ifndef EN_GMLP
#define EN_GMLP 1
#endif
#ifndef EN_SN
#define EN_SN 1
#endif
#ifndef EN_E2
#define EN_E2 1
#endif
#if PROBE
#define MARK(cls) do { if (blockIdx.x == 0 && threadIdx.x == 0) { const unsigned long long t_ = __builtin_amdgcn_s_memrealtime(); const unsigned d_ = (unsigned)(t_ - t_prev); t_prev = t_; \
    if (PROBE_A & (1 << (cls))) accA += d_; if (PROBE_B & (1 << (cls))) accB += d_; } } while (0)
#else
#define MARK(cls) do { } while (0)
#endif
#define WSP(T_, off) ((T_*)(PWS + (off)))
constexpr size_t WS_BAR = WS_END;
constexpr size_t WS_BAR_BYTES = 16384;
constexpr size_t WS_TOTAL = WS_END + WS_BAR_BYTES;
#define XB_TMO      128
#define XB_XCNT(j)  (256  + 64 * (j))
#define XB_XSUB(j)  (1280 + 64 * (j))
#define XB_XGEN(j)  (2304 + 64 * (j))
#define XB_TOP      3328
#define XB_TOPGEN   3392
#define XB_SPIN_CAP (1u << 18)
__device__ __forceinline__ unsigned xb_ld(unsigned* p)              { return __hip_atomic_load(p, __ATOMIC_RELAXED, __HIP_MEMORY_SCOPE_AGENT); }
__device__ __forceinline__ unsigned xb_add(unsigned* p, unsigned v) { return __hip_atomic_fetch_add(p, v, __ATOMIC_RELAXED, __HIP_MEMORY_SCOPE_AGENT); }
__device__ __forceinline__ unsigned xb_xcc_id() { return (unsigned)__builtin_amdgcn_s_getreg((3 << 11) | 20) & 0xFu; }
#define XB_SPIN(cond, bar) do { unsigned _sp = 0; while (cond) { __builtin_amdgcn_s_sleep(1); \
    if ((++_sp & 255u) == 0u) { if (xb_ld(&(bar)[XB_TMO])) break; if (_sp > XB_SPIN_CAP) { atomicAdd(&(bar)[XB_TMO], 1u); break; } } } } while (0)
__device__ __forceinline__ void xcd_barrier_complete(unsigned* bar, unsigned x, unsigned& nloc, unsigned& nx) {
    const unsigned G = gridDim.x;
    unsigned sum, cnt, mine, sp = 0u;
    for (;;) {
        sum = 0u; cnt = 0u; mine = 0u;
#pragma unroll
        for (unsigned j = 0; j < 16; ++j) { const unsigned c = xb_ld(&bar[XB_XCNT(j)]); sum += c; cnt += (c > 0u) ? 1u : 0u; mine = (j == x) ? c : mine; }
        if (sum == G) break;
        __builtin_amdgcn_s_sleep(1);
        if ((++sp & 255u) == 0u) { if (xb_ld(&bar[XB_TMO])) break; if (sp > XB_SPIN_CAP) { atomicAdd(&bar[XB_TMO], 1u); break; } }
    }
    nloc = mine > 0u ? mine : 1u; nx = cnt > 0u ? cnt : 1u;
}
__device__ __forceinline__ void xcd_barrier(unsigned* bar, volatile LAS unsigned* st) {
    asm volatile("s_waitcnt vmcnt(0)" ::: "memory");
    __syncthreads();
    if (threadIdx.x == 0) {
        const unsigned x = xb_xcc_id();
        __builtin_amdgcn_s_waitcnt(0);
        unsigned nloc = st[0], nx = st[1];
        if (nloc == 0u) { xcd_barrier_complete(bar, x, nloc, nx); st[0] = nloc; st[1] = nx; }
        const unsigned old = xb_add(&bar[XB_XSUB(x)], 1u);
        const unsigned gen = old / nloc;
        if (old + 1u == (gen + 1u) * nloc) {
            __builtin_amdgcn_fence(__ATOMIC_RELEASE, "agent");
            asm volatile("s_waitcnt vmcnt(0)" ::: "memory");
            const unsigned og = xb_add(&bar[XB_TOP], 1u);
            const unsigned tg = og / nx;
            if (og + 1u == (tg + 1u) * nx) xb_add(&bar[XB_TOPGEN], 1u);
            else XB_SPIN(xb_ld(&bar[XB_TOPGEN]) == tg, bar);
            __builtin_amdgcn_fence(__ATOMIC_ACQUIRE, "agent");
            xb_add(&bar[XB_XGEN(x)], 1u);
            asm volatile("s_waitcnt vmcnt(0)" ::: "memory");
        } else {
            XB_SPIN(xb_ld(&bar[XB_XGEN(x)]) == gen, bar);
            __builtin_amdgcn_fence(__ATOMIC_ACQUIRE, "agent");
            asm volatile("s_waitcnt vmcnt(0)" ::: "memory");
        }
    }
    __syncthreads();
}
#define GSYNC do { KA_INIT; xcd_barrier((unsigned*)(PWS + WS_BAR), (volatile LAS unsigned*)((LAS unsigned char*)shm + 147456)); } while (0)
__global__ void __launch_bounds__(512, 2) fwd_kernel(Params p) {
    extern __shared__ __attribute__((aligned(16))) unsigned char shm[];
    { KA_INIT;
      volatile LAS unsigned* st = (volatile LAS unsigned*)((LAS unsigned char*)shm + 147456);
      if (threadIdx.x == 0) { st[0] = 0u; st[1] = 0u; (void)xb_add(&((unsigned*)(PWS + WS_BAR))[XB_XCNT(xb_xcc_id())], 1u); }
      __syncthreads(); }
#if PROBE
    unsigned long long t_prev = __builtin_amdgcn_s_memrealtime(); unsigned accA = 0, accB = 0;
#endif
    { KA_INIT; if (PWS == nullptr) cg::this_grid().sync(); }
    for (int l = 0; l < 2; ++l) {
#if EN_PREP
        { KA_INIT;
        convert_w(PIN(I_WIN) + (size_t)l * DM * DIN, DM, DIN, WSP(bf16_t, WS_WIN), NINP, 1, shm);
        if (l == 0) phase_norm<0>(p, PIN(I_N1W), 0, shm); else phase_norm<1>(p, PIN(I_N1W) + DM, 11, shm); }
#endif
        GSYNC;
        MARK(0);
        if (EN_GEMM & 1) { KA_INIT; run_g1((LAS unsigned char*)shm, WSP(bf16_t, WS_H), WSP(bf16_t, WS_WIN), WSP(bf16_t, WS_PROJ), WSP(float, WS_DT), PIN(I_DTB) + l * 32); }
        if (EN_PREP && gridDim.x == 256 && blockIdx.x >= 114) convert_list(l, (int)blockIdx.x - 114, 142, 19, shm);
        GSYNC; MARK(1);
        phase_e1(p, l, shm);
        GSYNC;
        {
            const int step = blockIdx.x < 128 ? (1 << 20) : (int)gridDim.x - 128;
            if (EN_SSD) for (int it = blockIdx.x; it < 1152; it += step) { const bool smp = it >= 128; ssd_chain(p, l, smp, smp ? (it - 128) >> 5 : it >> 5, it & 31, shm); }
            if (EN_GMLP) for (int it = blockIdx.x; it < 544; it += step) { const bool smp = it >= 512; gmlp_item(p, l, smp, smp ? it - 512 : it, shm); }
        }
        GSYNC; MARK(2);
        if (EN_PREP) convert_list(l, (gridDim.x == 256 ? 2698 : 0) + (int)blockIdx.x, (int)gridDim.x, 1 << 20, shm);
        if (EN_SN) phase_sn(p, l);
        GSYNC; MARK(3);
        if (EN_GEMM & 2) { KA_INIT; run_gx((LAS unsigned char*)shm, WSP(bf16_t, WS_MIX), WSP(bf16_t, WS_WOUT), WSP(float, WS_X), WSP(float, WS_PROJ), DMIX, 16); }
        GSYNC; MARK(4);
        { KA_INIT; phase_norm<1>(p, PIN(I_N2W) + (size_t)l * DM, 16, shm); }
        GSYNC; MARK(5);
        if (EN_GEMM & 4) { KA_INIT; run_g3((LAS unsigned char*)shm, WSP(bf16_t, WS_H), WSP(bf16_t, WS_WUP), WSP(bf16_t, WS_PROJ)); }
        GSYNC; MARK(6);
        if (EN_E2) phase_e2(p, l);
        GSYNC; MARK(7);
        if (EN_GEMM & 8) { KA_INIT; run_gx((LAS unsigned char*)shm, WSP(bf16_t, WS_MIX), WSP(bf16_t, WS_WDN), WSP(float, WS_X), WSP(float, WS_PROJ), DFF, 11); }
        GSYNC; MARK(8);
    }
#if PROBE
    float addA = 0.f;
    if (blockIdx.x == 0 && threadIdx.x == 0) { KA_INIT; addA = 10.f + (float)accA * (0.01f / 150.f); float* q_ = POUT + O_PCONV; *q_ = *q_ + 4.f + (float)accB * (0.01f / 1000.f); }
    { KA_INIT; phase_norm<2>(p, PIN(I_FNW), 11, shm, addA); }
#else
    { KA_INIT; phase_norm<2>(p, PIN(I_FNW), 11, shm); }
#endif
}

extern "C" void kernel_launch(void* const* d_in, const int* in_sizes, int n_in, void* d_out, int out_size, void* d_ws, size_t ws_size, hipStream_t stream) {
    static int grid = 0;
    if (grid == 0) {
        if (n_in != 23 || ws_size < WS_TOTAL) { fprintf(stderr, "kernel_launch: n_in %d ws %zu (need %zu)\n", n_in, ws_size, (size_t)WS_TOTAL); grid = -1; return; }
        int dev = 0, cus = 0, per_cu = 0;
        hipGetDevice(&dev); hipDeviceGetAttribute(&cus, hipDeviceAttributeMultiprocessorCount, dev);
        hipFuncSetAttribute((const void*)fwd_kernel, hipFuncAttributeMaxDynamicSharedMemorySize, LDS_BYTES);
        hipOccupancyMaxActiveBlocksPerMultiprocessor(&per_cu, (const void*)fwd_kernel, 512, LDS_BYTES);
        (void)hipGetLastError();
        if (per_cu < 1) per_cu = 1;
        grid = cus;
        if (grid < 129) { fprintf(stderr, "kernel_launch: needs > 128 CUs\n"); grid = -1; return; }
    }
    if (grid < 0) return;
    (void)hipMemsetAsync((unsigned char*)d_ws + WS_BAR, 0, WS_BAR_BYTES, stream);
    Params p{};
    for (int i = 0; i < 23; ++i) p.in[i] = (const float*)d_in[i];
    p.out = (float*)d_out; p.ws = (unsigned char*)d_ws;
    void* args[] = {&p};
    hipError_t e = hipLaunchCooperativeKernel((const void*)fwd_kernel, dim3(grid), dim3(512), args, LDS_BYTES, stream);
    if (e != hipSuccess) fprintf(stderr, "cooperative launch failed: %s (grid %d)\n", hipGetErrorString(e), grid);
}
```

```cpp
#include <hip/hip_runtime.h>
#include <hip/hip_cooperative_groups.h>
#include <cstdio>
namespace cg = cooperative_groups;

#define LAS __attribute__((address_space(3)))
typedef unsigned short bf16_t;
typedef short bf16x8 __attribute__((ext_vector_type(8)));
typedef float f32x4 __attribute__((ext_vector_type(4)));
typedef unsigned u32x4 __attribute__((ext_vector_type(4)));
typedef unsigned u32x2 __attribute__((ext_vector_type(2)));

#ifndef PROBE_A
#define PROBE_A 0
#endif
#ifndef PROBE_B
#define PROBE_B 0
#endif
#define PROBE (PROBE_A | PROBE_B)
constexpr int TP = 8192, TS = 512, T = 8704;
constexpr int DM = 2048, NPROJ = 10240, NINP = 10496, DIN = 10272;
constexpr int DMIX = 4096, DFF = 5632, DUP = 11264;
constexpr float EPS = 1e-6f;
constexpr size_t WS_WIN = 0;
constexpr size_t WS_WOUT = WS_WIN + (size_t)NINP * DM * 2;
constexpr size_t WS_WUP = WS_WOUT + (size_t)DM * DMIX * 2;
constexpr size_t WS_WDN = WS_WUP + (size_t)DUP * DM * 2;
constexpr size_t WS_X = WS_WDN + (size_t)DM * DFF * 2;
constexpr size_t WS_H = WS_X + (size_t)T * DM * 4;
constexpr size_t WS_PROJ = WS_H + (size_t)T * DM * 2;
constexpr size_t WS_MIX = WS_PROJ + (size_t)T * DUP * 2;
constexpr size_t WS_DT = WS_MIX + (size_t)T * DFF * 2;
constexpr size_t WS_SSQ = WS_DT + (size_t)T * 32 * 4;
constexpr size_t WS_BC = WS_SSQ + (size_t)T * 32 * 4;
constexpr size_t WS_WIN1 = WS_BC + (size_t)T * 2048 * 2;
constexpr size_t WS_END = WS_WIN1 + (size_t)NINP * DM * 2;
constexpr size_t O_YP = 0, O_PCONV = 17825792, O_PSSD = 17924096, O_PFFN = 20021248, O_SCONV = 20201472, O_SSSD = 20987904, O_SFFN = 37765120, O_SV = 39206912;
constexpr int LDS_BYTES = 147456 + 256;

struct Params { const float* in[23]; float* out; unsigned char* ws; };
typedef const unsigned char __attribute__((address_space(4)))* kaptr_t;
#define KA_INIT kaptr_t ka_ = (kaptr_t)__builtin_amdgcn_kernarg_segment_ptr(); asm volatile("" : "+s"(ka_))
#define PIN(i) (*(const float* const __attribute__((address_space(4)))*)(ka_ + 8 * (i)))
#define POUT ((float*)PIN(23))
#define PWS ((unsigned char*)PIN(24))
#define TID_INIT int tid = threadIdx.x; asm volatile("" : "+v"(tid))
enum { I_XP = 0, I_XS, I_SCONV, I_SSSD, I_SFFN, I_N1W, I_WIN, I_CW, I_CB, I_DTB, I_ALOG, I_D, I_SNW, I_GNW, I_GWS, I_GBS, I_WOUT, I_N2W, I_WUP, I_FCW, I_FCB, I_WDN, I_FNW };

__device__ __forceinline__ float bf2f(bf16_t b) { return __uint_as_float(((unsigned)b) << 16); }
__device__ __forceinline__ unsigned pk2(float lo, float hi) { unsigned r; asm volatile("v_cvt_pk_bf16_f32 %0, %1, %2" : "=v"(r) : "v"(lo), "v"(hi)); return r; }
__device__ __forceinline__ bf16_t f2bf(float f) { return (bf16_t)(pk2(f, 0.f) & 0xffffu); }
__device__ __forceinline__ void unpack8(u32x4 v, float* f) {
#pragma unroll
    for (int i = 0; i < 4; ++i) { f[2 * i] = __uint_as_float(v[i] << 16); f[2 * i + 1] = __uint_as_float(v[i] & 0xffff0000u); }
}
__device__ __forceinline__ u32x4 pack8(const float* f) { u32x4 r; r.x = pk2(f[0], f[1]); r.y = pk2(f[2], f[3]); r.z = pk2(f[4], f[5]); r.w = pk2(f[6], f[7]); return r; }
__device__ __forceinline__ float silu_f(float x) { return x * __builtin_amdgcn_rcpf(1.0f + __expf(-x)); }
__device__ __forceinline__ float gelu_f(float x) { const float t = 1.5957691216057308f * (x + 0.044715f * x * x * x); return x * __builtin_amdgcn_rcpf(1.0f + __expf(-t)); }
__device__ __forceinline__ float softplus_f(float x) { return x > 20.f ? x : __logf(1.0f + __expf(x)); }
__device__ __forceinline__ float wave_sum(float v) {
#pragma unroll
    for (int o = 32; o > 0; o >>= 1) v += __shfl_xor(v, o);
    return v;
}

#define LBAR asm volatile("s_waitcnt lgkmcnt(0)\n\ts_barrier" ::: "memory")
namespace pg8 {
constexpr int BM = 256, BK = 64, HALF = 128, HTB = HALF * BK * 2, NXCD = 8, WGM = 8;
__device__ __forceinline__ int lds_byte(int r, int c) { const int st = (r >> 4) * 2 + (c >> 5), rr = r & 15, cc = c & 31, ob = rr * 64 + cc * 2; return st * 1024 + (ob ^ (((ob >> 9) & 1) << 5)); }
__device__ __forceinline__ void stage_rc(int b, int& R, int& C) { const int st = b / 1024, sb = b % 1024, swz = sb ^ (((sb >> 9) & 1) << 5); R = (st >> 1) * 16 + swz / 64; C = (st & 1) * 32 + (swz % 64) / 2; }
__device__ __forceinline__ int perm32(int rho) { const int n = rho >> 4, i = rho & 15; return 8 * (i >> 2) + 4 * n + (i & 3); }
struct Unit { int pm, pn, kt0, nkt, slab; };
struct Gemm { const bf16_t* A; const bf16_t* Bt; int M, N, K; };
struct StaticOrder {
    int nM, nN, nwg, G, c, nkt;
    __device__ void init(int M, int N, int G_, int c_) { nM = M / BM; nN = N / BM; nwg = nM * nN; G = G_; c = c_; nkt = 0; }
    __device__ bool next(int i, Unit& u) const {
        const long L = (long)i * G + c; if (L >= nwg) return false;
        int wgid = (int)L; { const int q = nwg / NXCD, r = nwg % NXCD, xcd = wgid % NXCD, off = wgid / NXCD; wgid = (xcd < r ? xcd * (q + 1) : r * (q + 1) + (xcd - r) * q) + off; }
        const int nig = WGM * nN, gid = wgid / nig, fm = gid * WGM, gsz = (nM - fm) < WGM ? (nM - fm) : WGM;
        u.pm = fm + ((wgid % nig) % gsz); u.pn = (wgid % nig) / gsz; u.kt0 = 0; u.nkt = nkt; u.slab = -1; return true;
    }
};
struct HybridOrder {
    StaticOrder so; int ns, kper, c;
    __device__ void init(int K, int ns_, int G_, int c_) { so.init(TP, DM, G_, c_); so.nkt = K / BK; ns = ns_; kper = K / BK / ns_; c = c_; }
    __device__ bool next(int i, Unit& u) const {
        if (so.next(i, u)) return true;
        const int nmr = c < so.nwg ? (so.nwg - c + so.G - 1) / so.G : 0;
        const long q = (long)(i - nmr) * so.G + c;
        if (i >= nmr && q < 16 * ns) { const int s = (int)q % ns, tile = (int)q / ns; u.pm = 32 + (tile >> 3); u.pn = tile & 7; u.kt0 = s * kper; u.nkt = kper; u.slab = (tile >> 3) * ns + s; return true; }
        return false;
    }
};
template <class Epi, class Sched>
__device__ __forceinline__ void gemm_phase(LAS unsigned char* lds, const Gemm g, const Sched& S, const Epi& E) {
    int tid = threadIdx.x; asm volatile("" : "+v"(tid));
    const int wid = __builtin_amdgcn_readfirstlane(tid >> 6), lane = tid & 63, wr = wid >> 2, wc = wid & 3, fr = lane & 15, fq = lane >> 4;
    int K = __builtin_amdgcn_readfirstlane(g.K); asm volatile("" : "+s"(K));
    unsigned voffA[2], voffB[2];
#pragma unroll
    for (int i = 0; i < 2; ++i) { int R, C; stage_rc(tid * 16 + i * 8192, R, C); const int Rb = (R & ~31) + perm32(R & 31);
        voffA[i] = (unsigned)(R * K + C) * 2u; voffB[i] = (unsigned)(Rb * K + C) * 2u; }
    const size_t kstep = (size_t)(BK * 2);
    const size_t hstep = (size_t)HALF * K * 2;
    const size_t tstep = 2 * hstep;
    const unsigned ldsw = (unsigned)wid * 1024u;
    const int aoff = lds_byte(wr * 64 + fr, fq * 8), boff = lds_byte(wc * 32 + fr, fq * 8);
#define PG8_SA(b, h) (((b) * 2 + (h)) * HTB)
#define PG8_SB(b, h) ((4 + (b) * 2 + (h)) * HTB)
#define PG8_STAGE(bufoff, gbase, voff) do { _Pragma("unroll") for (int _i = 0; _i < 2; ++_i) \
        __builtin_amdgcn_global_load_lds((const unsigned*)((const char*)(gbase) + (voff)[_i]), (LAS unsigned*)(lds + (bufoff) + ldsw + _i * 8192), 16, 0, 0); } while (0)
#define PG8_LDA(dst, b, h) do { _Pragma("unroll") for (int m = 0; m < 4; ++m) _Pragma("unroll") for (int k = 0; k < 2; ++k) dst[m][k] = *(const LAS bf16x8*)(lds + PG8_SA(b, h) + aoff + m * 2048 + k * 1024); } while (0)
#define PG8_LDB(dst, b, h) do { _Pragma("unroll") for (int n = 0; n < 2; ++n) _Pragma("unroll") for (int k = 0; k < 2; ++k) dst[n][k] = *(const LAS bf16x8*)(lds + PG8_SB(b, h) + boff + n * 2048 + k * 1024); } while (0)
#define PG8_MMA(ai, bj, At, Bt) do { __builtin_amdgcn_s_setprio(1); _Pragma("unroll") for (int m = 0; m < 4; ++m) _Pragma("unroll") for (int n = 0; n < 2; ++n) _Pragma("unroll") for (int k = 0; k < 2; ++k) \
        acc[ai][bj][m][n] = __builtin_amdgcn_mfma_f32_16x16x32_bf16(Bt[n][k], At[m][k], acc[ai][bj][m][n], 0, 0, 0); __builtin_amdgcn_s_setprio(0); } while (0)
#define PG8_WAIT_V(n) asm volatile("s_waitcnt vmcnt(" #n ")" ::: "memory")
#define PG8_WAIT_L(n) asm volatile("s_waitcnt lgkmcnt(" #n ")" ::: "memory")
#define PG8_BAR __builtin_amdgcn_s_barrier()
#define PG8_SCHED __builtin_amdgcn_sched_barrier(0)
    Unit cur, nxt; int ui = 0;
    if (!S.next(0, cur)) return;
    f32x4 acc[2][2][4][2];
#pragma unroll
    for (int a = 0; a < 2; ++a)
#pragma unroll
        for (int b = 0; b < 2; ++b)
#pragma unroll
            for (int m = 0; m < 4; ++m)
#pragma unroll
                for (int n = 0; n < 2; ++n) acc[a][b][m][n] = (f32x4){0.f, 0.f, 0.f, 0.f};
    bf16x8 At[4][2], B0[2][2], B1[2][2];
    const char* cA = (const char*)g.A + (size_t)cur.pm * tstep + (size_t)cur.kt0 * kstep; const char* cB = (const char*)g.Bt + (size_t)cur.pn * tstep + (size_t)cur.kt0 * kstep;
    PG8_STAGE(PG8_SB(0, 0), cB, voffB); PG8_STAGE(PG8_SA(0, 0), cA, voffA); PG8_STAGE(PG8_SB(0, 1), cB + hstep, voffB); PG8_STAGE(PG8_SA(0, 1), cA + hstep, voffA);
    if (wr == 1) PG8_BAR;
    PG8_WAIT_V(4); PG8_BAR;
    PG8_STAGE(PG8_SB(1, 0), cB + kstep, voffB); PG8_STAGE(PG8_SA(1, 0), cA + kstep, voffA); PG8_STAGE(PG8_SB(1, 1), cB + hstep + kstep, voffB);
    PG8_WAIT_V(6); PG8_BAR;
    for (;;) {
        const bool has_next = S.next(ui + 1, nxt);
        const char* nA = has_next ? (const char*)g.A + (size_t)nxt.pm * tstep + (size_t)nxt.kt0 * kstep : cA; const char* nB = has_next ? (const char*)g.Bt + (size_t)nxt.pn * tstep + (size_t)nxt.kt0 * kstep : cB;
        const int nt = cur.nkt;
        for (int t = 0; t < nt; t += 2) {
            const bool last = (t == nt - 2);
            const char* a1 = cA + (size_t)(t + 1) * kstep;
            const char* a2 = last ? nA : cA + (size_t)(t + 2) * kstep; const char* b2 = last ? nB : cB + (size_t)(t + 2) * kstep;
            const char* a3 = a2 + kstep; const char* b3 = b2 + kstep;
            PG8_LDB(B0, 0, 0); PG8_SCHED; PG8_LDA(At, 0, 0); PG8_STAGE(PG8_SA(1, 1), a1 + hstep, voffA);
            PG8_WAIT_L(8); PG8_BAR; PG8_WAIT_L(0); PG8_MMA(0, 0, At, B0); PG8_BAR; PG8_SCHED;
            PG8_LDB(B1, 0, 1); PG8_STAGE(PG8_SB(0, 0), b2, voffB);
            PG8_BAR; PG8_WAIT_L(0); PG8_MMA(0, 1, At, B1); PG8_BAR;
            PG8_LDA(At, 0, 1); PG8_STAGE(PG8_SA(0, 0), a2, voffA);
            PG8_BAR; PG8_WAIT_L(0); PG8_MMA(1, 0, At, B0); PG8_BAR; PG8_SCHED;
            PG8_STAGE(PG8_SB(0, 1), b2 + hstep, voffB);
            PG8_WAIT_V(6); PG8_BAR; PG8_MMA(1, 1, At, B1); PG8_BAR;
            PG8_LDB(B0, 1, 0); PG8_SCHED; PG8_LDA(At, 1, 0); PG8_STAGE(PG8_SA(0, 1), a2 + hstep, voffA);
            PG8_WAIT_L(8); PG8_BAR; PG8_WAIT_L(0); PG8_MMA(0, 0, At, B0); PG8_BAR; PG8_SCHED;
            PG8_LDB(B1, 1, 1); PG8_STAGE(PG8_SB(1, 0), b3, voffB);
            PG8_BAR; PG8_WAIT_L(0); PG8_MMA(0, 1, At, B1); PG8_BAR;
            PG8_LDA(At, 1, 1); PG8_STAGE(PG8_SA(1, 0), a3, voffA);
            PG8_BAR; PG8_WAIT_L(0); PG8_MMA(1, 0, At, B0); PG8_BAR; PG8_SCHED;
            PG8_STAGE(PG8_SB(1, 1), b3 + hstep, voffB);
            PG8_WAIT_V(6); PG8_BAR; PG8_MMA(1, 1, At, B1); PG8_BAR;
        }
        E(acc, cur, wr, wc, fr, fq);
        if (!has_next) break;
#pragma unroll
        for (int a = 0; a < 2; ++a)
#pragma unroll
            for (int b = 0; b < 2; ++b)
#pragma unroll
                for (int m = 0; m < 4; ++m)
#pragma unroll
                    for (int n = 0; n < 2; ++n) acc[a][b][m][n] = (f32x4){0.f, 0.f, 0.f, 0.f};
        cur = nxt; cA = nA; cB = nB; ++ui;
    }
    PG8_WAIT_V(0);
    if (wr == 0) PG8_BAR;
    PG8_BAR;
#undef PG8_SA
#undef PG8_SB
#undef PG8_STAGE
#undef PG8_LDA
#undef PG8_LDB
#undef PG8_MMA
#undef PG8_WAIT_V
#undef PG8_WAIT_L
#undef PG8_BAR
#undef PG8_SCHED
}
}
using pg8::Unit;

struct EpiG1 {
    bf16_t* P; float* DT; const float* dtb;
    __device__ __forceinline__ void operator()(const f32x4 (&acc)[2][2][4][2], const Unit& u, int wr, int wc, int fr, int fq) const {
        const int row0 = u.pm * 256 + wr * 64 + fr;
        if (u.pn < 40) {
            const int mode = u.pn < 8 ? 1 : (u.pn < 24 ? 0 : 2);
            const int col0 = u.pn * 256 + wc * 32 + 8 * fq;
#pragma unroll
            for (int ai = 0; ai < 2; ++ai)
#pragma unroll
                for (int m = 0; m < 4; ++m) { bf16_t* rowp = P + (size_t)(row0 + ai * 128 + m * 16) * NPROJ + col0;
#pragma unroll
                    for (int bj = 0; bj < 2; ++bj) { float v[8];
#pragma unroll
                        for (int j = 0; j < 4; ++j) { v[j] = acc[ai][bj][m][0][j]; v[4 + j] = acc[ai][bj][m][1][j]; }
                        if (mode == 1) {
#pragma unroll
                            for (int j = 0; j < 8; ++j) v[j] = silu_f(v[j]); }
                        else if (mode == 2) {
#pragma unroll
                            for (int j = 0; j < 8; ++j) v[j] = gelu_f(v[j]); }
                        *(u32x4*)(rowp + bj * 128) = pack8(v); } }
        } else if (wc == 0) {
#pragma unroll
            for (int ai = 0; ai < 2; ++ai)
#pragma unroll
                for (int m = 0; m < 4; ++m) { float* rowp = DT + (size_t)(row0 + ai * 128 + m * 16) * 32 + 8 * fq;
#pragma unroll
                    for (int n = 0; n < 2; ++n) { f32x4 o;
#pragma unroll
                        for (int j = 0; j < 4; ++j) o[j] = softplus_f(acc[ai][0][m][n][j] + dtb[8 * fq + 4 * n + j]);
                        *(f32x4*)(rowp + 4 * n) = o; } }
        }
    }
};
struct EpiX {
    float* X; float* SL;
    __device__ __forceinline__ void operator()(const f32x4 (&acc)[2][2][4][2], const Unit& u, int wr, int wc, int fr, int fq) const {
        const int col0 = u.pn * 256 + wc * 32 + 8 * fq;
        if (u.slab < 0) {
            const int row0 = u.pm * 256 + wr * 64 + fr;
#pragma unroll
            for (int ai = 0; ai < 2; ++ai)
#pragma unroll
                for (int m = 0; m < 4; ++m) { float* rowp = X + (size_t)(row0 + ai * 128 + m * 16) * DM + col0;
#pragma unroll
                    for (int bj = 0; bj < 2; ++bj) { f32x4* q = (f32x4*)(rowp + bj * 128); f32x4 a = q[0], b = q[1]; q[0] = a + acc[ai][bj][m][0]; q[1] = b + acc[ai][bj][m][1]; } }
        } else {
            float* base = SL + (size_t)u.slab * 256 * DM; const int row0 = wr * 64 + fr;
#pragma unroll
            for (int ai = 0; ai < 2; ++ai)
#pragma unroll
                for (int m = 0; m < 4; ++m) { float* rowp = base + (size_t)(row0 + ai * 128 + m * 16) * DM + col0;
#pragma unroll
                    for (int bj = 0; bj < 2; ++bj) { f32x4* q = (f32x4*)(rowp + bj * 128); q[0] = acc[ai][bj][m][0]; q[1] = acc[ai][bj][m][1]; } }
        }
    }
};
struct EpiUp {
    bf16_t* U;
    __device__ __forceinline__ void operator()(const f32x4 (&acc)[2][2][4][2], const Unit& u, int wr, int wc, int fr, int fq) const {
        const int row0 = u.pm * 256 + wr * 64 + fr, col0 = u.pn * 256 + wc * 32 + 8 * fq;
#pragma unroll
        for (int ai = 0; ai < 2; ++ai)
#pragma unroll
            for (int m = 0; m < 4; ++m) { bf16_t* rowp = U + (size_t)(row0 + ai * 128 + m * 16) * DUP + col0;
#pragma unroll
                for (int bj = 0; bj < 2; ++bj) { u32x4 w; w.x = pk2(acc[ai][bj][m][0][0], acc[ai][bj][m][0][1]); w.y = pk2(acc[ai][bj][m][0][2], acc[ai][bj][m][0][3]);
                    w.z = pk2(acc[ai][bj][m][1][0], acc[ai][bj][m][1][1]); w.w = pk2(acc[ai][bj][m][1][2], acc[ai][bj][m][1][3]); *(u32x4*)(rowp + bj * 128) = w; } }
    }
};

__device__ __forceinline__ int map_col(int n, int mode) {
    if (mode == 0) return n;
    if (n < 6144) return n; if (n < 10240) return n + 32; if (n < 10272) return n - 10240 + 6144; return -1;
}
__device__ __forceinline__ void convert_w(const float* __restrict__ src, int K, int Nsrc, bf16_t* __restrict__ dst, int Ndst, int mode, unsigned char* shm) {
    float* tile = (float*)shm;
    TID_INIT;
    const int ntn = Ndst / 256, ntk = K / 64, ntile = ntn * ntk;
    const int tkk = tid >> 4, tn4 = tid & 15, wn = tid >> 3, wk8 = tid & 7;
    f32x4 v[4][2];
    int t = blockIdx.x;
#define CW_LOAD(tt_) do { const int tn_ = (tt_) % ntn, tk_ = (tt_) / ntn; \
        _Pragma("unroll") for (int s_ = 0; s_ < 4; ++s_) { const int sc_ = map_col(tn_ * 256 + 64 * s_ + 4 * tn4, mode); \
            _Pragma("unroll") for (int i_ = 0; i_ < 2; ++i_) { v[s_][i_] = (f32x4){0.f, 0.f, 0.f, 0.f}; if (sc_ >= 0) v[s_][i_] = *(const f32x4*)(src + (size_t)(tk_ * 64 + tkk + 32 * i_) * Nsrc + sc_); } } } while (0)
    if (t < ntile) CW_LOAD(t);
    for (; t < ntile; t += gridDim.x) {
        const int tn = t % ntn, tk = t / ntn, n0 = tn * 256, k0 = tk * 64;
#pragma unroll
        for (int s_ = 0; s_ < 4; ++s_)
#pragma unroll
            for (int i = 0; i < 2; ++i)
#pragma unroll
                for (int j = 0; j < 4; ++j) tile[(tkk + 32 * i) * 257 + 64 * s_ + 4 * tn4 + j] = v[s_][i][j];
        LBAR;
        if (t + (int)gridDim.x < ntile) CW_LOAD(t + (int)gridDim.x);
#pragma unroll
        for (int s_ = 0; s_ < 4; ++s_) { float f[8];
#pragma unroll
            for (int j = 0; j < 8; ++j) f[j] = tile[(8 * wk8 + j) * 257 + 64 * s_ + wn];
            *(u32x4*)(dst + (size_t)(n0 + 64 * s_ + wn) * K + k0 + 8 * wk8) = pack8(f); }
        LBAR;
    }
#undef CW_LOAD
}

struct CvtTile { const float* src; bf16_t* dst; int K, Nsrc, n0, k0, mode; };
__device__ __forceinline__ CvtTile cvt_decode(int lst, int t, int l, kaptr_t ka_) {
    CvtTile c; int ntn, tt; c.mode = 0;
    if (lst == 1) { ntn = 8; tt = t; c.src = PIN(I_WDN) + (size_t)l * DFF * DM; c.K = DFF; c.Nsrc = DM; c.dst = (bf16_t*)(PWS + WS_WDN); }
    else if (t < 512) { ntn = 8; tt = t; c.src = PIN(I_WOUT) + (size_t)l * DMIX * DM; c.K = DMIX; c.Nsrc = DM; c.dst = (bf16_t*)(PWS + WS_WOUT); }
    else if (t < 1920) { ntn = 44; tt = t - 512; c.src = PIN(I_WUP) + (size_t)l * DM * DUP; c.K = DM; c.Nsrc = DUP; c.dst = (bf16_t*)(PWS + WS_WUP); }
    else { ntn = 41; tt = t - 1920; c.src = PIN(I_WIN) + (size_t)(l + 1) * DM * DIN; c.K = DM; c.Nsrc = DIN; c.dst = (bf16_t*)(PWS + WS_WIN1); c.mode = 1; }
    c.n0 = (tt % ntn) * 256; c.k0 = (tt / ntn) * 64; return c;
}
__device__ __forceinline__ void convert_list(int lst, int ntot, int l, int t0, int stride, int niter, unsigned char* shm) {
    KA_INIT; TID_INIT;
    float* tile = (float*)shm;
    const int tkk = tid >> 4, tn4 = tid & 15, wn = tid >> 3, wk8 = tid & 7;
    f32x4 v[4][2];
    int t = t0; asm volatile("" : "+s"(t));
#define CL_LOAD(tt_) do { const CvtTile c_ = cvt_decode(lst, (tt_), l, ka_); \
        _Pragma("unroll") for (int s_ = 0; s_ < 4; ++s_) { const int sc_ = map_col(c_.n0 + 64 * s_ + 4 * tn4, c_.mode); \
            _Pragma("unroll") for (int i_ = 0; i_ < 2; ++i_) { v[s_][i_] = (f32x4){0.f, 0.f, 0.f, 0.f}; \
                if (sc_ >= 0) v[s_][i_] = *(const f32x4*)(c_.src + (size_t)(c_.k0 + tkk + 32 * i_) * c_.Nsrc + sc_); } } } while (0)
    if (niter > 0 && t < ntot) CL_LOAD(t);
    for (int k = 0; k < niter && t < ntot; ++k, t += stride) {
        const CvtTile c = cvt_decode(lst, t, l, ka_);
#pragma unroll
        for (int s_ = 0; s_ < 4; ++s_)
#pragma unroll
            for (int i = 0; i < 2; ++i)
#pragma unroll
                for (int j = 0; j < 4; ++j) tile[(tkk + 32 * i) * 257 + 64 * s_ + 4 * tn4 + j] = v[s_][i][j];
        LBAR;
        if (k + 1 < niter && t + stride < ntot) CL_LOAD(t + stride);
#pragma unroll
        for (int s_ = 0; s_ < 4; ++s_) { float f[8];
#pragma unroll
            for (int j = 0; j < 8; ++j) f[j] = tile[(8 * wk8 + j) * 257 + 64 * s_ + wn];
            *(u32x4*)(c.dst + (size_t)(c.n0 + 64 * s_ + wn) * c.K + c.k0 + 8 * wk8) = pack8(f); }
        LBAR;
    }
#undef CL_LOAD
}

template <int MODE>
__device__ __forceinline__ void phase_norm(const Params& p, const float* __restrict__ w, int ns, unsigned char* shm, float addA = 0.f) {
    KA_INIT; TID_INIT;
    const int lane = tid & 63, wv_ = tid >> 6, gw = blockIdx.x * 8 + wv_, nw = gridDim.x * 8;
    float* X = (float*)(PWS + WS_X); bf16_t* H = (bf16_t*)(PWS + WS_H);
    const int nrows = ns > 0 ? TP : T;
    for (int row = gw; row < nrows; row += nw) {
        const float* src = MODE == 0 ? (row < TP ? PIN(I_XP) + (size_t)row * DM : PIN(I_XS) + (size_t)(row - TP) * DM) : X + (size_t)row * DM;
        f32x4 v[8]; float ss = 0.f;
#pragma unroll
        for (int i = 0; i < 8; ++i) { v[i] = *(const f32x4*)(src + i * 256 + lane * 4); ss += v[i][0] * v[i][0] + v[i][1] * v[i][1] + v[i][2] * v[i][2] + v[i][3] * v[i][3]; }
        ss = wave_sum(ss);
        const float rstd = rsqrtf(ss * (1.0f / DM) + EPS);
#pragma unroll
        for (int i = 0; i < 8; ++i) { const int c = i * 256 + lane * 4; const f32x4 wv = *(const f32x4*)(w + c);
            if (MODE == 0) *(f32x4*)(X + (size_t)row * DM + c) = v[i];
            f32x4 o = v[i] * rstd * wv;
            if (MODE == 2) { if (PROBE && row == 0 && i == 0 && lane == 0) o[0] += addA; *(f32x4*)(POUT + O_YP + (size_t)row * DM + c) = o; }
            else { u32x2 pk; pk.x = pk2(o[0], o[1]); pk.y = pk2(o[2], o[3]); *(u32x2*)(H + (size_t)row * DM + c) = pk; } }
    }
    if (ns > 0) {
        float* red = (float*)shm; const float* SL = (const float*)(PWS + WS_PROJ);
        for (int r = blockIdx.x; r < TS; r += gridDim.x) {
            const int row = TP + r, pmi = r >> 8, rr = r & 255, c = wv_ * 256 + lane * 4;
            f32x4 v = *(const f32x4*)(X + (size_t)row * DM + c);
            { f32x4 sl[16];
#pragma unroll
              for (int s = 0; s < 16; ++s) { sl[s] = (f32x4){0.f, 0.f, 0.f, 0.f}; if (s < ns) sl[s] = *(const f32x4*)(SL + ((size_t)(pmi * ns + s) * 256 + rr) * DM + c); }
#pragma unroll
              for (int s = 0; s < 16; s += 4) v += (sl[s] + sl[s + 1]) + (sl[s + 2] + sl[s + 3]); }
            float ss = wave_sum(v[0] * v[0] + v[1] * v[1] + v[2] * v[2] + v[3] * v[3]);
            if (lane == 0) red[wv_] = ss;
            __syncthreads();
            ss = red[0] + red[1] + red[2] + red[3] + red[4] + red[5] + red[6] + red[7];
            const float rstd = rsqrtf(ss * (1.0f / DM) + EPS);
            *(f32x4*)(X + (size_t)row * DM + c) = v;
            const f32x4 o = v * rstd * *(const f32x4*)(w + c);
            if (MODE == 2) *(f32x4*)(POUT + O_YP + (size_t)row * DM + c) = o;
            else { u32x2 pk; pk.x = pk2(o[0], o[1]); pk.y = pk2(o[2], o[3]); *(u32x2*)(H + (size_t)row * DM + c) = pk; }
            __syncthreads();
        }
    }
}

__device__ __forceinline__ bf16x8 ldfrag(const bf16_t* base, int ld, int row0, int k0, int lane) { return *(const bf16x8*)(base + (row0 + (lane & 15)) * ld + k0 + (lane >> 4) * 8); }
__device__ __forceinline__ f32x4 mma16(bf16x8 x, bf16x8 y, f32x4 c) { return __builtin_amdgcn_mfma_f32_16x16x32_bf16(x, y, c, 0, 0, 0); }

__device__ __forceinline__ void phase_e1(const Params& p, int l, unsigned char* shm) {
    KA_INIT; TID_INIT;
    const int lane = tid & 63, w = __builtin_amdgcn_readfirstlane(tid >> 6);
    bf16_t* RAWE = (bf16_t*)(shm + 0);
    bf16_t* HST = (bf16_t*)(shm + 18432);
    bf16_t* OUT = (bf16_t*)(shm + 22528);
    const bf16_t* proj = (const bf16_t*)(PWS + WS_PROJ); bf16_t* bc = (bf16_t*)(PWS + WS_BC);
    typedef const float __attribute__((address_space(4)))* cptr4_t;
    const cptr4_t cw4 = (cptr4_t)(PIN(I_CW) + (size_t)l * 4 * 4096); const cptr4_t cb4 = (cptr4_t)(PIN(I_CB) + (size_t)l * 4096);
    u32x4 pre[3];
#define E1_LOAD(item_) do { const int rb_ = (item_) >> 4, chb_ = 2048 + ((item_) & 1) * 1024 + (((item_) >> 1) & 7) * 128, R0_ = rb_ * 64; const bool hh_ = R0_ < TP && (rb_ & 31) != 0; \
        _Pragma("unroll") for (int i_ = 0; i_ < 3; ++i_) { const int v_ = i_ * 512 + tid, rowh_ = v_ >> 4, c16_ = v_ & 15; pre[i_] = (u32x4){0u, 0u, 0u, 0u}; \
            if (v_ < 1072 && (rowh_ >= 3 || hh_)) pre[i_] = *(const u32x4*)(proj + (size_t)(R0_ - 3 + rowh_) * NPROJ + 2048 + chb_ + c16_ * 8); } } while (0)
    int item = blockIdx.x; asm volatile("" : "+s"(item));
    if (item < 2176) E1_LOAD(item);
    for (; item < 2176; item += gridDim.x) {
        const int rb = item >> 4, g = (item >> 1) & 7, half = item & 1, chb = 2048 + half * 1024 + g * 128, R0 = rb * 64; const bool sample = R0 >= TP;
#pragma unroll
        for (int i = 0; i < 3; ++i) { const int v_ = i * 512 + tid; if (v_ < 1072) *(u32x4*)(RAWE + (v_ >> 4) * 136 + (v_ & 15) * 8) = pre[i]; }
        if (sample && tid < 192) { const int sl = tid / 48, rem = tid - sl * 48, hr = rem >> 4, c16 = rem & 15, sq = ((R0 - TP) >> 4) + sl;
            const float* sp = PIN(I_SCONV) + ((size_t)(l * 32 + sq) * 3 + hr) * 4096 + chb + c16 * 8; const f32x4 a = *(const f32x4*)sp, b = *(const f32x4*)(sp + 4);
            u32x4 hv; hv.x = pk2(a[0], a[1]); hv.y = pk2(a[2], a[3]); hv.z = pk2(b[0], b[1]); hv.w = pk2(b[2], b[3]);
            *(u32x4*)(HST + (sl * 3 + hr) * 136 + c16 * 8) = hv; }
        LBAR;
        if (item + (int)gridDim.x < 2176) E1_LOAD(item + (int)gridDim.x);
        {
            const int t = lane, tl = t & 15;
            u32x4 rws[2][4];
#pragma unroll
            for (int it = 0; it < 2; ++it)
#pragma unroll
                for (int k = 0; k < 4; ++k) { const int c16 = 2 * w + it; int off = ((t + k) * 136 + c16 * 8) * 2;
                    if (sample && tl - 3 + k < 0) off = 18432 + (((t >> 4) * 3 + tl + k) * 136 + c16 * 8) * 2;
                    rws[it][k] = *(const u32x4*)(shm + off); }
#pragma unroll
            for (int it = 0; it < 2; ++it) { const int c16 = 2 * w + it, ch = chb + c16 * 8;
                float v[8];
#pragma unroll
                for (int j = 0; j < 8; ++j) v[j] = cb4[ch + j];
#pragma unroll
                for (int k = 0; k < 4; ++k) { float rw[8]; unpack8(rws[it][k], rw);
#pragma unroll
                    for (int j = 0; j < 8; ++j) v[j] += cw4[k * 4096 + ch + j] * rw[j]; }
#pragma unroll
                for (int j = 0; j < 8; ++j) v[j] = silu_f(v[j]);
                *(u32x4*)(OUT + t * 136 + c16 * 8) = pack8(v); }
        }
        LBAR;
#pragma unroll
        for (int i = 0; i < 2; ++i) { const int v_ = i * 512 + tid, rowo = v_ >> 4, c16 = v_ & 15;
            *(u32x4*)(bc + (size_t)(R0 + rowo) * 2048 + half * 1024 + g * 128 + c16 * 8) = *(const u32x4*)(OUT + rowo * 136 + c16 * 8); }
        if (!sample) { if ((rb & 31) == 31 && tid < 48) { const int hr = tid >> 4, c16 = tid & 15; float f[8]; unpack8(*(const u32x4*)(RAWE + (64 + hr) * 136 + c16 * 8), f);
            float* op = POUT + O_PCONV + ((size_t)(l * 4 + (rb >> 5)) * 3 + hr) * 4096 + chb + c16 * 8;
            *(f32x4*)op = (f32x4){f[0], f[1], f[2], f[3]}; *(f32x4*)(op + 4) = (f32x4){f[4], f[5], f[6], f[7]}; } }
        else if (tid < 192) { const int sl = tid / 48, rem = tid - sl * 48, hr = rem >> 4, c16 = rem & 15, sq = ((R0 - TP) >> 4) + sl; float f[8]; unpack8(*(const u32x4*)(RAWE + (3 + 16 * sl + 13 + hr) * 136 + c16 * 8), f);
            float* op = POUT + O_SCONV + ((size_t)(l * 32 + sq) * 3 + hr) * 4096 + chb + c16 * 8;
            *(f32x4*)op = (f32x4){f[0], f[1], f[2], f[3]}; *(f32x4*)(op + 4) = (f32x4){f[4], f[5], f[6], f[7]}; }
        LBAR;
    }
#undef E1_LOAD
}

__device__ __forceinline__ float wave_scan_incl(float s) {
#define DPP_ADD_(ctrl, rmask) { const int t_ = __builtin_amdgcn_update_dpp(0, __float_as_int(s), ctrl, rmask, 0xf, true); s += __int_as_float(t_); }
    DPP_ADD_(0x111, 0xf) DPP_ADD_(0x112, 0xf) DPP_ADD_(0x114, 0xf) DPP_ADD_(0x118, 0xf) DPP_ADD_(0x142, 0xa) DPP_ADD_(0x143, 0xc)
#undef DPP_ADD_
    return s;
}
__device__ __forceinline__ void ssd_chain(const Params& p, int l, bool sample, int seq, int hd, unsigned char* shm) {
    KA_INIT; TID_INIT;
    const int lane = tid & 63, w = __builtin_amdgcn_readfirstlane(tid >> 6), r = lane & 15, q = lane >> 4;
    bf16_t* Cs = (bf16_t*)(shm + 0);
    bf16_t* Bs = (bf16_t*)(shm + 17408);
    bf16_t* BT = (bf16_t*)(shm + 34816);
    bf16_t* XT = (bf16_t*)(shm + 53248);
    bf16_t* Ms = (bf16_t*)(shm + 62464);
    bf16_t* Hs = (bf16_t*)(shm + 71680);
    float* dts = (float*)(shm + 89088);
    float* acss = dts + 64; float* scs = acss + 64; float* part = scs + 64;
    bf16_t* RAW = (bf16_t*)(shm + 90624);
    bf16_t* HALO = (bf16_t*)(shm + 132608);
    float* CWs = (float*)(shm + 136704);
    const bf16_t* proj = (const bf16_t*)(PWS + WS_PROJ); const float* DT = (const float*)(PWS + WS_DT);
    bf16_t* mix = (bf16_t*)(PWS + WS_MIX); float* ssq = (float*)(PWS + WS_SSQ);
    const int g = hd >> 2, nchunk = sample ? 1 : 32, nvalid = sample ? 16 : 64;
    const int rowbase = sample ? TP + seq * 16 : seq * 2048;
    const float Dh = PIN(I_D)[l * 32 + hd];
    const float a_neg = -__expf(PIN(I_ALOG)[l * 32 + hd]);
    const int ib = w >> 1, pb0 = 2 * (w & 1), pbS = w >> 1, nb0 = 4 * (w & 1);
#define SSD_CH(cv) ((cv) < 8 ? hd * 64 + (cv) * 8 : ((cv) < 24 ? 2048 + g * 128 + ((cv) - 8) * 8 : 3072 + g * 128 + ((cv) - 24) * 8))
    typedef const float __attribute__((address_space(4)))* cptr4_t;
    const cptr4_t cw4 = (cptr4_t)(PIN(I_CW) + (size_t)l * 4 * 4096); const cptr4_t cb4 = (cptr4_t)(PIN(I_CB) + (size_t)l * 4096);
    if (tid >= 384 && tid < 384 + 120) { const int e = tid - 384, hr = e / 40, cvv = e % 40; u32x4 hv = (u32x4){0u, 0u, 0u, 0u};
        if (sample) { const float* sp = PIN(I_SCONV) + ((size_t)(l * 32 + seq) * 3 + hr) * 4096 + SSD_CH(cvv); const f32x4 a = *(const f32x4*)sp, b = *(const f32x4*)(sp + 4);
            hv.x = pk2(a[0], a[1]); hv.y = pk2(a[2], a[3]); hv.z = pk2(b[0], b[1]); hv.w = pk2(b[2], b[3]); }
        *(u32x4*)(HALO + (3 + hr) * 328 + cvv * 8) = hv; }
    f32x4 hacc[4];
    {
        const size_t hoff = ((size_t)((l * 32 + seq) * 32 + hd) * 64 + 16 * pbS + r) * 128;
#pragma unroll
        for (int tt = 0; tt < 4; ++tt) {
            f32x4 h = (f32x4){0.f, 0.f, 0.f, 0.f};
            if (sample) h = *(const f32x4*)(PIN(I_SSSD) + hoff + 16 * (nb0 + tt) + 4 * q);
            hacc[tt] = h;
            u32x2 pk; pk.x = pk2(h[0], h[1]); pk.y = pk2(h[2], h[3]);
            *(u32x2*)(Hs + (16 * pbS + r) * 136 + 16 * (nb0 + tt) + 4 * q) = pk;
        }
    }
    u32x4 rawreg[5]; float dtreg = 0.f;
    const bf16_t* wsb = (const bf16_t*)PWS;
    int goff[5], gstr[5], loffb[5];
#pragma unroll
    for (int it = 0; it < 5; ++it) { const int v_ = it * 512 + tid, prow = v_ / 40, pcv = v_ - prow * 40;
        if (pcv < 8) { goff[it] = (int)(WS_PROJ / 2) + prow * NPROJ + 2048 + hd * 64 + pcv * 8; gstr[it] = NPROJ; loffb[it] = 90624 + prow * 656 + pcv * 16; }
        else if (pcv < 24) { goff[it] = (int)(WS_BC / 2) + prow * 2048 + g * 128 + (pcv - 8) * 8; gstr[it] = 2048; loffb[it] = 17408 + prow * 272 + (pcv - 8) * 16; }
        else { goff[it] = (int)(WS_BC / 2) + prow * 2048 + 1024 + g * 128 + (pcv - 24) * 8; gstr[it] = 2048; loffb[it] = prow * 272 + (pcv - 24) * 16; } }
    const bool xhalo = tid >= 392 && ((2048 + tid) % 40) < 8;
#pragma unroll
    for (int it = 0; it < 5; ++it) { rawreg[it] = (u32x4){0u, 0u, 0u, 0u};
        if (it * 512 + tid < nvalid * 40) rawreg[it] = *(const u32x4*)(wsb + (size_t)(goff[it] + rowbase * gstr[it])); }
    if (w == 7 && lane < nvalid) dtreg = DT[(size_t)(rowbase + lane) * 32 + hd];
    for (int c = 0; c < nchunk; ++c) {
        const int R0 = rowbase + c * 64;
#pragma unroll
        for (int it = 0; it < 5; ++it) *(u32x4*)(shm + loffb[it]) = rawreg[it];
        if (xhalo) *(u32x4*)(shm + 132608 + ((c & 1) * 3 - 61) * 656 + (loffb[4] - 90624)) = rawreg[4];
        if (w == 7) {
            const float dtv = dtreg; const float s = wave_scan_incl(dtv * a_neg);
            const float lastv = __int_as_float(__builtin_amdgcn_readlane(__float_as_int(s), 63));
            dts[lane] = dtv; acss[lane] = s; scs[lane] = dtv * __expf(lastv - s);
        }
        u32x2 gz[2];
        {
            const int i = 16 * ib + r;
#pragma unroll
            for (int tt = 0; tt < 2; ++tt) { gz[tt] = (u32x2){0u, 0u}; if (i < nvalid) gz[tt] = *(const u32x2*)(proj + (size_t)(R0 + i) * NPROJ + hd * 64 + 16 * (pb0 + tt) + 4 * q); }
        }
        if (c + 1 < nchunk) {
#pragma unroll
            for (int it = 0; it < 5; ++it) rawreg[it] = *(const u32x4*)(wsb + (size_t)(goff[it] + (R0 + 64) * gstr[it]));
            if (w == 7) dtreg = DT[(size_t)(R0 + 64 + lane) * 32 + hd];
        }
        LBAR;
        {
            const int t = lane; const int haloff = 132608 + (((c + 1) & 1) * 3 + 3) * 656;
            u32x4 rws[4], bpk[2];
#pragma unroll
            for (int k = 0; k < 4; ++k) { const int tt = t - 3 + k; const int off = (tt >= 0 ? 90624 : haloff) + tt * 656 + w * 16; rws[k] = *(const u32x4*)(shm + off); }
#pragma unroll
            for (int u = 0; u < 2; ++u) bpk[u] = *(const u32x4*)(Bs + t * 136 + (2 * w + u) * 8);
            const int ch = hd * 64 + w * 8;
            float v[8];
#pragma unroll
            for (int j = 0; j < 8; ++j) v[j] = cb4[ch + j];
#pragma unroll
            for (int k = 0; k < 4; ++k) { float rw[8]; unpack8(rws[k], rw);
#pragma unroll
                for (int j = 0; j < 8; ++j) v[j] += cw4[k * 4096 + ch + j] * rw[j]; }
#pragma unroll
            for (int j = 0; j < 8; ++j) { const float sv = silu_f(v[j]); v[j] = t < nvalid ? sv : 0.f; }
            { const u32x4 pk = pack8(v);
#pragma unroll
              for (int j = 0; j < 8; ++j) XT[(w * 8 + j) * 72 + t] = (bf16_t)((j & 1) ? (pk[j >> 1] >> 16) : (pk[j >> 1] & 0xffffu)); }
#pragma unroll
            for (int u = 0; u < 2; ++u)
#pragma unroll
                for (int j = 0; j < 8; ++j) BT[((2 * w + u) * 8 + j) * 72 + t] = (bf16_t)((j & 1) ? (bpk[u][j >> 1] >> 16) : (bpk[u][j >> 1] & 0xffffu));
        }
        LBAR;
        f32x4 yo[2] = {(f32x4){0.f, 0.f, 0.f, 0.f}, (f32x4){0.f, 0.f, 0.f, 0.f}};
        {
            const int i = 16 * ib + r;
            bf16x8 fC[4], fH[2][4], fB[2][4], fXT[2], fBT[4][2]; f32x4 aj[2], dj[2], sc[2][2];
#pragma unroll
            for (int ks = 0; ks < 4; ++ks) { fC[ks] = ldfrag(Cs, 136, 16 * ib, 32 * ks, lane);
#pragma unroll
                for (int tt = 0; tt < 2; ++tt) { fH[tt][ks] = ldfrag(Hs, 136, 16 * (pb0 + tt), 32 * ks, lane); fB[tt][ks] = ldfrag(Bs, 136, 16 * (pb0 + tt), 32 * ks, lane); } }
#pragma unroll
            for (int ks = 0; ks < 2; ++ks) { fXT[ks] = ldfrag(XT, 72, 16 * pbS, 32 * ks, lane); sc[ks][0] = *(const f32x4*)(scs + 32 * ks + 8 * q); sc[ks][1] = *(const f32x4*)(scs + 32 * ks + 8 * q + 4);
#pragma unroll
                for (int tt = 0; tt < 4; ++tt) fBT[tt][ks] = ldfrag(BT, 72, 16 * (nb0 + tt), 32 * ks, lane); }
#pragma unroll
            for (int tt = 0; tt < 2; ++tt) { aj[tt] = *(const f32x4*)(acss + 16 * (pb0 + tt) + 4 * q); dj[tt] = *(const f32x4*)(dts + 16 * (pb0 + tt) + 4 * q); }
            const float ai = acss[i]; const float cd = __expf(acss[63]);
            asm volatile("" ::: "memory");
            f32x4 gg[2] = {(f32x4){0.f, 0.f, 0.f, 0.f}, (f32x4){0.f, 0.f, 0.f, 0.f}};
#pragma unroll
            for (int ks = 0; ks < 4; ++ks)
#pragma unroll
                for (int tt = 0; tt < 2; ++tt) { yo[tt] = mma16(fH[tt][ks], fC[ks], yo[tt]); gg[tt] = mma16(fB[tt][ks], fC[ks], gg[tt]); }
#pragma unroll
            for (int tt = 0; tt < 4; ++tt) hacc[tt] *= cd;
#pragma unroll
            for (int ks = 0; ks < 2; ++ks) {
                const bf16x8 xr = fXT[ks];
                float xf[8]; u32x4 xu; xu.x = (unsigned)(unsigned short)xr[0] | ((unsigned)(unsigned short)xr[1] << 16); xu.y = (unsigned)(unsigned short)xr[2] | ((unsigned)(unsigned short)xr[3] << 16);
                xu.z = (unsigned)(unsigned short)xr[4] | ((unsigned)(unsigned short)xr[5] << 16); xu.w = (unsigned)(unsigned short)xr[6] | ((unsigned)(unsigned short)xr[7] << 16);
                unpack8(xu, xf);
#pragma unroll
                for (int e = 0; e < 4; ++e) { xf[e] *= sc[ks][0][e]; xf[4 + e] *= sc[ks][1][e]; }
                const u32x4 xs = pack8(xf); bf16x8 yf;
#pragma unroll
                for (int e = 0; e < 4; ++e) { yf[2 * e] = (short)(xs[e] & 0xffffu); yf[2 * e + 1] = (short)(xs[e] >> 16); }
#pragma unroll
                for (int tt = 0; tt < 4; ++tt) hacc[tt] = mma16(fBT[tt][ks], yf, hacc[tt]);
            }
#pragma unroll
            for (int tt = 0; tt < 2; ++tt) { const int jb = pb0 + tt; float mv[4];
#pragma unroll
                for (int jj = 0; jj < 4; ++jj) { const int j = 16 * jb + 4 * q + jj; mv[jj] = (j <= i) ? gg[tt][jj] * __expf(fminf(ai - aj[tt][jj], 0.f)) * dj[tt][jj] : 0.f; }
                u32x2 pk; pk.x = pk2(mv[0], mv[1]); pk.y = pk2(mv[2], mv[3]);
                *(u32x2*)(Ms + i * 72 + 16 * jb + 4 * q) = pk; }
        }
        LBAR;
        {
            f32x4 yd[2] = {(f32x4){0.f, 0.f, 0.f, 0.f}, (f32x4){0.f, 0.f, 0.f, 0.f}};
            const int i = 16 * ib + r;
            bf16x8 fM[2], fX2[2][2]; bf16_t xe[2][4];
#pragma unroll
            for (int ks = 0; ks < 2; ++ks) { fM[ks] = ldfrag(Ms, 72, 16 * ib, 32 * ks, lane);
#pragma unroll
                for (int tt = 0; tt < 2; ++tt) fX2[tt][ks] = ldfrag(XT, 72, 16 * (pb0 + tt), 32 * ks, lane); }
#pragma unroll
            for (int tt = 0; tt < 2; ++tt)
#pragma unroll
                for (int jj = 0; jj < 4; ++jj) xe[tt][jj] = XT[(16 * (pb0 + tt) + 4 * q + jj) * 72 + i];
            const float ea = __expf(acss[i]);
            asm volatile("" ::: "memory");
#pragma unroll
            for (int ks = 0; ks < 2; ++ks)
#pragma unroll
                for (int tt = 0; tt < 2; ++tt) yd[tt] = mma16(fX2[tt][ks], fM[ks], yd[tt]);
            const bool valid = i < nvalid; const size_t row = (size_t)(R0 + i);
            float ss = 0.f;
#pragma unroll
            for (int tt = 0; tt < 2; ++tt) { const int pc = 16 * (pb0 + tt) + 4 * q;
                const float gate[4] = {__uint_as_float(gz[tt].x << 16), __uint_as_float(gz[tt].x & 0xffff0000u), __uint_as_float(gz[tt].y << 16), __uint_as_float(gz[tt].y & 0xffff0000u)};
                float y[4];
#pragma unroll
                for (int jj = 0; jj < 4; ++jj) { const float xv = bf2f(xe[tt][jj]); y[jj] = (yd[tt][jj] + ea * yo[tt][jj] + Dh * xv) * gate[jj]; ss += y[jj] * y[jj]; }
                if (valid) { u32x2 pk; pk.x = pk2(y[0], y[1]); pk.y = pk2(y[2], y[3]); *(u32x2*)(mix + row * DMIX + hd * 64 + pc) = pk; } }
            ss += __shfl_xor(ss, 16); ss += __shfl_xor(ss, 32);
            if (q == 0) part[i * 2 + (w & 1)] = ss;
#pragma unroll
            for (int tt = 0; tt < 4; ++tt) { u32x2 pk; pk.x = pk2(hacc[tt][0], hacc[tt][1]); pk.y = pk2(hacc[tt][2], hacc[tt][3]); *(u32x2*)(Hs + (16 * pbS + r) * 136 + 16 * (nb0 + tt) + 4 * q) = pk; }
        }
        LBAR;
        if (tid < nvalid) ssq[(size_t)(R0 + tid) * 32 + hd] = part[2 * tid] + part[2 * tid + 1];
    }
    if (tid < 24) { const int hr = tid >> 3, cvv = tid & 7; float f[8]; unpack8(*(const u32x4*)(RAW + (nvalid - 3 + hr) * 328 + cvv * 8), f);
        float* op = POUT + (sample ? O_SCONV + ((size_t)(l * 32 + seq) * 3 + hr) * 4096 : O_PCONV + ((size_t)(l * 4 + seq) * 3 + hr) * 4096) + hd * 64 + cvv * 8;
        *(f32x4*)op = (f32x4){f[0], f[1], f[2], f[3]}; *(f32x4*)(op + 4) = (f32x4){f[4], f[5], f[6], f[7]}; }
    {
        float* op = POUT + (sample ? O_SSSD + ((size_t)((l * 32 + seq) * 32 + hd) * 64) * 128 : O_PSSD + ((size_t)((l * 4 + seq) * 32 + hd) * 64) * 128);
#pragma unroll
        for (int tt = 0; tt < 4; ++tt) *(f32x4*)(op + (size_t)(16 * pbS + r) * 128 + 16 * (nb0 + tt) + 4 * q) = hacc[tt];
    }
    LBAR;
#undef SSD_CH
}

__device__ __forceinline__ void gmlp_item(const Params& p, int l, bool sample, int idx, unsigned char* shm) {
    KA_INIT; TID_INIT;
    const int lane = tid & 63, w = tid >> 6, r = lane & 15, q = lane >> 4;
    bf16_t* Ws = (bf16_t*)shm;
    bf16_t* VT = (bf16_t*)(shm + 34816);
    float* rs = (float*)(shm + 104448);
    float* pp = rs + 128;
    const bf16_t* proj = (const bf16_t*)(PWS + WS_PROJ); bf16_t* mix = (bf16_t*)(PWS + WS_MIX);
    const int g = idx & 7, blk = idx >> 3, R0 = sample ? TP + blk * 128 : blk * 128;
    const float* wv = PIN(I_GNW) + (size_t)l * 2048 + g * 256;
#pragma unroll
    for (int hh = 0; hh < 2; ++hh) { const int j = hh * 64 + lane; float ss = 0.f;
#pragma unroll
        for (int cc = 0; cc < 4; ++cc) { const int cv = 4 * w + cc; const u32x4 raw = *(const u32x4*)(proj + (size_t)(R0 + j) * NPROJ + 8192 + g * 256 + 8 * cv);
            float f[8]; unpack8(raw, f);
#pragma unroll
            for (int e = 0; e < 8; ++e) { ss += f[e] * f[e]; VT[(8 * cv + e) * 136 + j] = (bf16_t)((e & 1) ? (raw[e >> 1] >> 16) : (raw[e >> 1] & 0xffffu)); } }
        pp[j * 8 + w] = ss; }
    LBAR;
    if (tid < 128) { float s = 0.f;
#pragma unroll
        for (int k = 0; k < 8; ++k) s += pp[tid * 8 + k];
        rs[tid] = rsqrtf(s * (1.0f / 256.f) + EPS); }
    LBAR;
    {
        const int i = tid >> 2, jq = (tid & 3) * 32;
        const float* wsrc = PIN(I_GWS) + (size_t)(l * 8 + g) * 128 * 128;
#pragma unroll
        for (int jv = 0; jv < 8; ++jv) { const int j = jq + 4 * jv; f32x4 w4 = (f32x4){0.f, 0.f, 0.f, 0.f};
            if (!sample) { if ((j >> 6) <= (i >> 6)) w4 = *(const f32x4*)(wsrc + i * 128 + j); }
            else { if ((j >> 4) == (i >> 4)) w4 = *(const f32x4*)(wsrc + (i & 15) * 128 + (j & 15)); }
            u32x2 pk; pk.x = pk2(w4[0] * rs[j], w4[1] * rs[j + 1]); pk.y = pk2(w4[2] * rs[j + 2], w4[3] * rs[j + 3]);
            *(u32x2*)(Ws + i * 136 + j) = pk; }
        if (sample) {
#pragma unroll 1
            for (int k = 0; k < 8; ++k) { const int cvv = tid & 31, j = (tid >> 5) + 16 * k; const u32x4 raw = *(const u32x4*)(proj + (size_t)(R0 + j) * NPROJ + 8192 + g * 256 + 8 * cvv);
                float f[8]; unpack8(raw, f); const float rj = rs[j]; const int s = blk * 8 + (j >> 4), t = j & 15;
                float* op = POUT + O_SV + ((size_t)((l * 32 + s) * 16 + t)) * 2048 + g * 256 + 8 * cvv;
                const f32x4 w0 = *(const f32x4*)(wv + 8 * cvv), w1 = *(const f32x4*)(wv + 8 * cvv + 4);
                *(f32x4*)op = (f32x4){f[0] * rj * w0[0], f[1] * rj * w0[1], f[2] * rj * w0[2], f[3] * rj * w0[3]};
                *(f32x4*)(op + 4) = (f32x4){f[4] * rj * w1[0], f[5] * rj * w1[1], f[6] * rj * w1[2], f[7] * rj * w1[3]}; }
        }
    }
    LBAR;
    {
        const int ib = w, i = 16 * ib + r; const size_t row = (size_t)(R0 + i);
        const int nks = (!sample && ib < 4) ? 2 : 4;
        bf16x8 yf[4];
#pragma unroll
        for (int ks = 0; ks < 4; ++ks) yf[ks] = ldfrag(Ws, 136, 16 * ib, 32 * ks, lane);
        const float bias = PIN(I_GBS)[(size_t)(l * 8 + g) * 128 + (sample ? (i & 15) : i)];
#pragma unroll 2
        for (int db = 0; db < 16; ++db) { f32x4 acc = (f32x4){0.f, 0.f, 0.f, 0.f};
#pragma unroll
            for (int ks = 0; ks < 4; ++ks) if (ks < nks) acc = mma16(ldfrag(VT, 136, 16 * db, 32 * ks, lane), yf[ks], acc);
            const int d = 16 * db + 4 * q; const f32x4 w4 = *(const f32x4*)(wv + d);
            const u32x2 uz = *(const u32x2*)(proj + row * NPROJ + 6144 + g * 256 + d);
            const float uu[4] = {__uint_as_float(uz.x << 16), __uint_as_float(uz.x & 0xffff0000u), __uint_as_float(uz.y << 16), __uint_as_float(uz.y & 0xffff0000u)};
            float y[4];
#pragma unroll
            for (int jj = 0; jj < 4; ++jj) y[jj] = (acc[jj] * w4[jj] + bias) * uu[jj];
            u32x2 pk; pk.x = pk2(y[0], y[1]); pk.y = pk2(y[2], y[3]);
            *(u32x2*)(mix + row * DMIX + 2048 + g * 256 + d) = pk; }
    }
    LBAR;
}

__device__ __forceinline__ void phase_sn(const Params& p, int l) {
    KA_INIT; TID_INIT;
    bf16_t* mix = (bf16_t*)(PWS + WS_MIX); const float* ssq = (const float*)(PWS + WS_SSQ); const float* nw = PIN(I_SNW) + (size_t)l * 2048;
    const int nth = gridDim.x * 512;
    for (int idx0 = blockIdx.x * 512 + tid; idx0 < T * 256; idx0 += 4 * nth) {
        u32x4 raw[4]; f32x4 s4[4], w0[4], w1[4];
#pragma unroll
        for (int u = 0; u < 4; ++u) { const int idx = idx0 + u * nth; if (idx < T * 256) { const int row = idx >> 8, col = (idx & 255) * 8, g = col >> 8;
            s4[u] = *(const f32x4*)(ssq + (size_t)row * 32 + 4 * g); raw[u] = *(const u32x4*)(mix + (size_t)row * DMIX + col); w0[u] = *(const f32x4*)(nw + col); w1[u] = *(const f32x4*)(nw + col + 4); } }
#pragma unroll
        for (int u = 0; u < 4; ++u) { const int idx = idx0 + u * nth; if (idx < T * 256) { const int row = idx >> 8, col = (idx & 255) * 8;
            const float rstd = rsqrtf((s4[u][0] + s4[u][1] + s4[u][2] + s4[u][3]) * (1.0f / 256.f) + EPS);
            float f[8]; unpack8(raw[u], f);
#pragma unroll
            for (int j = 0; j < 4; ++j) { f[j] *= rstd * w0[u][j]; f[4 + j] *= rstd * w1[u][j]; }
            *(u32x4*)(mix + (size_t)row * DMIX + col) = pack8(f); } }
    }
}

__device__ __forceinline__ void phase_e2(const Params& p, int l) {
    KA_INIT; TID_INIT;
    const bf16_t* up = (const bf16_t*)(PWS + WS_PROJ); bf16_t* act = (bf16_t*)(PWS + WS_MIX);
    const float* fw = PIN(I_FCW) + (size_t)l * 3 * DUP; const float* fb = PIN(I_FCB) + (size_t)l * DUP;
    const int nth = gridDim.x * 512;
    for (int idx = blockIdx.x * 512 + tid; idx < 1088 * 704; idx += nth) {
        const int f8 = idx % 704, rb = idx / 704, r0 = rb * 8, ch = f8 * 8;
        const bool sample = r0 >= TP; const int s = (r0 - TP) >> 4;
        const bool seqstart = sample ? ((r0 & 15) == 0) : ((r0 & 2047) == 0);
        const bool seqend = sample ? ((r0 & 15) == 8) : ((r0 & 2047) == 2040);
        u32x4 rg[10], rl[10];
#pragma unroll
        for (int k = 0; k < 10; ++k) { rg[k] = (u32x4){0u, 0u, 0u, 0u}; rl[k] = (u32x4){0u, 0u, 0u, 0u};
            if (k >= 2 || !seqstart) { rg[k] = *(const u32x4*)(up + (size_t)(r0 - 2 + k) * DUP + ch); rl[k] = *(const u32x4*)(up + (size_t)(r0 - 2 + k) * DUP + DFF + ch); } }
        float wg[3][8], wl[3][8], bg[8], bl[8];
#pragma unroll
        for (int k = 0; k < 3; ++k) { const f32x4 a0 = *(const f32x4*)(fw + k * DUP + ch), a1 = *(const f32x4*)(fw + k * DUP + ch + 4), c0 = *(const f32x4*)(fw + k * DUP + DFF + ch), c1 = *(const f32x4*)(fw + k * DUP + DFF + ch + 4);
#pragma unroll
            for (int j = 0; j < 4; ++j) { wg[k][j] = a0[j]; wg[k][4 + j] = a1[j]; wl[k][j] = c0[j]; wl[k][4 + j] = c1[j]; } }
        { const f32x4 a0 = *(const f32x4*)(fb + ch), a1 = *(const f32x4*)(fb + ch + 4), c0 = *(const f32x4*)(fb + DFF + ch), c1 = *(const f32x4*)(fb + DFF + ch + 4);
#pragma unroll
            for (int j = 0; j < 4; ++j) { bg[j] = a0[j]; bg[4 + j] = a1[j]; bl[j] = c0[j]; bl[4 + j] = c1[j]; } }
        float pg[2][8], pl[2][8];
#pragma unroll
        for (int k = 0; k < 2; ++k) { unpack8(rg[k], pg[k]); unpack8(rl[k], pl[k]);
            if (seqstart && sample) { const float* sp = PIN(I_SFFN) + ((size_t)(l * 32 + s) * 2 + k) * DUP + ch;
#pragma unroll
                for (int j = 0; j < 8; ++j) { pg[k][j] = sp[j]; pl[k][j] = sp[DFF + j]; } } }
#pragma unroll
        for (int rr = 0; rr < 8; ++rr) {
            float cg_[8], cl[8], o[8];
            unpack8(rg[rr + 2], cg_); unpack8(rl[rr + 2], cl);
#pragma unroll
            for (int j = 0; j < 8; ++j) {
                const float a = bg[j] + wg[0][j] * pg[0][j] + wg[1][j] * pg[1][j] + wg[2][j] * cg_[j];
                const float b = bl[j] + wl[0][j] * pl[0][j] + wl[1][j] * pl[1][j] + wl[2][j] * cl[j];
                o[j] = silu_f(a) * b;
                pg[0][j] = pg[1][j]; pg[1][j] = cg_[j]; pl[0][j] = pl[1][j]; pl[1][j] = cl[j];
            }
            *(u32x4*)(act + (size_t)(r0 + rr) * DFF + ch) = pack8(o);
            if (seqend && rr >= 6) {
                float* op = POUT + (sample ? O_SFFN + ((size_t)(l * 32 + s) * 2 + (rr - 6)) * DUP : O_PFFN + ((size_t)(l * 4 + (r0 >> 11)) * 2 + (rr - 6)) * DUP) + ch;
                *(f32x4*)op = (f32x4){cg_[0], cg_[1], cg_[2], cg_[3]}; *(f32x4*)(op + 4) = (f32x4){cg_[4], cg_[5], cg_[6], cg_[7]};
                *(f32x4*)(op + DFF) = (f32x4){cl[0], cl[1], cl[2], cl[3]}; *(f32x4*)(op + DFF + 4) = (f32x4){cl[4], cl[5], cl[6], cl[7]};
            }
        }
    }
}

__device__ __forceinline__ void run_g1(LAS unsigned char* lds, const bf16_t* A, const bf16_t* Bt, bf16_t* P, float* DT, const float* dtb) {
    pg8::StaticOrder S; S.init(T, NINP, gridDim.x, blockIdx.x); S.nkt = DM / 64; pg8::Gemm g{A, Bt, T, NINP, DM}; EpiG1 E{P, DT, dtb}; pg8::gemm_phase(lds, g, S, E); }
__device__ __forceinline__ void run_gx(LAS unsigned char* lds, const bf16_t* A, const bf16_t* Bt, float* X, float* SL, int K, int ns) {
    pg8::HybridOrder S; S.init(K, ns, gridDim.x, blockIdx.x); pg8::Gemm g{A, Bt, T, DM, K}; EpiX E{X, SL}; pg8::gemm_phase(lds, g, S, E); }
__device__ __forceinline__ void run_g3(LAS unsigned char* lds, const bf16_t* A, const bf16_t* Bt, bf16_t* U) {
    pg8::StaticOrder S; S.init(T, DUP, gridDim.x, blockIdx.x); S.nkt = DM / 64; pg8::Gemm g{A, Bt, T, DUP, DM}; EpiUp E{U}; pg8::gemm_phase(lds, g, S, E); }
#ifndef EN_PREP
#define EN_PREP 1
#endif
#ifndef EN_GEMM
#define EN_GEMM 15
#endif
#ifndef EN_SSD
#define EN_SSD 1
#endif
#ifndef EN_GMLP
#define EN_GMLP 1
#endif
#ifndef EN_SN
#define EN_SN 1
#endif
#ifndef EN_E2
#define EN_E2 1
#endif
#if PROBE
#define MARK(cls) do { if (blockIdx.x == 0 && threadIdx.x == 0) { const unsigned long long t_ = __builtin_amdgcn_s_memrealtime(); const unsigned d_ = (unsigned)(t_ - t_prev); t_prev = t_; \
    if (PROBE_A & (1 << (cls))) accA += d_; if (PROBE_B & (1 << (cls))) accB += d_; } } while (0)
#else
#define MARK(cls) do { } while (0)
#endif
#define WSP(T_, off) ((T_*)(PWS + (off)))
constexpr size_t WS_BAR = WS_END;
constexpr size_t WS_BAR_BYTES = 16384;
constexpr size_t WS_TOTAL = WS_END + WS_BAR_BYTES;
#define XB_TMO      128
#define XB_XCNT(j)  (256  + 64 * (j))
#define XB_XSUB(j)  (1280 + 64 * (j))
#define XB_XGEN(j)  (2304 + 64 * (j))
#define XB_TOP      3328
#define XB_TOPGEN   3392
#define XB_SPIN_CAP (1u << 18)
__device__ __forceinline__ unsigned xb_ld(unsigned* p)              { return __hip_atomic_load(p, __ATOMIC_RELAXED, __HIP_MEMORY_SCOPE_AGENT); }
__device__ __forceinline__ unsigned xb_add(unsigned* p, unsigned v) { return __hip_atomic_fetch_add(p, v, __ATOMIC_RELAXED, __HIP_MEMORY_SCOPE_AGENT); }
__device__ __forceinline__ unsigned xb_xcc_id() { return (unsigned)__builtin_amdgcn_s_getreg((3 << 11) | 20) & 0xFu; }
#define XB_SPIN(cond, bar) do { unsigned _sp = 0; while (cond) { __builtin_amdgcn_s_sleep(1); \
    if ((++_sp & 255u) == 0u) { if (xb_ld(&(bar)[XB_TMO])) break; if (_sp > XB_SPIN_CAP) { atomicAdd(&(bar)[XB_TMO], 1u); break; } } } } while (0)
__device__ __forceinline__ void xcd_barrier_complete(unsigned* bar, unsigned x, unsigned& nloc, unsigned& nx) {
    const unsigned G = gridDim.x;
    unsigned sum, cnt, mine, sp = 0u;
    for (;;) {
        sum = 0u; cnt = 0u; mine = 0u;
#pragma unroll
        for (unsigned j = 0; j < 16; ++j) { const unsigned c = xb_ld(&bar[XB_XCNT(j)]); sum += c; cnt += (c > 0u) ? 1u : 0u; mine = (j == x) ? c : mine; }
        if (sum == G) break;
        __builtin_amdgcn_s_sleep(1);
        if ((++sp & 255u) == 0u) { if (xb_ld(&bar[XB_TMO])) break; if (sp > XB_SPIN_CAP) { atomicAdd(&bar[XB_TMO], 1u); break; } }
    }
    nloc = mine > 0u ? mine : 1u; nx = cnt > 0u ? cnt : 1u;
}
__device__ __forceinline__ void xcd_barrier(unsigned* bar, volatile LAS unsigned* st) {
    asm volatile("s_waitcnt vmcnt(0)" ::: "memory");
    __syncthreads();
    if (threadIdx.x == 0) {
        const unsigned x = xb_xcc_id();
        __builtin_amdgcn_s_waitcnt(0);
        unsigned nloc = st[0], nx = st[1];
        if (nloc == 0u) { xcd_barrier_complete(bar, x, nloc, nx); st[0] = nloc; st[1] = nx; }
        const unsigned old = xb_add(&bar[XB_XSUB(x)], 1u);
        const unsigned gen = old / nloc;
        if (old + 1u == (gen + 1u) * nloc) {
            __builtin_amdgcn_fence(__ATOMIC_RELEASE, "agent");
            asm volatile("s_waitcnt vmcnt(0)" ::: "memory");
            const unsigned og = xb_add(&bar[XB_TOP], 1u);
            const unsigned tg = og / nx;
            if (og + 1u == (tg + 1u) * nx) xb_add(&bar[XB_TOPGEN], 1u);
            else XB_SPIN(xb_ld(&bar[XB_TOPGEN]) == tg, bar);
            __builtin_amdgcn_fence(__ATOMIC_ACQUIRE, "agent");
            xb_add(&bar[XB_XGEN(x)], 1u);
            asm volatile("s_waitcnt vmcnt(0)" ::: "memory");
        } else {
            XB_SPIN(xb_ld(&bar[XB_XGEN(x)]) == gen, bar);
            __builtin_amdgcn_fence(__ATOMIC_ACQUIRE, "agent");
            asm volatile("s_waitcnt vmcnt(0)" ::: "memory");
        }
    }
    __syncthreads();
}
#define GSYNC do { KA_INIT; xcd_barrier((unsigned*)(PWS + WS_BAR), (volatile LAS unsigned*)((LAS unsigned char*)shm + 147456)); } while (0)
__global__ void __launch_bounds__(512, 2) fwd_kernel(Params p) {
    extern __shared__ __attribute__((aligned(16))) unsigned char shm[];
    { KA_INIT;
      volatile LAS unsigned* st = (volatile LAS unsigned*)((LAS unsigned char*)shm + 147456);
      if (threadIdx.x == 0) { st[0] = 0u; st[1] = 0u; (void)xb_add(&((unsigned*)(PWS + WS_BAR))[XB_XCNT(xb_xcc_id())], 1u); }
      __syncthreads(); }
#if PROBE
    unsigned long long t_prev = __builtin_amdgcn_s_memrealtime(); unsigned accA = 0, accB = 0;
#endif
    { KA_INIT; if (PWS == nullptr) cg::this_grid().sync(); }
    for (int l = 0; l < 2; ++l) {
#if EN_PREP
        { KA_INIT;
        if (l == 0) convert_w(PIN(I_WIN), DM, DIN, WSP(bf16_t, WS_WIN), NINP, 1, shm);
        if (l == 0) phase_norm<0>(p, PIN(I_N1W), 0, shm); else phase_norm<1>(p, PIN(I_N1W) + DM, 11, shm); }
#endif
        GSYNC;
        MARK(0);
        if (EN_GEMM & 1) { KA_INIT; run_g1((LAS unsigned char*)shm, WSP(bf16_t, WS_H), WSP(bf16_t, l ? WS_WIN1 : WS_WIN), WSP(bf16_t, WS_PROJ), WSP(float, WS_DT), PIN(I_DTB) + l * 32); }
        if (EN_PREP && gridDim.x == 256 && blockIdx.x >= 114) convert_list(0, l == 0 ? 3232 : 1920, l, (int)blockIdx.x - 114, 142, 23, shm);
        GSYNC; MARK(1);
        phase_e1(p, l, shm);
        GSYNC;
        {
            const int step = blockIdx.x < 128 ? (1 << 20) : (int)gridDim.x - 128;
            if (EN_SSD) for (int it = blockIdx.x; it < 1152; it += step) { const bool smp = it >= 128; ssd_chain(p, l, smp, smp ? (it - 128) >> 5 : it >> 5, it & 31, shm); }
            if (EN_GMLP) for (int it = blockIdx.x; it < 544; it += step) { const bool smp = it >= 512; gmlp_item(p, l, smp, smp ? it - 512 : it, shm); }
        }
        GSYNC; MARK(2);
        if (EN_PREP && gridDim.x != 256) { convert_list(0, l == 0 ? 3232 : 1920, l, (int)blockIdx.x, (int)gridDim.x, 1 << 20, shm); convert_list(1, 704, l, (int)blockIdx.x, (int)gridDim.x, 1 << 20, shm); }
        if (EN_SN) phase_sn(p, l);
        GSYNC; MARK(3);
        if (EN_GEMM & 2) { KA_INIT; run_gx((LAS unsigned char*)shm, WSP(bf16_t, WS_MIX), WSP(bf16_t, WS_WOUT), WSP(float, WS_X), WSP(float, WS_PROJ), DMIX, 16); }
        GSYNC; MARK(4);
        { KA_INIT; phase_norm<1>(p, PIN(I_N2W) + (size_t)l * DM, 16, shm); }
        GSYNC; MARK(5);
        if (EN_GEMM & 4) { KA_INIT; run_g3((LAS unsigned char*)shm, WSP(bf16_t, WS_H), WSP(bf16_t, WS_WUP), WSP(bf16_t, WS_PROJ)); }
        if (EN_PREP && gridDim.x == 256 && blockIdx.x >= 216) convert_list(1, 704, l, (int)blockIdx.x - 216, 40, 18, shm);
        GSYNC; MARK(6);
        if (EN_E2) phase_e2(p, l);
        GSYNC; MARK(7);
        if (EN_GEMM & 8) { KA_INIT; run_gx((LAS unsigned char*)shm, WSP(bf16_t, WS_MIX), WSP(bf16_t, WS_WDN), WSP(float, WS_X), WSP(float, WS_PROJ), DFF, 11); }
        GSYNC; MARK(8);
    }
#if PROBE
    float addA = 0.f;
    if (blockIdx.x == 0 && threadIdx.x == 0) { KA_INIT; addA = 10.f + (float)accA * (0.01f / 150.f); float* q_ = POUT + O_PCONV; *q_ = *q_ + 4.f + (float)accB * (0.01f / 1000.f); }
    { KA_INIT; phase_norm<2>(p, PIN(I_FNW), 11, shm, addA); }
#else
    { KA_INIT; phase_norm<2>(p, PIN(I_FNW), 11, shm); }
#endif
}

extern "C" void kernel_launch(void* const* d_in, const int* in_sizes, int n_in, void* d_out, int out_size, void* d_ws, size_t ws_size, hipStream_t stream) {
    static int grid = 0;
    if (grid == 0) {
        if (n_in != 23 || ws_size < WS_TOTAL) { fprintf(stderr, "kernel_launch: n_in %d ws %zu (need %zu)\n", n_in, ws_size, (size_t)WS_TOTAL); grid = -1; return; }
        int dev = 0, cus = 0, per_cu = 0;
        hipGetDevice(&dev); hipDeviceGetAttribute(&cus, hipDeviceAttributeMultiprocessorCount, dev);
        hipFuncSetAttribute((const void*)fwd_kernel, hipFuncAttributeMaxDynamicSharedMemorySize, LDS_BYTES);
        hipOccupancyMaxActiveBlocksPerMultiprocessor(&per_cu, (const void*)fwd_kernel, 512, LDS_BYTES);
        (void)hipGetLastError();
        if (per_cu < 1) per_cu = 1;
        grid = cus;
        if (grid < 129) { fprintf(stderr, "kernel_launch: needs > 128 CUs\n"); grid = -1; return; }
    }
    if (grid < 0) return;
    (void)hipMemsetAsync((unsigned char*)d_ws + WS_BAR, 0, WS_BAR_BYTES, stream);
    Params p{};
    for (int i = 0; i < 23; ++i) p.in[i] = (const float*)d_in[i];
    p.out = (float*)d_out; p.ws = (unsigned char*)d_ws;
    void* args[] = {&p};
    hipError_t e = hipLaunchCooperativeKernel((const void*)fwd_kernel, dim3(grid), dim3(512), args, LDS_BYTES, stream);
    if (e != hipSuccess) fprintf(stderr, "cooperative launch failed: %s (grid %d)\n", hipGetErrorString(e), grid);
}
```
